# Optimizing an MI355X kernel written in HIP

```python
import jax, jax.numpy as jnp
from jax import lax
import numpy as np

D_MODEL = 1024
BATCH = 4
SEQ = 8192
DEPTH = 2

GRID_W = 64
CTX_LEN = 256
EPS = 1e-6

N_Q_HEADS = 8
N_KV_HEADS = 2
HEAD_DIM = 64
ATTN_WIDTH = N_Q_HEADS * HEAD_DIM
KV_WIDTH = N_KV_HEADS * HEAD_DIM
QKV_WIDTH = ATTN_WIDTH + 2 * KV_WIDTH
Q_BLOCK = 128
ROPE_THETA = 10000.0

CHUNK = 128
GMLP_GROUPS = 4
GMLP_WIDTH = D_MODEL // 4

CONV_WIDTH = D_MODEL // 4
CONV_K = 31

MIX_WIDTH = ATTN_WIDTH + GMLP_WIDTH + CONV_WIDTH
IN_WIDTH = QKV_WIDTH + 2 * GMLP_WIDTH + 2 * CONV_WIDTH

PEER_HEADS = 8
N_KEYS = 128
N_EXPERTS = N_KEYS * N_KEYS
PEER_TOPK = 16
PEER_QDIM = 256
PEER_TOKEN_BLOCK = 128

ALPHA = (2 * DEPTH) ** 0.25
BETA = (8 * DEPTH) ** -0.25

kernel_name = "hybrid_parallel_heads_peer_dit_block"


def layer_norm(x, g=None, b=None):
    xf = x.astype(jnp.float32)
    mu = jnp.mean(xf, -1, keepdims=True)
    var = jnp.mean(jnp.square(xf - mu), -1, keepdims=True)
    y = (xf - mu) * lax.rsqrt(var + EPS)
    if g is not None:
        y = y * g + b
    return y.astype(x.dtype)


def rms_norm(x, g):
    xf = x.astype(jnp.float32)
    y = xf * lax.rsqrt(jnp.mean(jnp.square(xf), -1, keepdims=True) + EPS) * g
    return y.astype(x.dtype)


def rope_1d(x, pos):
    half = x.shape[-1] // 2
    freqs = ROPE_THETA ** (-jnp.arange(half, dtype=jnp.float32) / half)
    ang = pos.astype(jnp.float32)[:, None] * freqs
    cos = jnp.cos(ang)[None, :, None, :]
    sin = jnp.sin(ang)[None, :, None, :]
    x1 = x[..., :half].astype(jnp.float32)
    x2 = x[..., half:].astype(jnp.float32)
    return jnp.concatenate([x1 * cos - x2 * sin, x1 * sin + x2 * cos], -1).astype(x.dtype)


def axial_rope(x, rows, cols):
    h = x.shape[-1] // 2
    return jnp.concatenate([rope_1d(x[..., :h], rows), rope_1d(x[..., h:], cols)], -1)


def modulation(cond, w_mod, b_mod):
    m = jax.nn.silu(cond) @ w_mod + b_mod
    return jnp.split(m, 6, axis=-1)


def modulate(x, shift, scale):
    return layer_norm(x) * (1.0 + scale) + shift


def attn_queries(p, q_g, rows=None, cols=None):
    B, L, _ = p.shape
    q = rms_norm(p[..., :ATTN_WIDTH].reshape(B, L, N_Q_HEADS, HEAD_DIM), q_g)
    return q if rows is None else axial_rope(q, rows, cols)


def attn_keys_values(p, k_g, rows=None, cols=None):
    B, L, _ = p.shape
    k = rms_norm(p[..., ATTN_WIDTH:ATTN_WIDTH + KV_WIDTH].reshape(B, L, N_KV_HEADS, HEAD_DIM), k_g)
    v = p[..., ATTN_WIDTH + KV_WIDTH:QKV_WIDTH].reshape(B, L, N_KV_HEADS, HEAD_DIM)
    if rows is not None:
        k = axial_rope(k, rows, cols)
    return k, v


def gqa_attend(q, k, v):
    B, Lq = q.shape[:2]
    qg = q.reshape(B, Lq, N_KV_HEADS, N_Q_HEADS // N_KV_HEADS, HEAD_DIM)
    s = jnp.einsum('bqgrd,bkgd->bgrqk', qg, k, preferred_element_type=jnp.float32) * (HEAD_DIM ** -0.5)
    pr = jax.nn.softmax(s, axis=-1).astype(v.dtype)
    o = jnp.einsum('bgrqk,bkgd->bqgrd', pr, v)
    return o.reshape(B, Lq, ATTN_WIDTH)


def blocked_attention(q, k, v):
    B, L = q.shape[:2]
    nb = L // Q_BLOCK
    qb = jnp.moveaxis(q.reshape(B, nb, Q_BLOCK, N_Q_HEADS, HEAD_DIM), 1, 0)
    ob = lax.map(lambda qi: gqa_attend(qi, k, v), qb)
    return jnp.moveaxis(ob, 0, 1).reshape(B, L, ATTN_WIDTH)


def chunk_gmlp(z, ln_g, ln_b, w_s, b_s):
    B, L, _ = z.shape
    z = jax.nn.gelu(z)
    u, v = jnp.split(z, 2, axis=-1)
    v = layer_norm(v, ln_g, ln_b)
    v = v.reshape(B, L // CHUNK, CHUNK, GMLP_GROUPS, GMLP_WIDTH // GMLP_GROUPS)
    s = jnp.einsum('gpq,bnqgc->bnpgc', w_s, v) + b_s.T[None, None, :, :, None]
    return u * s.reshape(B, L, GMLP_WIDTH)


def conformer_conv(z, w_dw, b_dw, ln_g, ln_b, w_pw, b_pw):
    a, g = jnp.split(z, 2, axis=-1)
    y = a * jax.nn.sigmoid(g)
    y = lax.conv_general_dilated(
        y, w_dw[:, None, :], window_strides=(1,),
        padding=[(CONV_K // 2, CONV_K // 2)],
        dimension_numbers=('NWC', 'WIO', 'NWC'),
        feature_group_count=CONV_WIDTH) + b_dw
    y = jax.nn.silu(layer_norm(y, ln_g, ln_b))
    return y @ w_pw + b_pw


def token_mixers(p, attn_o, gmlp_ln_g, gmlp_ln_b, gmlp_w_s, gmlp_b_s,
                 conv_w_dw, conv_b_dw, conv_ln_g, conv_ln_b, conv_w_pw, conv_b_pw, w_out):
    zg = p[..., QKV_WIDTH:QKV_WIDTH + 2 * GMLP_WIDTH]
    zc = p[..., QKV_WIDTH + 2 * GMLP_WIDTH:]
    y_g = chunk_gmlp(zg, gmlp_ln_g, gmlp_ln_b, gmlp_w_s, gmlp_b_s)
    y_c = conformer_conv(zc, conv_w_dw, conv_b_dw, conv_ln_g, conv_ln_b, conv_w_pw, conv_b_pw)
    return jnp.concatenate([attn_o, y_g, y_c], axis=-1) @ w_out


def peer_ffn(h, w_q, sub_keys, u_tab, v_tab):
    B, L, D = h.shape
    hb = h.reshape(-1, PEER_TOKEN_BLOCK, D)

    def block(xb):
        T = xb.shape[0]
        q = (xb @ w_q).reshape(T, PEER_HEADS, 2, PEER_QDIM // 2)
        s = jnp.einsum('thpd,hpkd->thpk', q, sub_keys, preferred_element_type=jnp.float32)
        s_top, i_top = lax.top_k(s, PEER_TOPK)
        cand = s_top[:, :, 0, :, None] + s_top[:, :, 1, None, :]
        cand_idx = i_top[:, :, 0, :, None] * N_KEYS + i_top[:, :, 1, None, :]
        best, pos = lax.top_k(cand.reshape(T, PEER_HEADS, PEER_TOPK * PEER_TOPK), PEER_TOPK)
        experts = jnp.take_along_axis(cand_idx.reshape(T, PEER_HEADS, -1), pos, axis=-1)
        gate = jax.nn.softmax(best, axis=-1)
        act = jax.nn.gelu(jnp.einsum('thkd,td->thk', u_tab[experts], xb,
                                     preferred_element_type=jnp.float32))
        w = (gate * act).astype(xb.dtype)
        return jnp.einsum('thk,thkd->td', w, v_tab[experts])

    return lax.map(block, hb).reshape(B, L, D)


def setup_inputs(seed: int = 0) -> dict:
    key = jax.random.key(seed)
    ks = jax.random.split(key, 28)
    D = D_MODEL

    def nrm(i, shape, s):
        return jax.random.normal(ks[i], shape, jnp.float32) * s

    def gain(i, shape):
        return 1.0 + nrm(i, shape, 0.01)

    return {
        "x": nrm(0, (BATCH, SEQ, D), 1.0),
        "c": nrm(1, (BATCH, D), 1.0),
        "ctx": nrm(2, (BATCH, CTX_LEN, D), 1.0),
        "c_ctx": nrm(3, (D,), 1.0),
        "w_mod": nrm(4, (DEPTH, D, 6 * D), 0.5 * D ** -0.5),
        "b_mod": nrm(5, (DEPTH, 6 * D), 0.01),
        "w_in": nrm(6, (DEPTH, D, IN_WIDTH), D ** -0.5),
        "q_norm_g": gain(7, (DEPTH, HEAD_DIM)),
        "k_norm_g": gain(8, (DEPTH, HEAD_DIM)),
        "gmlp_ln_g": gain(9, (DEPTH, GMLP_WIDTH)),
        "gmlp_ln_b": nrm(10, (DEPTH, GMLP_WIDTH), 0.01),
        "gmlp_w_s": nrm(11, (DEPTH, GMLP_GROUPS, CHUNK, CHUNK), CHUNK ** -0.5),
        "gmlp_b_s": gain(12, (DEPTH, GMLP_GROUPS, CHUNK)),
        "conv_w_dw": nrm(13, (DEPTH, CONV_K, CONV_WIDTH), CONV_K ** -0.5),
        "conv_b_dw": nrm(14, (DEPTH, CONV_WIDTH), 0.01),
        "conv_ln_g": gain(15, (DEPTH, CONV_WIDTH)),
        "conv_ln_b": nrm(16, (DEPTH, CONV_WIDTH), 0.01),
        "conv_w_pw": nrm(17, (DEPTH, CONV_WIDTH, CONV_WIDTH), CONV_WIDTH ** -0.5),
        "conv_b_pw": nrm(18, (DEPTH, CONV_WIDTH), 0.01),
        "w_out": nrm(19, (DEPTH, MIX_WIDTH, D), BETA * MIX_WIDTH ** -0.5),
        "ln1_g": gain(20, (DEPTH, D)),
        "ln1_b": nrm(21, (DEPTH, D), 0.01),
        "ln2_g": gain(22, (DEPTH, D)),
        "ln2_b": nrm(23, (DEPTH, D), 0.01),
        "peer_w_q": nrm(24, (DEPTH, D, PEER_HEADS * PEER_QDIM), D ** -0.5),
        "peer_sub_keys": nrm(25, (DEPTH, PEER_HEADS, 2, N_KEYS, PEER_QDIM // 2), (PEER_QDIM // 2) ** -0.5),
        "peer_u": nrm(26, (DEPTH, N_EXPERTS, D), D ** -0.5),
        "peer_v": nrm(27, (DEPTH, N_EXPERTS, D), BETA),
    }


def reference(x, c, ctx, c_ctx, w_mod, b_mod, w_in, q_norm_g, k_norm_g,
              gmlp_ln_g, gmlp_ln_b, gmlp_w_s, gmlp_b_s,
              conv_w_dw, conv_b_dw, conv_ln_g, conv_ln_b, conv_w_pw, conv_b_pw,
              w_out, ln1_g, ln1_b, ln2_g, ln2_b,
              peer_w_q, peer_sub_keys, peer_u, peer_v):
    B, L, _ = x.shape
    rows = L // GRID_W
    row_ids = jnp.repeat(jnp.arange(rows, dtype=jnp.int32), GRID_W)
    col_ids = jnp.arange(rows * GRID_W, dtype=jnp.int32) % GRID_W

    x_lat, x_ctx = x, ctx
    for l in range(DEPTH):
        last = l == DEPTH - 1
        sh1, sc1, g1, sh2, sc2, g2 = modulation(c[:, None, :], w_mod[l], b_mod[l])
        csh1, csc1, cg1, csh2, csc2, cg2 = modulation(c_ctx, w_mod[l], b_mod[l])
        mix_params = (gmlp_ln_g[l], gmlp_ln_b[l], gmlp_w_s[l], gmlp_b_s[l],
                      conv_w_dw[l], conv_b_dw[l], conv_ln_g[l], conv_ln_b[l],
                      conv_w_pw[l], conv_b_pw[l], w_out[l])

        p_lat = modulate(x_lat, sh1, sc1) @ w_in[l]
        p_ctx = modulate(x_ctx, csh1, csc1) @ w_in[l]
        k_c, v_c = attn_keys_values(p_ctx, k_norm_g[l])
        k_l, v_l = attn_keys_values(p_lat, k_norm_g[l], row_ids, col_ids)
        q_l = attn_queries(p_lat, q_norm_g[l], row_ids, col_ids)
        k_all = jnp.concatenate([k_c, k_l], axis=1)
        v_all = jnp.concatenate([v_c, v_l], axis=1)
        o_lat = blocked_attention(q_l, k_all, v_all)
        y_lat = token_mixers(p_lat, o_lat, *mix_params)
        x_lat_new = layer_norm(ALPHA * x_lat + g1 * y_lat, ln1_g[l], ln1_b[l])

        f_lat = peer_ffn(modulate(x_lat_new, sh2, sc2), peer_w_q[l], peer_sub_keys[l], peer_u[l], peer_v[l])
        x_lat_new = layer_norm(ALPHA * x_lat_new + g2 * f_lat, ln2_g[l], ln2_b[l])

        if not last:
            q_c = attn_queries(p_ctx, q_norm_g[l])
            o_ctx = gqa_attend(q_c, k_c, v_c)
            y_ctx = token_mixers(p_ctx, o_ctx, *mix_params)
            x_ctx = layer_norm(ALPHA * x_ctx + cg1 * y_ctx, ln1_g[l], ln1_b[l])
            f_ctx = peer_ffn(modulate(x_ctx, csh2, csc2), peer_w_q[l], peer_sub_keys[l], peer_u[l], peer_v[l])
            x_ctx = layer_norm(ALPHA * x_ctx + cg2 * f_ctx, ln2_g[l], ln2_b[l])
        x_lat = x_lat_new
    return x_lat
```

```cpp
#include <hip/hip_runtime.h>
#include <stdint.h>

namespace {
constexpr int D = 1024, NB = 4, SEQ = 8192, CTXL = 256;
constexpr int ML = NB * SEQ, MC = NB * CTXL, MT = ML + MC;
constexpr int INW = 1792;
constexpr int COL_K = 512, COL_V = 640, COL_G = 768, COL_C = 1280;
constexpr float EPS = 1e-6f;
constexpr float ALPHA = 1.41421356237309515f;

typedef unsigned short bf16_t;
__device__ __forceinline__ bf16_t f2bf(float f) { uint32_t u = __float_as_uint(f); u += 0x7fffu + ((u >> 16) & 1u); return (bf16_t)(u >> 16); }
__device__ __forceinline__ float bf2f(bf16_t h) { return __uint_as_float(((uint32_t)h) << 16); }
__device__ __forceinline__ float gelu_tanh(float x) { return 0.5f * x * (1.0f + tanhf(0.7978845608028654f * (x + 0.044715f * x * x * x))); }
__device__ __forceinline__ float sigmoidf_(float x) { return 1.0f / (1.0f + expf(-x)); }
__device__ __forceinline__ float wave_sum(float v) {
#pragma unroll
    for (int o = 32; o >= 1; o >>= 1) v += __shfl_xor(v, o);
    return v;
}
__device__ __forceinline__ const float* rowptr(const float* xl, const float* xc, int row) { return row < ML ? xl + (size_t)row * D : xc + (size_t)(row - ML) * D; }
__device__ __forceinline__ float* rowptr_w(float* xl, float* xc, int row) { return row < ML ? xl + (size_t)row * D : xc + (size_t)(row - ML) * D; }
__device__ __forceinline__ int modid(int row) { return row < ML ? row / SEQ : 4; }

__global__ void __launch_bounds__(256) k_mod(const float* __restrict__ c, const float* __restrict__ cctx, const float* __restrict__ w_mod, const float* __restrict__ b_mod, float* __restrict__ mod) {
    __shared__ float sc[5][1024];
    __shared__ float red[4][5][64];
    const int tid = threadIdx.x, l = blockIdx.x / 96, cg = blockIdx.x % 96;
    for (int i = tid; i < 5 * 1024; i += 256) { int r = i >> 10, k = i & 1023; float v = r < 4 ? c[r * 1024 + k] : cctx[k]; sc[r][k] = v / (1.0f + expf(-v)); }
    __syncthreads();
    const int w = tid >> 6, lane = tid & 63, col = cg * 64 + lane;
    float acc[5] = {0.f, 0.f, 0.f, 0.f, 0.f};
    const float* wp = w_mod + (size_t)l * 1024 * 6144 + col;
    for (int k = w * 256; k < w * 256 + 256; ++k) {
        float wv = wp[(size_t)k * 6144];
#pragma unroll
        for (int r = 0; r < 5; ++r) acc[r] += sc[r][k] * wv;
    }
#pragma unroll
    for (int r = 0; r < 5; ++r) red[w][r][lane] = acc[r];
    __syncthreads();
    if (tid < 64) {
#pragma unroll
        for (int r = 0; r < 5; ++r) mod[(size_t)(l * 5 + r) * 6144 + col] = red[0][r][lane] + red[1][r][lane] + red[2][r][lane] + red[3][r][lane] + b_mod[l * 6144 + col];
    }
}

__global__ void k_rope(float* __restrict__ rope) {
    int i = blockIdx.x * blockDim.x + threadIdx.x;
    if (i < 128 * 16) {
        int pos = i >> 4, f = i & 15;
        double freq = exp(-(double)f / 16.0 * 9.210340371976184);
        double a = (double)pos * freq;
        rope[i * 2] = (float)cos(a); rope[i * 2 + 1] = (float)sin(a);
    }
}

__global__ void __launch_bounds__(256) k_ws(const float* __restrict__ w_q, const float* __restrict__ sk, float* __restrict__ W_s) {
    size_t i = (size_t)blockIdx.x * 256 + threadIdx.x;
    int k = i & 127, hp = (i >> 7) & 15, j = (i >> 11) & 1023, l = (int)(i >> 21);
    const float4* a = (const float4*)(w_q + ((size_t)l * 1024 + j) * 2048 + hp * 128);
    const float4* b = (const float4*)(sk + (((size_t)l * 16 + hp) * 128 + k) * 128);
    float acc = 0.f;
#pragma unroll 8
    for (int d = 0; d < 32; ++d) { float4 x = a[d], y = b[d]; acc += x.x * y.x + x.y * y.y + x.z * y.z + x.w * y.w; }
    W_s[i] = acc;
}

__global__ void __launch_bounds__(256) k_lnmod(const float* __restrict__ xl, const float* __restrict__ xc, const float* __restrict__ modl, int shift_off, int scale_off, bf16_t* __restrict__ h, int nrows) {
    const int lane = threadIdx.x & 63, wv = threadIdx.x >> 6;
    for (int row = blockIdx.x * 4 + wv; row < nrows; row += gridDim.x * 4) {
        const float* xp = rowptr(xl, xc, row);
        float4 v[4];
#pragma unroll
        for (int j = 0; j < 4; ++j) v[j] = *(const float4*)(xp + j * 256 + lane * 4);
        float s = 0.f;
#pragma unroll
        for (int j = 0; j < 4; ++j) s += v[j].x + v[j].y + v[j].z + v[j].w;
        const float mu = wave_sum(s) * (1.0f / 1024.0f);
        float q = 0.f;
#pragma unroll
        for (int j = 0; j < 4; ++j) { float a = v[j].x - mu, b = v[j].y - mu, c2 = v[j].z - mu, d = v[j].w - mu; q += a * a + b * b + c2 * c2 + d * d; }
        const float rstd = rsqrtf(wave_sum(q) * (1.0f / 1024.0f) + EPS);
        const float* mp = modl + (size_t)modid(row) * 6144;
#pragma unroll
        for (int j = 0; j < 4; ++j) {
            const int col = j * 256 + lane * 4;
            float4 sh = *(const float4*)(mp + shift_off + col), sc = *(const float4*)(mp + scale_off + col);
            ushort4 o;
            o.x = f2bf((v[j].x - mu) * rstd * (1.0f + sc.x) + sh.x);
            o.y = f2bf((v[j].y - mu) * rstd * (1.0f + sc.y) + sh.y);
            o.z = f2bf((v[j].z - mu) * rstd * (1.0f + sc.z) + sh.z);
            o.w = f2bf((v[j].w - mu) * rstd * (1.0f + sc.w) + sh.w);
            *(ushort4*)(h + (size_t)row * D + col) = o;
        }
    }
}

__global__ void __launch_bounds__(256) k_gemm_naive(const bf16_t* __restrict__ A, const float* __restrict__ W, float* __restrict__ C, int N, int K) {
    __shared__ float As[16][68];
    __shared__ float Bs[16][64];
    const int tid = threadIdx.x, ty = tid >> 4, tx = tid & 15;
    const int bm = blockIdx.y * 64, bn = blockIdx.x * 64;
    float acc[4][4] = {};
    for (int k0 = 0; k0 < K; k0 += 16) {
        {
            const int r = tid >> 2, kq = (tid & 3) * 4;
            ushort4 a = *(const ushort4*)(A + (size_t)(bm + r) * K + k0 + kq);
            As[kq + 0][r] = bf2f(a.x); As[kq + 1][r] = bf2f(a.y); As[kq + 2][r] = bf2f(a.z); As[kq + 3][r] = bf2f(a.w);
            const int kr = tid >> 4, nq = (tid & 15) * 4;
            *(float4*)&Bs[kr][nq] = *(const float4*)(W + (size_t)(k0 + kr) * N + bn + nq);
        }
        __syncthreads();
#pragma unroll
        for (int kk = 0; kk < 16; ++kk) {
            float4 a = *(const float4*)&As[kk][ty * 4];
            float4 b = *(const float4*)&Bs[kk][tx * 4];
            float av[4] = {a.x, a.y, a.z, a.w}, bv[4] = {b.x, b.y, b.z, b.w};
#pragma unroll
            for (int i = 0; i < 4; ++i)
#pragma unroll
                for (int j = 0; j < 4; ++j) acc[i][j] += av[i] * bv[j];
        }
        __syncthreads();
    }
#pragma unroll
    for (int i = 0; i < 4; ++i) *(float4*)(C + (size_t)(bm + ty * 4 + i) * N + bn + tx * 4) = make_float4(acc[i][0], acc[i][1], acc[i][2], acc[i][3]);
}

__global__ void __launch_bounds__(256) k_qkprep(float* __restrict__ p, const float* __restrict__ qg, const float* __restrict__ kg, const float* __restrict__ rope, int nrows) {
    const int lane = threadIdx.x & 63, wv = threadIdx.x >> 6;
    const float gq = qg[lane], gk = kg[lane];
    for (int row = blockIdx.x * 4 + wv; row < nrows; row += gridDim.x * 4) {
        float* pr = p + (size_t)row * INW;
        const bool lat = row < ML;
        const int t = row % SEQ;
        const int pos = lane < 32 ? (t >> 6) : (t & 63);
        float cs = 1.f, sn = 0.f;
        if (lat) { cs = rope[(pos * 16 + (lane & 15)) * 2]; sn = rope[(pos * 16 + (lane & 15)) * 2 + 1]; }
        for (int hd = 0; hd < 10; ++hd) {
            float x = pr[hd * 64 + lane];
            float ss = wave_sum(x * x);
            float y = x * rsqrtf(ss * (1.0f / 64.0f) + EPS) * (hd < 8 ? gq : gk);
            float o = __shfl_xor(y, 16);
            float r = (lane & 16) ? (o * sn + y * cs) : (y * cs - o * sn);
            pr[hd * 64 + lane] = r;
        }
    }
}

__global__ void __launch_bounds__(256) k_attn_naive(const float* __restrict__ p, bf16_t* __restrict__ mix, int nunits) {
    __shared__ float Qs[64][64];
    __shared__ float Ks[64][64];
    __shared__ float Vs[64][64];
    __shared__ float Ps[64][64];
    const int tid = threadIdx.x, ty = tid >> 4, tx = tid & 15;
    for (int unit = blockIdx.x; unit < nunits; unit += gridDim.x) {
        const int hq = unit & 7, qt = unit >> 3;
        const int row0 = qt * 64;
        const bool lat = row0 < ML;
        const int b = lat ? row0 / SEQ : (row0 - ML) / CTXL;
        const int nkeys = lat ? (CTXL + SEQ) : CTXL;
        const int g = hq >> 2;
        __syncthreads();
        for (int e = tid; e < 1024; e += 256) {
            const int q = e >> 4, d4 = (e & 15) * 4;
            float4 v = *(const float4*)(p + (size_t)(row0 + q) * INW + hq * 64 + d4);
            Qs[d4 + 0][q] = v.x; Qs[d4 + 1][q] = v.y; Qs[d4 + 2][q] = v.z; Qs[d4 + 3][q] = v.w;
        }
        float m[4], l[4], o[4][4];
#pragma unroll
        for (int i = 0; i < 4; ++i) { m[i] = -1e30f; l[i] = 0.f;
#pragma unroll
            for (int j = 0; j < 4; ++j) o[i][j] = 0.f; }
        for (int k0 = 0; k0 < nkeys; k0 += 64) {
            __syncthreads();
            for (int e = tid; e < 1024; e += 256) {
                const int kk = e >> 4, d4 = (e & 15) * 4;
                const int key = k0 + kk;
                const int krow = key < CTXL ? (ML + b * CTXL + key) : (b * SEQ + key - CTXL);
                const float* kp = p + (size_t)krow * INW;
                float4 kv = *(const float4*)(kp + COL_K + g * 64 + d4);
                Ks[d4 + 0][kk] = kv.x; Ks[d4 + 1][kk] = kv.y; Ks[d4 + 2][kk] = kv.z; Ks[d4 + 3][kk] = kv.w;
                *(float4*)&Vs[kk][d4] = *(const float4*)(kp + COL_V + g * 64 + d4);
            }
            __syncthreads();
            float s[4][4] = {};
#pragma unroll 8
            for (int d = 0; d < 64; ++d) {
                float4 a = *(const float4*)&Qs[d][ty * 4];
                float4 bb = *(const float4*)&Ks[d][tx * 4];
                float av[4] = {a.x, a.y, a.z, a.w}, bv[4] = {bb.x, bb.y, bb.z, bb.w};
#pragma unroll
                for (int i = 0; i < 4; ++i)
#pragma unroll
                    for (int j = 0; j < 4; ++j) s[i][j] += av[i] * bv[j];
            }
#pragma unroll
            for (int i = 0; i < 4; ++i) {
                float mx = -1e30f;
#pragma unroll
                for (int j = 0; j < 4; ++j) { s[i][j] *= 0.125f; mx = fmaxf(mx, s[i][j]); }
                mx = fmaxf(mx, __shfl_xor(mx, 1)); mx = fmaxf(mx, __shfl_xor(mx, 2)); mx = fmaxf(mx, __shfl_xor(mx, 4)); mx = fmaxf(mx, __shfl_xor(mx, 8));
                const float mn = fmaxf(m[i], mx);
                const float alpha = expf(m[i] - mn);
                float rs = 0.f;
                float pv[4];
#pragma unroll
                for (int j = 0; j < 4; ++j) { pv[j] = expf(s[i][j] - mn); rs += pv[j]; }
                rs += __shfl_xor(rs, 1); rs += __shfl_xor(rs, 2); rs += __shfl_xor(rs, 4); rs += __shfl_xor(rs, 8);
                l[i] = l[i] * alpha + rs; m[i] = mn;
#pragma unroll
                for (int j = 0; j < 4; ++j) o[i][j] *= alpha;
                *(float4*)&Ps[ty * 4 + i][tx * 4] = make_float4(pv[0], pv[1], pv[2], pv[3]);
            }
            __syncthreads();
#pragma unroll 8
            for (int kk = 0; kk < 64; ++kk) {
                float4 vv = *(const float4*)&Vs[kk][tx * 4];
                float bv[4] = {vv.x, vv.y, vv.z, vv.w};
#pragma unroll
                for (int i = 0; i < 4; ++i) { const float pp = Ps[ty * 4 + i][kk];
#pragma unroll
                    for (int j = 0; j < 4; ++j) o[i][j] += pp * bv[j]; }
            }
        }
#pragma unroll
        for (int i = 0; i < 4; ++i) {
            const float inv = 1.0f / l[i];
            ushort4 w; w.x = f2bf(o[i][0] * inv); w.y = f2bf(o[i][1] * inv); w.z = f2bf(o[i][2] * inv); w.w = f2bf(o[i][3] * inv);
            *(ushort4*)(mix + (size_t)(row0 + ty * 4 + i) * D + hq * 64 + tx * 4) = w;
        }
    }
}

__global__ void __launch_bounds__(256) k_gmlp(const float* __restrict__ p, const float* __restrict__ ln_g, const float* __restrict__ ln_b, const float* __restrict__ w_s, const float* __restrict__ b_s, bf16_t* __restrict__ mix, int nchunks) {
    __shared__ float st[128][2];
    __shared__ float V[128][64];
    const int tid = threadIdx.x, lane = tid & 63, wv = tid >> 6;
    for (int ch = blockIdx.x; ch < nchunks; ch += gridDim.x) {
        const int row0 = ch * 128;
        __syncthreads();
        for (int r = wv; r < 128; r += 4) {
            const float* zp = p + (size_t)(row0 + r) * INW + COL_G + 256;
            float4 z = *(const float4*)(zp + lane * 4);
            float a = gelu_tanh(z.x), b = gelu_tanh(z.y), c = gelu_tanh(z.z), d = gelu_tanh(z.w);
            const float mu = wave_sum(a + b + c + d) * (1.0f / 256.0f);
            a -= mu; b -= mu; c -= mu; d -= mu;
            const float var = wave_sum(a * a + b * b + c * c + d * d) * (1.0f / 256.0f);
            if (lane == 0) { st[r][0] = mu; st[r][1] = rsqrtf(var + EPS); }
        }
        for (int g = 0; g < 4; ++g) {
            __syncthreads();
            for (int e = tid; e < 128 * 64; e += 256) {
                const int q = e >> 6, c = e & 63;
                const float z = gelu_tanh(p[(size_t)(row0 + q) * INW + COL_G + 256 + g * 64 + c]);
                V[q][c] = (z - st[q][0]) * st[q][1] * ln_g[g * 64 + c] + ln_b[g * 64 + c];
            }
            __syncthreads();
            const int c = lane;
            for (int pp = wv * 32; pp < wv * 32 + 32; ++pp) {
                const float* wr = w_s + ((size_t)g * 128 + pp) * 128;
                float acc = 0.f;
#pragma unroll 8
                for (int q = 0; q < 128; ++q) acc += wr[q] * V[q][c];
                acc += b_s[g * 128 + pp];
                const float u = gelu_tanh(p[(size_t)(row0 + pp) * INW + COL_G + g * 64 + c]);
                mix[(size_t)(row0 + pp) * D + 512 + g * 64 + c] = f2bf(u * acc);
            }
        }
    }
}

__global__ void __launch_bounds__(256) k_conv(const float* __restrict__ p, const float* __restrict__ w_dw, const float* __restrict__ b_dw, const float* __restrict__ ln_g, const float* __restrict__ ln_b,
                                              const float* __restrict__ w_pw, const float* __restrict__ b_pw, bf16_t* __restrict__ mix, int ntiles) {
    __shared__ float cb[16][256];
    const int tid = threadIdx.x, lane = tid & 63, wv = tid >> 6;
    for (int tile = blockIdx.x; tile < ntiles; tile += gridDim.x) {
        const int row0 = tile * 16;
        const bool lat = row0 < ML;
        const int Ls = lat ? SEQ : CTXL;
        const int t0 = lat ? (row0 % SEQ) : ((row0 - ML) % CTXL);
        __syncthreads();
        float wd[31];
#pragma unroll
        for (int j = 0; j < 31; ++j) wd[j] = w_dw[j * 256 + tid];
        const float bd = b_dw[tid];
        for (int r = 0; r < 16; ++r) {
            float acc = bd;
#pragma unroll
            for (int j = 0; j < 31; ++j) {
                const int tt = t0 + r + j - 15;
                if (tt >= 0 && tt < Ls) {
                    const float* pr = p + (size_t)(row0 + r + j - 15) * INW + COL_C;
                    acc += pr[tid] * sigmoidf_(pr[256 + tid]) * wd[j];
                }
            }
            cb[r][tid] = acc;
        }
        __syncthreads();
        for (int r = wv * 4; r < wv * 4 + 4; ++r) {
            float4 z = *(const float4*)&cb[r][lane * 4];
            const float mu = wave_sum(z.x + z.y + z.z + z.w) * (1.0f / 256.0f);
            float a = z.x - mu, b = z.y - mu, c = z.z - mu, d = z.w - mu;
            const float rstd = rsqrtf(wave_sum(a * a + b * b + c * c + d * d) * (1.0f / 256.0f) + EPS);
            float4 gg = *(const float4*)(ln_g + lane * 4), bb = *(const float4*)(ln_b + lane * 4);
            a = a * rstd * gg.x + bb.x; b = b * rstd * gg.y + bb.y; c = c * rstd * gg.z + bb.z; d = d * rstd * gg.w + bb.w;
            a = a * sigmoidf_(a); b = b * sigmoidf_(b); c = c * sigmoidf_(c); d = d * sigmoidf_(d);
            *(float4*)&cb[r][lane * 4] = make_float4(a, b, c, d);
        }
        __syncthreads();
        float acc[16];
        const float bp = b_pw[tid];
#pragma unroll
        for (int r = 0; r < 16; ++r) acc[r] = bp;
        for (int k = 0; k < 256; ++k) {
            const float w = w_pw[k * 256 + tid];
#pragma unroll
            for (int r = 0; r < 16; ++r) acc[r] += cb[r][k] * w;
        }
#pragma unroll
        for (int r = 0; r < 16; ++r) mix[(size_t)(row0 + r) * D + 768 + tid] = f2bf(acc[r]);
    }
}

__global__ void __launch_bounds__(256) k_ln1(const float* xl, const float* xc, const float* __restrict__ y, const float* __restrict__ modl, const float* __restrict__ lg, const float* __restrict__ lb,
                                             float* x1l, float* x1c, bf16_t* __restrict__ h, int nrows) {
    const int lane = threadIdx.x & 63, wv = threadIdx.x >> 6;
    for (int row = blockIdx.x * 4 + wv; row < nrows; row += gridDim.x * 4) {
        const float* xp = rowptr(xl, xc, row);
        const float* yp = y + (size_t)row * D;
        const float* mp = modl + (size_t)modid(row) * 6144;
        float v[16];
#pragma unroll
        for (int j = 0; j < 4; ++j) {
            const int col = j * 256 + lane * 4;
            float4 a = *(const float4*)(xp + col), b = *(const float4*)(yp + col), g = *(const float4*)(mp + 2048 + col);
            v[j * 4 + 0] = ALPHA * a.x + g.x * b.x; v[j * 4 + 1] = ALPHA * a.y + g.y * b.y; v[j * 4 + 2] = ALPHA * a.z + g.z * b.z; v[j * 4 + 3] = ALPHA * a.w + g.w * b.w;
        }
        float s = 0.f;
#pragma unroll
        for (int i = 0; i < 16; ++i) s += v[i];
        float mu = wave_sum(s) * (1.0f / 1024.0f);
        float q = 0.f;
#pragma unroll
        for (int i = 0; i < 16; ++i) { v[i] -= mu; q += v[i] * v[i]; }
        float rstd = rsqrtf(wave_sum(q) * (1.0f / 1024.0f) + EPS);
        float* op = rowptr_w(x1l, x1c, row);
        s = 0.f;
#pragma unroll
        for (int j = 0; j < 4; ++j) {
            const int col = j * 256 + lane * 4;
            float4 g = *(const float4*)(lg + col), b = *(const float4*)(lb + col);
            v[j * 4 + 0] = v[j * 4 + 0] * rstd * g.x + b.x; v[j * 4 + 1] = v[j * 4 + 1] * rstd * g.y + b.y; v[j * 4 + 2] = v[j * 4 + 2] * rstd * g.z + b.z; v[j * 4 + 3] = v[j * 4 + 3] * rstd * g.w + b.w;
            *(float4*)(op + col) = make_float4(v[j * 4 + 0], v[j * 4 + 1], v[j * 4 + 2], v[j * 4 + 3]);
            s += v[j * 4 + 0] + v[j * 4 + 1] + v[j * 4 + 2] + v[j * 4 + 3];
        }
        mu = wave_sum(s) * (1.0f / 1024.0f);
        q = 0.f;
#pragma unroll
        for (int i = 0; i < 16; ++i) { v[i] -= mu; q += v[i] * v[i]; }
        rstd = rsqrtf(wave_sum(q) * (1.0f / 1024.0f) + EPS);
#pragma unroll
        for (int j = 0; j < 4; ++j) {
            const int col = j * 256 + lane * 4;
            float4 sh = *(const float4*)(mp + 3072 + col), sc = *(const float4*)(mp + 4096 + col);
            ushort4 o;
            o.x = f2bf(v[j * 4 + 0] * rstd * (1.0f + sc.x) + sh.x); o.y = f2bf(v[j * 4 + 1] * rstd * (1.0f + sc.y) + sh.y);
            o.z = f2bf(v[j * 4 + 2] * rstd * (1.0f + sc.z) + sh.z); o.w = f2bf(v[j * 4 + 3] * rstd * (1.0f + sc.w) + sh.w);
            *(ushort4*)(h + (size_t)row * D + col) = o;
        }
    }
}

__device__ __forceinline__ uint32_t fkey(float f) { uint32_t u = __float_as_uint(f); return (u & 0x80000000u) ? ~u : (u | 0x80000000u); }
__device__ __forceinline__ float funkey(uint32_t k) { uint32_t u = (k & 0x80000000u) ? (k & 0x7fffffffu) : ~k; return __uint_as_float(u); }
__device__ __forceinline__ unsigned long long wave_max_u64(unsigned long long k) {
#pragma unroll
    for (int o = 32; o >= 1; o >>= 1) {
        uint32_t hi = __shfl_xor((uint32_t)(k >> 32), o), lo = __shfl_xor((uint32_t)k, o);
        unsigned long long other = ((unsigned long long)hi << 32) | lo;
        k = other > k ? other : k;
    }
    return k;
}
__global__ void __launch_bounds__(256) k_topk(const float* __restrict__ s, int* __restrict__ tk_idx, float* __restrict__ tk_gate, int nrows) {
    const int lane = threadIdx.x & 63, wv = threadIdx.x >> 6;
    for (int item = blockIdx.x * 4 + wv; item < nrows * 8; item += gridDim.x * 4) {
        const float* sp = s + (size_t)item * 256;
        float topv[2]; int topi[2];
#pragma unroll
        for (int ph = 0; ph < 2; ++ph) {
            unsigned long long k0 = ((unsigned long long)fkey(sp[ph * 128 + lane]) << 32) | (unsigned)(127 - lane);
            unsigned long long k1 = ((unsigned long long)fkey(sp[ph * 128 + 64 + lane]) << 32) | (unsigned)(127 - (64 + lane));
            float tv = 0.f; int ti = 0;
            for (int it = 0; it < 16; ++it) {
                unsigned long long best = wave_max_u64(k0 > k1 ? k0 : k1);
                const int idx = 127 - (int)(best & 0xffu);
                if (k0 == best) k0 = 0ull;
                if (k1 == best) k1 = 0ull;
                if (lane == it) { tv = funkey((uint32_t)(best >> 32)); ti = idx; }
            }
            topv[ph] = tv; topi[ph] = ti;
        }
        const float av = __shfl(topv[0], lane >> 2);
        unsigned long long ck[4];
#pragma unroll
        for (int c = 0; c < 4; ++c) {
            const float bv = __shfl(topv[1], (lane & 3) * 4 + c);
            ck[c] = ((unsigned long long)fkey(av + bv) << 32) | (unsigned)(255 - (lane * 4 + c));
        }
        float bestv = 0.f; int bestpos = 0;
        for (int it = 0; it < 16; ++it) {
            unsigned long long a = ck[0] > ck[1] ? ck[0] : ck[1], b = ck[2] > ck[3] ? ck[2] : ck[3];
            unsigned long long best = wave_max_u64(a > b ? a : b);
#pragma unroll
            for (int c = 0; c < 4; ++c) if (ck[c] == best) ck[c] = 0ull;
            if (lane == it) { bestv = funkey((uint32_t)(best >> 32)); bestpos = 255 - (int)(best & 0xffu); }
        }
        const int ia = __shfl(topi[0], bestpos >> 4), ib = __shfl(topi[1], bestpos & 15);
        const float mx = __shfl(bestv, 0);
        const float e = lane < 16 ? expf(bestv - mx) : 0.f;
        const float sum = wave_sum(e);
        if (lane < 16) { tk_idx[(size_t)item * 16 + lane] = ia * 128 + ib; tk_gate[(size_t)item * 16 + lane] = e / sum; }
    }
}

__global__ void __launch_bounds__(256) k_peer(const bf16_t* __restrict__ h, const int* __restrict__ tk_idx, const float* __restrict__ tk_gate, const float* __restrict__ ut, const float* __restrict__ vt,
                                              const float* x1l_, const float* x1c_, const float* __restrict__ modl, const float* __restrict__ lg, const float* __restrict__ lb,
                                              float* x2l, float* x2c, int nrows) {
    __shared__ float fb[4][1024];
    __shared__ float red[8];
    const int tid = threadIdx.x, lane = tid & 63, wv = tid >> 6;
    for (int row = blockIdx.x; row < nrows; row += gridDim.x) {
        __syncthreads();
        float hv[16];
#pragma unroll
        for (int j = 0; j < 4; ++j) { ushort4 a = *(const ushort4*)(h + (size_t)row * D + j * 256 + lane * 4); hv[j * 4] = bf2f(a.x); hv[j * 4 + 1] = bf2f(a.y); hv[j * 4 + 2] = bf2f(a.z); hv[j * 4 + 3] = bf2f(a.w); }
        float acc[16];
#pragma unroll
        for (int i = 0; i < 16; ++i) acc[i] = 0.f;
        for (int hh = 0; hh < 2; ++hh) {
            const int head = wv * 2 + hh;
            const int myi = lane < 16 ? tk_idx[((size_t)row * 8 + head) * 16 + lane] : 0;
            const float myg = lane < 16 ? tk_gate[((size_t)row * 8 + head) * 16 + lane] : 0.f;
            for (int k = 0; k < 16; ++k) {
                const int e = __shfl(myi, k);
                const float gate = __shfl(myg, k);
                const float* up = ut + (size_t)e * D;
                float d = 0.f;
#pragma unroll
                for (int j = 0; j < 4; ++j) { float4 u = *(const float4*)(up + j * 256 + lane * 4); d += u.x * hv[j * 4] + u.y * hv[j * 4 + 1] + u.z * hv[j * 4 + 2] + u.w * hv[j * 4 + 3]; }
                d = wave_sum(d);
                const float w = gate * gelu_tanh(d);
                const float* vp = vt + (size_t)e * D;
#pragma unroll
                for (int j = 0; j < 4; ++j) { float4 v = *(const float4*)(vp + j * 256 + lane * 4); acc[j * 4] += w * v.x; acc[j * 4 + 1] += w * v.y; acc[j * 4 + 2] += w * v.z; acc[j * 4 + 3] += w * v.w; }
            }
        }
#pragma unroll
        for (int j = 0; j < 4; ++j) *(float4*)&fb[wv][j * 256 + lane * 4] = make_float4(acc[j * 4], acc[j * 4 + 1], acc[j * 4 + 2], acc[j * 4 + 3]);
        __syncthreads();
        const int col = tid * 4;
        float4 f0 = *(const float4*)&fb[0][col], f1 = *(const float4*)&fb[1][col], f2 = *(const float4*)&fb[2][col], f3 = *(const float4*)&fb[3][col];
        const float* mp = modl + (size_t)modid(row) * 6144;
        float4 g2 = *(const float4*)(mp + 5120 + col);
        float4 x1 = *(const float4*)(rowptr(x1l_, x1c_, row) + col);
        float t0 = ALPHA * x1.x + g2.x * (f0.x + f1.x + f2.x + f3.x), t1 = ALPHA * x1.y + g2.y * (f0.y + f1.y + f2.y + f3.y);
        float t2 = ALPHA * x1.z + g2.z * (f0.z + f1.z + f2.z + f3.z), t3 = ALPHA * x1.w + g2.w * (f0.w + f1.w + f2.w + f3.w);
        float sm = wave_sum(t0 + t1 + t2 + t3);
        if (lane == 0) red[wv] = sm;
        __syncthreads();
        const float mu = (red[0] + red[1] + red[2] + red[3]) * (1.0f / 1024.0f);
        t0 -= mu; t1 -= mu; t2 -= mu; t3 -= mu;
        float sq = wave_sum(t0 * t0 + t1 * t1 + t2 * t2 + t3 * t3);
        if (lane == 0) red[4 + wv] = sq;
        __syncthreads();
        const float rstd = rsqrtf((red[4] + red[5] + red[6] + red[7]) * (1.0f / 1024.0f) + EPS);
        float4 gg = *(const float4*)(lg + col), bb = *(const float4*)(lb + col);
        *(float4*)(rowptr_w(x2l, x2c, row) + col) = make_float4(t0 * rstd * gg.x + bb.x, t1 * rstd * gg.y + bb.y, t2 * rstd * gg.z + bb.z, t3 * rstd * gg.w + bb.w);
    }
}
}

extern "C" void kernel_launch(void* const* d_in, const int* in_sizes, int n_in, void* d_out, int out_size, void* d_ws, size_t ws_size, hipStream_t stream) {
    const float* x = (const float*)d_in[0];
    const float* c = (const float*)d_in[1];
    const float* ctx = (const float*)d_in[2];
    const float* c_ctx = (const float*)d_in[3];
    const float* w_mod = (const float*)d_in[4];
    const float* b_mod = (const float*)d_in[5];
    const float* w_in = (const float*)d_in[6];
    const float* q_norm_g = (const float*)d_in[7];
    const float* k_norm_g = (const float*)d_in[8];
    const float* gmlp_ln_g = (const float*)d_in[9];
    const float* gmlp_ln_b = (const float*)d_in[10];
    const float* gmlp_w_s = (const float*)d_in[11];
    const float* gmlp_b_s = (const float*)d_in[12];
    const float* conv_w_dw = (const float*)d_in[13];
    const float* conv_b_dw = (const float*)d_in[14];
    const float* conv_ln_g = (const float*)d_in[15];
    const float* conv_ln_b = (const float*)d_in[16];
    const float* conv_w_pw = (const float*)d_in[17];
    const float* conv_b_pw = (const float*)d_in[18];
    const float* w_out = (const float*)d_in[19];
    const float* ln1_g = (const float*)d_in[20];
    const float* ln1_b = (const float*)d_in[21];
    const float* ln2_g = (const float*)d_in[22];
    const float* ln2_b = (const float*)d_in[23];
    const float* peer_w_q = (const float*)d_in[24];
    const float* peer_sk = (const float*)d_in[25];
    const float* peer_u = (const float*)d_in[26];
    const float* peer_v = (const float*)d_in[27];
    float* out = (float*)d_out;

    char* ws = (char*)d_ws;
    size_t off = 0;
    auto carve = [&](size_t bytes) { char* r = ws + off; off += (bytes + 255) & ~(size_t)255; return r; };
    float* mod = (float*)carve((size_t)2 * 5 * 6144 * 4);
    float* rope = (float*)carve((size_t)128 * 16 * 2 * 4);
    bf16_t* h = (bf16_t*)carve((size_t)MT * D * 2);
    bf16_t* mix = (bf16_t*)carve((size_t)MT * D * 2);
    float* ps = (float*)carve((size_t)MT * 2048 * 4);
    float* xc1 = (float*)carve((size_t)MC * D * 4);
    float* xc2 = (float*)carve((size_t)MC * D * 4);
    float* W_s = (float*)carve((size_t)2 * 1024 * 2048 * 4);
    int* tk_idx = (int*)carve((size_t)MT * 128 * 4);
    float* tk_gate = (float*)carve((size_t)MT * 128 * 4);

    k_mod<<<192, 256, 0, stream>>>(c, c_ctx, w_mod, b_mod, mod);
    k_rope<<<8, 256, 0, stream>>>(rope);
    k_ws<<<2 * 1024 * 2048 / 256, 256, 0, stream>>>(peer_w_q, peer_sk, W_s);

    for (int l = 0; l < 2; ++l) {
        const float* xl = l == 0 ? x : out;
        const float* xc = l == 0 ? ctx : xc2;
        const float* modl = mod + (size_t)l * 5 * 6144;
        const int nr = l == 0 ? MT : ML;
        k_lnmod<<<2048, 256, 0, stream>>>(xl, xc, modl, 0, 1024, h, MT);
        k_gemm_naive<<<dim3(INW / 64, MT / 64), 256, 0, stream>>>(h, w_in + (size_t)l * 1024 * INW, ps, INW, 1024);
        k_qkprep<<<2048, 256, 0, stream>>>(ps, q_norm_g + l * 64, k_norm_g + l * 64, rope, MT);
        k_attn_naive<<<2048, 256, 0, stream>>>(ps, mix, (nr / 64) * 8);
        k_gmlp<<<nr / 128, 256, 0, stream>>>(ps, gmlp_ln_g + l * 256, gmlp_ln_b + l * 256, gmlp_w_s + (size_t)l * 4 * 128 * 128, gmlp_b_s + l * 512, mix, nr / 128);
        k_conv<<<nr / 16, 256, 0, stream>>>(ps, conv_w_dw + l * 31 * 256, conv_b_dw + l * 256, conv_ln_g + l * 256, conv_ln_b + l * 256, conv_w_pw + (size_t)l * 65536, conv_b_pw + l * 256, mix, nr / 16);
        k_gemm_naive<<<dim3(1024 / 64, nr / 64), 256, 0, stream>>>(mix, w_out + (size_t)l * 1024 * 1024, ps, 1024, 1024);
        k_ln1<<<2048, 256, 0, stream>>>(xl, xc, ps, modl, ln1_g + l * 1024, ln1_b + l * 1024, out, xc1, h, nr);
        k_gemm_naive<<<dim3(2048 / 64, nr / 64), 256, 0, stream>>>(h, W_s + (size_t)l * 1024 * 2048, ps, 2048, 1024);
        k_topk<<<4096, 256, 0, stream>>>(ps, tk_idx, tk_gate, nr);
        k_peer<<<4096, 256, 0, stream>>>(h, tk_idx, tk_gate, peer_u + (size_t)l * 16384 * 1024, peer_v + (size_t)l * 16384 * 1024, out, xc1, modl, ln2_g + l * 1024, ln2_b + l * 1024, out, xc2, nr);
    }
}
```

```cpp
#include <hip/hip_runtime.h>
#include <hip/hip_bf16.h>
#include <cstdio>
#include <cstdint>

#define GAS __attribute__((address_space(1)))
#define LAS __attribute__((address_space(3)))

namespace cfg {
constexpr int D = 1024, NB = 4, SEQ = 8192, CTXL = 256;
constexpr int ML = NB * SEQ, MC = NB * CTXL, MT = ML + MC;
constexpr int KVSEQ = CTXL + SEQ;
constexpr int INW = 1792;
constexpr float EPS = 1e-6f;
constexpr float ALPHA = 1.41421356237309515f;
constexpr float C2 = 0.125f * 1.4426950408889634f;
constexpr float U_SCALE = 1024.f, V_SCALE = 64.f;
constexpr int NWAVES = 8, NTHREADS = 512;
}
using namespace cfg;

typedef unsigned short bf16_t;
typedef float f32x2 __attribute__((ext_vector_type(2)));
typedef float f32x4 __attribute__((ext_vector_type(4)));
typedef unsigned u32x2 __attribute__((ext_vector_type(2)));
typedef unsigned u32x4 __attribute__((ext_vector_type(4)));
typedef short bf16x8 __attribute__((ext_vector_type(8)));

__device__ __forceinline__ int mk_tid() { int t = threadIdx.x; asm volatile("" : "+v"(t)); return t; }
__device__ __forceinline__ unsigned f2bf(float f) { unsigned u = __builtin_bit_cast(unsigned, f); return (u + 0x7fffu + ((u >> 16) & 1u)) >> 16; }
__device__ __forceinline__ unsigned pk2(float lo, float hi) { return f2bf(lo) | (f2bf(hi) << 16); }
__device__ __forceinline__ float bflo(unsigned w) { return __uint_as_float(w << 16); }
__device__ __forceinline__ float bfhi(unsigned w) { return __uint_as_float(w & 0xffff0000u); }
__device__ __forceinline__ float fast_sigmoid(float x) { return __builtin_amdgcn_rcpf(1.0f + __builtin_amdgcn_exp2f(-1.4426950408889634f * x)); }
__device__ __forceinline__ float gelu_tanh(float x) { const float z = x * (1.0f + 0.044715f * x * x); return x * __builtin_amdgcn_rcpf(1.0f + __builtin_amdgcn_exp2f(-2.302208198f * z)); }
__device__ __forceinline__ float wave_sum(float v) {
#pragma unroll
    for (int o = 32; o >= 1; o >>= 1) v += __shfl_xor(v, o);
    return v;
}
__device__ __forceinline__ float wave_reduce16(float (&v)[16], int lane) {
    const bool b5 = lane & 32, b4 = lane & 16, b3 = lane & 8, b2 = lane & 4;
#pragma unroll
    for (int i = 0; i < 8; ++i) { const float send = b5 ? v[i] : v[i + 8], keep = b5 ? v[i + 8] : v[i]; v[i] = keep + __shfl_xor(send, 32); }
#pragma unroll
    for (int i = 0; i < 4; ++i) { const float send = b4 ? v[i] : v[i + 4], keep = b4 ? v[i + 4] : v[i]; v[i] = keep + __shfl_xor(send, 16); }
#pragma unroll
    for (int i = 0; i < 2; ++i) { const float send = b3 ? v[i] : v[i + 2], keep = b3 ? v[i + 2] : v[i]; v[i] = keep + __shfl_xor(send, 8); }
    { const float send = b2 ? v[0] : v[1], keep = b2 ? v[1] : v[0]; v[0] = keep + __shfl_xor(send, 4); }
    v[0] += __shfl_xor(v[0], 2); v[0] += __shfl_xor(v[0], 1);
    return v[0];
}
__device__ __forceinline__ const float* rowptr(const float* xl, const float* xc, int row) { return row < ML ? xl + (size_t)row * D : xc + (size_t)(row - ML) * D; }
__device__ __forceinline__ float* rowptr_w(float* xl, float* xc, int row) { return row < ML ? xl + (size_t)row * D : xc + (size_t)(row - ML) * D; }
__device__ __forceinline__ int modid(int row) { return row < ML ? row / SEQ : 4; }
__device__ __forceinline__ int kvrow(int row) { return row < ML ? (row / SEQ) * KVSEQ + CTXL + (row % SEQ) : ((row - ML) / CTXL) * KVSEQ + ((row - ML) % CTXL); }

namespace pg8 {
#define PG8_LAS __attribute__((address_space(3)))
constexpr int BM = 256, BK = 64, HALF = 128, HTB = HALF * BK * 2  , STAGE_BYTES = 8 * HTB, NXCD = 8, WGM = 8;

__host__ __device__ __forceinline__ int lds_byte(int r, int c) { const int st = (r >> 4) * 2 + (c >> 5), rr = r & 15, cc = c & 31, ob = rr * 64 + cc * 2; return st * 1024 + (ob ^ (((ob >> 9) & 1) << 5)); }
__host__ __device__ __forceinline__ void stage_rc(int b, int& R, int& C) { const int st = b / 1024, sb = b % 1024, swz = sb ^ (((sb >> 9) & 1) << 5); R = (st >> 1) * 16 + swz / 64; C = (st & 1) * 32 + (swz % 64) / 2; }
__host__ __device__ __forceinline__ int perm32(int rho) { const int n = rho >> 4, i = rho & 15; return 8 * (i >> 2) + 4 * n + (i & 3); }

struct Unit { int pm, pn; };
struct Gemm { const bf16_t* A; const bf16_t* Bt; int M, N, K; };

struct StaticOrder {
    int nM, nN, nwg, G, c;
    __host__ __device__ void init(int M, int N, int G_, int c_) { nM = M / BM; nN = N / BM; nwg = nM * nN; G = G_; c = c_; }
    __host__ __device__ bool next(int i, Unit& u) const {
        const long L = (long)i * G + c; if (L >= nwg) return false;
        int wgid = (int)L; { const int q = nwg / NXCD, r = nwg % NXCD, xcd = wgid % NXCD, off = wgid / NXCD; wgid = (xcd < r ? xcd * (q + 1) : r * (q + 1) + (xcd - r) * q) + off; }
        const int nig = WGM * nN, gid = wgid / nig, fm = gid * WGM, gsz = (nM - fm) < WGM ? (nM - fm) : WGM;
        u.pm = fm + ((wgid % nig) % gsz); u.pn = (wgid % nig) / gsz; return true;
    }
    __device__ __forceinline__ void a_ready(const Unit&) const {}
    __device__ __forceinline__ void done(const Unit&) const {}
};


struct EpiF32 {
    static constexpr bool PERM = false, AFTER_DRAIN = false;
    float* C; int ldc; const float* bias;
    __device__ __forceinline__ void operator()(const f32x4 (&acc)[2][2][4][2], const Unit& u, int wr, int wc, int fr, int fq) const {
        const int row0 = u.pm * BM + wr * 64 + fr, col0 = u.pn * BM + wc * 32 + 4 * fq;
        f32x4 bv[2][2];
#pragma unroll
        for (int bj = 0; bj < 2; ++bj)
#pragma unroll
            for (int n = 0; n < 2; ++n) bv[bj][n] = bias ? *(const f32x4*)(bias + col0 + bj * HALF + 16 * n) : (f32x4){0.f, 0.f, 0.f, 0.f};
#pragma unroll
        for (int ai = 0; ai < 2; ++ai)
#pragma unroll
            for (int m = 0; m < 4; ++m) { float* rowp = C + (size_t)(row0 + ai * HALF + m * 16) * ldc + col0;
#pragma unroll
                for (int bj = 0; bj < 2; ++bj)
#pragma unroll
                    for (int n = 0; n < 2; ++n) *(f32x4*)(rowp + bj * HALF + 16 * n) = acc[ai][bj][m][n] + bv[bj][n]; }
    }
};

struct EpiInProj {
    static constexpr bool PERM = false, AFTER_DRAIN = false;
    bf16_t* q; bf16_t* kv; bf16_t* zg; bf16_t* yc; const float* qg; const float* kg; const float* rope;
    __device__ __forceinline__ void operator()(const f32x4 (&acc)[2][2][4][2], const Unit& u, int wr, int wc, int fr, int fq) const {
        const int pn = u.pn, rowb = u.pm * BM + wr * 64 + fr;
        if (pn <= 2) {
            const bool isq = pn < 2, isv = (pn == 2 && wc >= 2), lat = (u.pm * BM) < ML;
            f32x4 gn[2][2];
#pragma unroll
            for (int bj = 0; bj < 2; ++bj)
#pragma unroll
                for (int n = 0; n < 2; ++n) gn[bj][n] = *(const f32x4*)((isq ? qg : kg) + 32 * bj + 16 * n + 4 * fq);
#pragma unroll
            for (int ai = 0; ai < 2; ++ai)
#pragma unroll
                for (int m = 0; m < 4; ++m) {
                    const int row = rowb + ai * HALF + m * 16;
                    f32x4 v[2][2];
#pragma unroll
                    for (int bj = 0; bj < 2; ++bj)
#pragma unroll
                        for (int n = 0; n < 2; ++n) v[bj][n] = acc[ai][bj][m][n];
                    if (!isv) {
                        float ss = 0.f;
#pragma unroll
                        for (int bj = 0; bj < 2; ++bj)
#pragma unroll
                            for (int n = 0; n < 2; ++n) ss += (v[bj][n][0] * v[bj][n][0] + v[bj][n][1] * v[bj][n][1]) + (v[bj][n][2] * v[bj][n][2] + v[bj][n][3] * v[bj][n][3]);
                        ss += __shfl_xor(ss, 16); ss += __shfl_xor(ss, 32);
                        const float rs = __builtin_amdgcn_rsqf(ss * (1.0f / 64.0f) + EPS);
#pragma unroll
                        for (int bj = 0; bj < 2; ++bj)
#pragma unroll
                            for (int n = 0; n < 2; ++n) v[bj][n] = v[bj][n] * rs * gn[bj][n];
                        if (lat) {
                            const int t = row & (SEQ - 1);
#pragma unroll
                            for (int bj = 0; bj < 2; ++bj) {
                                const int pos = bj ? (t & 63) : (t >> 6);
                                const float* rp = rope + (pos * 16 + 4 * fq) * 2;
                                const f32x4 cs01 = *(const f32x4*)rp, cs23 = *(const f32x4*)(rp + 4);
                                const float cs[4] = {cs01[0], cs01[2], cs23[0], cs23[2]}, sn[4] = {cs01[1], cs01[3], cs23[1], cs23[3]};
#pragma unroll
                                for (int e = 0; e < 4; ++e) { const float x1 = v[bj][0][e], x2 = v[bj][1][e]; v[bj][0][e] = x1 * cs[e] - x2 * sn[e]; v[bj][1][e] = x1 * sn[e] + x2 * cs[e]; }
                            }
                        }
                        if (isq) {
#pragma unroll
                            for (int bj = 0; bj < 2; ++bj)
#pragma unroll
                                for (int n = 0; n < 2; ++n) v[bj][n] = v[bj][n] * C2;
                        }
                    }
                    bf16_t* dst = isq ? q + (size_t)row * 512 + (pn * 4 + wc) * 64 : kv + (size_t)kvrow(row) * 256 + (wc >= 2 ? 128 + (wc - 2) * 64 : wc * 64);
#pragma unroll
                    for (int bj = 0; bj < 2; ++bj)
#pragma unroll
                        for (int n = 0; n < 2; ++n) { u32x2 w; w.x = pk2(v[bj][n][0], v[bj][n][1]); w.y = pk2(v[bj][n][2], v[bj][n][3]); *(u32x2*)(dst + 32 * bj + 16 * n + 4 * fq) = w; }
                }
        } else if (pn <= 4) {
#pragma unroll
            for (int ai = 0; ai < 2; ++ai)
#pragma unroll
                for (int m = 0; m < 4; ++m) { bf16_t* dst = zg + (size_t)(rowb + ai * HALF + m * 16) * 512 + (pn - 3) * 256 + wc * 32 + 4 * fq;
#pragma unroll
                    for (int bj = 0; bj < 2; ++bj)
#pragma unroll
                        for (int n = 0; n < 2; ++n) { const f32x4 a = acc[ai][bj][m][n]; u32x2 w; w.x = pk2(gelu_tanh(a[0]), gelu_tanh(a[1])); w.y = pk2(gelu_tanh(a[2]), gelu_tanh(a[3]));
                            *(u32x2*)(dst + bj * HALF + 16 * n) = w; } }
        } else {
#pragma unroll
            for (int ai = 0; ai < 2; ++ai)
#pragma unroll
                for (int m = 0; m < 4; ++m) { bf16_t* dst = yc + (size_t)(rowb + ai * HALF + m * 16) * 256 + (pn - 5) * 128 + wc * 32 + 4 * fq;
#pragma unroll
                    for (int n = 0; n < 2; ++n) { const f32x4 a = acc[ai][0][m][n], g = acc[ai][1][m][n]; u32x2 w;
                        w.x = pk2(a[0] * fast_sigmoid(g[0]), a[1] * fast_sigmoid(g[1])); w.y = pk2(a[2] * fast_sigmoid(g[2]), a[3] * fast_sigmoid(g[3]));
                        *(u32x2*)(dst + 16 * n) = w; } }
        }
    }
};
template <class Epi, class Sched, bool ALIGN_EPI = false, bool SP2 = false>
__device__ __forceinline__ void gemm_phase(PG8_LAS unsigned char* lds, const Gemm g, const Sched& S, const Epi& E) {
    const int tid = mk_tid(), wid = __builtin_amdgcn_readfirstlane(tid >> 6), lane = tid & 63, wr = wid >> 2, wc = wid & 3, fr = lane & 15, fq = lane >> 4;
    const int K = g.K, nt = K / BK;
    unsigned voffA[2], voffB[2];
#pragma unroll
    for (int i = 0; i < 2; ++i) { int R, C; stage_rc(tid * 16 + i * 8192, R, C); const int Rb = Epi::PERM ? ((R & ~31) + perm32(R & 31)) : R;
        voffA[i] = (unsigned)(R * K + C) * 2u; voffB[i] = (unsigned)(Rb * K + C) * 2u; }
    const size_t kstep = (size_t)(BK * 2);
    const size_t hstep = (size_t)HALF * K * 2;
    const size_t tstep = 2 * hstep;
    const unsigned ldsw = (unsigned)wid * 1024u;
    const int aoff = lds_byte(wr * 64 + fr, fq * 8), boff = lds_byte(wc * 32 + fr, fq * 8);
#define PG8_SA(b, h) (((b) * 2 + (h)) * HTB)
#define PG8_SB(b, h) ((4 + (b) * 2 + (h)) * HTB)
#define PG8_STAGE(bufoff, gbase, voff) do { _Pragma("unroll") for (int _i = 0; _i < 2; ++_i) \
        __builtin_amdgcn_global_load_lds((const unsigned*)((const char*)(gbase) + (voff)[_i]), (PG8_LAS unsigned*)(lds + (bufoff) + ldsw + _i * 8192), 16, 0, 0); } while (0)
#define PG8_LDA(dst, b, h) do { _Pragma("unroll") for (int m = 0; m < 4; ++m) _Pragma("unroll") for (int k = 0; k < 2; ++k) dst[m][k] = *(const PG8_LAS bf16x8*)(lds + PG8_SA(b, h) + aoff + m * 2048 + k * 1024); } while (0)
#define PG8_LDB(dst, b, h) do { _Pragma("unroll") for (int n = 0; n < 2; ++n) _Pragma("unroll") for (int k = 0; k < 2; ++k) dst[n][k] = *(const PG8_LAS bf16x8*)(lds + PG8_SB(b, h) + boff + n * 2048 + k * 1024); } while (0)
#define PG8_MMA(ai, bj, At, Bt) do { __builtin_amdgcn_s_setprio(1); _Pragma("unroll") for (int m = 0; m < 4; ++m) _Pragma("unroll") for (int n = 0; n < 2; ++n) _Pragma("unroll") for (int k = 0; k < 2; ++k) \
        acc[ai][bj][m][n] = __builtin_amdgcn_mfma_f32_16x16x32_bf16(Bt[n][k], At[m][k], acc[ai][bj][m][n], 0, 0, 0); __builtin_amdgcn_s_setprio(0); } while (0)
#define PG8_WAIT_V(n) asm volatile("s_waitcnt vmcnt(" #n ")" ::: "memory")
#define PG8_WAIT_L(n) asm volatile("s_waitcnt lgkmcnt(" #n ")" ::: "memory")
#define PG8_BAR __builtin_amdgcn_s_barrier()
#define PG8_SCHED __builtin_amdgcn_sched_barrier(0)
    Unit cur, nxt; int ui = 0;
    if (!S.next(0, cur)) return;
    f32x4 acc[2][2][4][2];
#pragma unroll
    for (int a = 0; a < 2; ++a)
#pragma unroll
        for (int b = 0; b < 2; ++b)
#pragma unroll
            for (int m = 0; m < 4; ++m)
#pragma unroll
                for (int n = 0; n < 2; ++n) acc[a][b][m][n] = (f32x4){0.f, 0.f, 0.f, 0.f};
    bf16x8 At[4][2], B0[2][2], B1[2][2];
    const char* cA = (const char*)g.A + (size_t)cur.pm * tstep; const char* cB = (const char*)g.Bt + (size_t)cur.pn * tstep;
    S.a_ready(cur);
    if constexpr (SP2) {
        PG8_STAGE(PG8_SB(0, 0), cB, voffB); PG8_STAGE(PG8_SB(0, 1), cB + hstep, voffB); PG8_STAGE(PG8_SA(0, 0), cA, voffA); PG8_STAGE(PG8_SA(0, 1), cA + hstep, voffA);
        if (wr == 1) PG8_BAR;
        PG8_WAIT_V(2); PG8_BAR;
        PG8_STAGE(PG8_SB(1, 0), cB + kstep, voffB); PG8_STAGE(PG8_SA(1, 0), cA + kstep, voffA); PG8_STAGE(PG8_SB(1, 1), cB + hstep + kstep, voffB);
        PG8_WAIT_V(6); PG8_BAR;
    } else {
        PG8_STAGE(PG8_SB(0, 0), cB, voffB); PG8_STAGE(PG8_SA(0, 0), cA, voffA); PG8_STAGE(PG8_SB(0, 1), cB + hstep, voffB); PG8_STAGE(PG8_SA(0, 1), cA + hstep, voffA);
        if (wr == 1) PG8_BAR;
        PG8_WAIT_V(4); PG8_BAR;
        PG8_STAGE(PG8_SB(1, 0), cB + kstep, voffB); PG8_STAGE(PG8_SA(1, 0), cA + kstep, voffA); PG8_STAGE(PG8_SB(1, 1), cB + hstep + kstep, voffB);
        PG8_WAIT_V(6); PG8_BAR;
    }
    for (;;) {
        const bool has_next = S.next(ui + 1, nxt);
        const char* nA = has_next ? (const char*)g.A + (size_t)nxt.pm * tstep : cA; const char* nB = has_next ? (const char*)g.Bt + (size_t)nxt.pn * tstep : cB;
        for (int t = 0; t < nt; t += 2) {
            const bool last = (t == nt - 2);
            const char* a1 = cA + (size_t)(t + 1) * kstep;
            const char* a2 = last ? nA : cA + (size_t)(t + 2) * kstep; const char* b2 = last ? nB : cB + (size_t)(t + 2) * kstep;
            const char* a3 = a2 + kstep; const char* b3 = b2 + kstep;
            if (last && has_next) S.a_ready(nxt);
            if constexpr (SP2) {
            PG8_LDB(B0, 0, 0); PG8_LDB(B1, 0, 1); PG8_SCHED; PG8_LDA(At, 0, 0); PG8_STAGE(PG8_SA(1, 1), a1 + hstep, voffA);
            PG8_WAIT_V(8); PG8_WAIT_L(0); PG8_BAR; PG8_MMA(0, 0, At, B0); PG8_MMA(0, 1, At, B1); PG8_BAR; PG8_SCHED;
            PG8_LDA(At, 0, 1); PG8_STAGE(PG8_SB(0, 0), b2, voffB); PG8_STAGE(PG8_SB(0, 1), b2 + hstep, voffB); PG8_STAGE(PG8_SA(0, 0), a2, voffA);
            PG8_WAIT_V(8); PG8_WAIT_L(0); PG8_BAR; PG8_MMA(1, 0, At, B0); PG8_MMA(1, 1, At, B1); PG8_BAR; PG8_SCHED;
            PG8_LDB(B0, 1, 0); PG8_LDB(B1, 1, 1); PG8_SCHED; PG8_LDA(At, 1, 0); PG8_STAGE(PG8_SA(0, 1), a2 + hstep, voffA);
            PG8_WAIT_V(8); PG8_WAIT_L(0); PG8_BAR; PG8_MMA(0, 0, At, B0); PG8_MMA(0, 1, At, B1); PG8_BAR; PG8_SCHED;
            PG8_LDA(At, 1, 1); PG8_STAGE(PG8_SB(1, 0), b3, voffB); PG8_STAGE(PG8_SB(1, 1), b3 + hstep, voffB); PG8_STAGE(PG8_SA(1, 0), a3, voffA);
            PG8_WAIT_V(8); PG8_WAIT_L(0); PG8_BAR; PG8_MMA(1, 0, At, B0); PG8_MMA(1, 1, At, B1); PG8_BAR; PG8_SCHED;
            } else {
            PG8_LDB(B0, 0, 0); PG8_SCHED; PG8_LDA(At, 0, 0); PG8_STAGE(PG8_SA(1, 1), a1 + hstep, voffA);
            PG8_WAIT_L(8); PG8_BAR; PG8_WAIT_L(0); PG8_MMA(0, 0, At, B0); PG8_BAR; PG8_SCHED;
            PG8_LDB(B1, 0, 1); PG8_STAGE(PG8_SB(0, 0), b2, voffB);
            PG8_BAR; PG8_WAIT_L(0); PG8_MMA(0, 1, At, B1); PG8_BAR;
            PG8_LDA(At, 0, 1); PG8_STAGE(PG8_SA(0, 0), a2, voffA);
            PG8_BAR; PG8_WAIT_L(0); PG8_MMA(1, 0, At, B0); PG8_BAR; PG8_SCHED;
            PG8_STAGE(PG8_SB(0, 1), b2 + hstep, voffB);
            PG8_WAIT_V(6); PG8_BAR; PG8_MMA(1, 1, At, B1); PG8_BAR;
            PG8_LDB(B0, 1, 0); PG8_SCHED; PG8_LDA(At, 1, 0); PG8_STAGE(PG8_SA(0, 1), a2 + hstep, voffA);
            PG8_WAIT_L(8); PG8_BAR; PG8_WAIT_L(0); PG8_MMA(0, 0, At, B0); PG8_BAR; PG8_SCHED;
            PG8_LDB(B1, 1, 1); PG8_STAGE(PG8_SB(1, 0), b3, voffB);
            PG8_BAR; PG8_WAIT_L(0); PG8_MMA(0, 1, At, B1); PG8_BAR;
            PG8_LDA(At, 1, 1); PG8_STAGE(PG8_SA(1, 0), a3, voffA);
            PG8_BAR; PG8_WAIT_L(0); PG8_MMA(1, 0, At, B0); PG8_BAR; PG8_SCHED;
            PG8_STAGE(PG8_SB(1, 1), b3 + hstep, voffB);
            PG8_WAIT_V(6); PG8_BAR; PG8_MMA(1, 1, At, B1); PG8_BAR;
            }
        }
        if constexpr (ALIGN_EPI) { if (wr == 0) PG8_BAR; }
        if constexpr (!Epi::AFTER_DRAIN) { E(acc, cur, wr, wc, fr, fq); S.done(cur); }
        if (!has_next) break;
#pragma unroll
        for (int a = 0; a < 2; ++a)
#pragma unroll
            for (int b = 0; b < 2; ++b)
#pragma unroll
                for (int m = 0; m < 4; ++m)
#pragma unroll
                    for (int n = 0; n < 2; ++n) acc[a][b][m][n] = (f32x4){0.f, 0.f, 0.f, 0.f};
        cur = nxt; cA = nA; cB = nB; ++ui;
        if constexpr (ALIGN_EPI) { if (wr == 1) PG8_BAR; }
    }
    PG8_WAIT_V(0);
    if constexpr (!ALIGN_EPI) { if (wr == 0) PG8_BAR; }
    PG8_BAR;
    if constexpr (Epi::AFTER_DRAIN) { E.fused(acc, cur, wr, wc, fr, fq, lds, wid, lane); S.done(cur); }
#undef PG8_SA
#undef PG8_SB
#undef PG8_STAGE
#undef PG8_LDA
#undef PG8_LDB
#undef PG8_MMA
#undef PG8_WAIT_V
#undef PG8_WAIT_L
#undef PG8_BAR
#undef PG8_SCHED
}
}
namespace attn_body {
using bf16=__hip_bfloat16;
using bf16x8=__attribute__((ext_vector_type(8)))short;
using s16x4=__attribute__((ext_vector_type(4)))short;
using f32x16=__attribute__((ext_vector_type(16)))float;
using u32x4=__attribute__((ext_vector_type(4)))unsigned;
constexpr int D=64;
constexpr int DMQ=512, DMKV=256, DMO=1024;
constexpr int NW=8,QBLK=32,QB=QBLK*NW,KVBLK=64;
constexpr int ATTN_UNIT_ROWS=QB;
__device__ __forceinline__ int crow(int r,int hi){return (r&3)+8*(r>>2)+4*hi;}
#define SBAR() __builtin_amdgcn_sched_barrier(0)
constexpr int NSLOT=3, SLOTB=8192;
constexpr int LDS_K=0, LDS_V=NSLOT*SLOTB, LDS_WS=2*NSLOT*SLOTB, LDS_OST=LDS_WS+NW*64*4, LDS_BYTES=LDS_OST+NW*4096;
__device__ __forceinline__ void glds16(const void*gsrc,unsigned lds_dst){unsigned keep;
  asm volatile("s_mov_b32 %0, m0\n\ts_mov_b32 m0, %2\n\ts_nop 0\n\tglobal_load_lds_dwordx4 %1, off\n\ts_mov_b32 m0, %0":"=&s"(keep):"v"(gsrc),"s"(lds_dst):"memory");}
__device__ __forceinline__ float max3f(float a,float b,float c){float r;asm("v_max3_f32 %0, %1, %2, %3":"=v"(r):"v"(a),"v"(b),"v"(c));return r;}
__device__ __forceinline__ float max2f(float a,float b){float r;asm("v_max_f32_e32 %0, %1, %2":"=v"(r):"v"(a),"v"(b));return r;}
__device__ __forceinline__ float fadd_s(float a,float b){float r;asm("v_add_f32_e32 %0, %1, %2":"=v"(r):"v"(a),"v"(b));return r;}
__device__ __forceinline__ float fsub_s(float a,float b){float r;asm("v_sub_f32_e32 %0, %1, %2":"=v"(r):"v"(a),"v"(b));return r;}
typedef float f32x2_t __attribute__((ext_vector_type(2))); typedef __bf16 bf16x2_t __attribute__((ext_vector_type(2)));
__device__ __forceinline__ unsigned cvtpk_s(float lo,float hi){f32x2_t v={lo,hi};bf16x2_t b=__builtin_convertvector(v,bf16x2_t);return __builtin_bit_cast(unsigned,b);}
#define WAIT_BAR(N) asm volatile("s_waitcnt vmcnt(" #N ") lgkmcnt(0)\n\ts_barrier":::"memory")

__device__ __forceinline__ void qkt(f32x16&p0,f32x16&p1,const char*Kslot,const bf16x8*qr,const f32x16&negm,int r32,int hi){
  const char*kb=Kslot+hi*1024+r32*16;
  #pragma unroll
  for(int d0=0;d0<4;++d0){
    const bf16x8 b0=*reinterpret_cast<const bf16x8*>(kb+d0*2048);
    const bf16x8 b1=*reinterpret_cast<const bf16x8*>(kb+d0*2048+512);
    if(d0==0){p0=__builtin_amdgcn_mfma_f32_32x32x16_bf16(b0,qr[0],negm,0,0,0);p1=__builtin_amdgcn_mfma_f32_32x32x16_bf16(b1,qr[0],negm,0,0,0);}
    else{p0=__builtin_amdgcn_mfma_f32_32x32x16_bf16(b0,qr[d0],p0,0,0,0);p1=__builtin_amdgcn_mfma_f32_32x32x16_bf16(b1,qr[d0],p1,0,0,0);}}
}
typedef __attribute__((address_space(3))) const char* lds_cptr;
typedef short v4i16_t __attribute__((ext_vector_type(4)));
__device__ __forceinline__ void kload8(bf16x8*kf,lds_cptr kp){
  kf[0]=*(const __attribute__((address_space(3))) bf16x8*)(kp);      kf[1]=*(const __attribute__((address_space(3))) bf16x8*)(kp+512);
  kf[2]=*(const __attribute__((address_space(3))) bf16x8*)(kp+2048); kf[3]=*(const __attribute__((address_space(3))) bf16x8*)(kp+2560);
  kf[4]=*(const __attribute__((address_space(3))) bf16x8*)(kp+4096); kf[5]=*(const __attribute__((address_space(3))) bf16x8*)(kp+4608);
  kf[6]=*(const __attribute__((address_space(3))) bf16x8*)(kp+6144); kf[7]=*(const __attribute__((address_space(3))) bf16x8*)(kp+6656);
}
__device__ __forceinline__ void kload2(bf16x8*kf,lds_cptr kp,int j){ kf[2*j]=*(const __attribute__((address_space(3))) bf16x8*)(kp+j*2048); kf[2*j+1]=*(const __attribute__((address_space(3))) bf16x8*)(kp+j*2048+512); }
__device__ __forceinline__ s16x4 vtr(lds_cptr p){ return __builtin_bit_cast(s16x4,__builtin_amdgcn_ds_read_tr16_b64_v4i16((__attribute__((address_space(3))) v4i16_t*)p)); }
__device__ __forceinline__ float rowmax(const f32x16&p0,const f32x16&p1){
  float a=max3f(p0[0],p0[1],p1[0]),b=max3f(p0[2],p0[3],p1[1]);a=max3f(a,p1[2],p1[3]);
  #pragma unroll
  for(int r=4;r<16;r+=4){a=max3f(a,p0[r],p0[r+1]);b=max3f(b,p0[r+2],p0[r+3]);a=max3f(a,p1[r],p1[r+1]);b=max3f(b,p1[r+2],p1[r+3]);}
  const float m=max2f(a,b);
  auto rr=__builtin_amdgcn_permlane32_swap(__float_as_uint(m),__float_as_uint(m),false,false);
  return max2f(__uint_as_float(rr[0]),__uint_as_float(rr[1]));
}
__device__ __forceinline__ void pv(f32x16*o,int vb,bf16x8 pa0,bf16x8 pa1,bf16x8 pa2,bf16x8 pa3){
  #pragma unroll
  for(int d0=0;d0<2;++d0){s16x4 lo[4],hi[4];
    #pragma unroll
    for(int ks=0;ks<4;++ks){
      asm volatile("ds_read_b64_tr_b16 %0,%1 offset:%c2":"=&v"(lo[ks]):"v"(vb),"i"(d0*4096+ks*1024):"memory");
      asm volatile("ds_read_b64_tr_b16 %0,%1 offset:%c2":"=&v"(hi[ks]):"v"(vb),"i"(d0*4096+ks*1024+512):"memory");}
    asm volatile("s_waitcnt lgkmcnt(0)":::"memory");SBAR();
    #define PK(k) (bf16x8){lo[k][0],lo[k][1],lo[k][2],lo[k][3],hi[k][0],hi[k][1],hi[k][2],hi[k][3]}
    o[d0]=__builtin_amdgcn_mfma_f32_32x32x16_bf16(pa0,PK(0),o[d0],0,0,0);
    o[d0]=__builtin_amdgcn_mfma_f32_32x32x16_bf16(pa1,PK(1),o[d0],0,0,0);
    o[d0]=__builtin_amdgcn_mfma_f32_32x32x16_bf16(pa2,PK(2),o[d0],0,0,0);
    o[d0]=__builtin_amdgcn_mfma_f32_32x32x16_bf16(pa3,PK(3),o[d0],0,0,0);
    #undef PK
  }
}

#ifndef ATTN_STORE16
#define ATTN_STORE16(p,v) (*(u32x4*)(p)=(v))
#endif
template<int THRL> __device__ __forceinline__ void attn_unit(const bf16*Q0,const bf16*__restrict__ K0,const bf16*__restrict__ V0,bf16*O0,const int NT,char*shm){
  const int tid=mk_tid(),lane=tid&63,r32=lane&31,hi=lane>>5; const int wid=__builtin_amdgcn_readfirstlane(tid>>6);
  const bf16*Qw=Q0+(long)(wid*QBLK)*DMQ;
  const bf16*Kh=K0,*Vh=V0;
  const unsigned lds0=(unsigned)(uintptr_t)shm;
  float*wsf=(float*)(shm+LDS_WS)+wid*64;
  const bf16*ksrc=Kh+(long)lane*DMKV+wid*8;
  const bf16*vsrc=Vh+(long)(16*(wid&3)+(lane>>2))*DMKV+(wid>>2)*32+(lane&3)*8;
  const unsigned kdst=lds0+LDS_K+wid*1024, vdst=lds0+LDS_V+wid*1024;
  #define DMA_K(t,slot) glds16(ksrc+(long)(t)*KVBLK*DMKV,(unsigned)__builtin_amdgcn_readfirstlane(kdst+(slot)))
  #define DMA_V(t,slot) glds16(vsrc+(long)(t)*KVBLK*DMKV,(unsigned)__builtin_amdgcn_readfirstlane(vdst+(slot)))
  const int vb0=(int)(lds0+LDS_V)+((lane>>4)&1)*32+(lane&3)*8+(4*hi+((lane&15)>>2))*64;
  const char*Kbase=shm+LDS_K; bf16x8 kf[8];
  const lds_cptr shm3=(lds_cptr)shm; const lds_cptr kp0=shm3+LDS_K+hi*1024+r32*16; const lds_cptr vp0=shm3+LDS_V+((lane>>4)&1)*32+(lane&3)*8+(4*hi+((lane&15)>>2))*64;
  DMA_K(0,0);DMA_V(0,0);DMA_K(1,SLOTB);
  bf16x8 qr[4];
  #pragma unroll
  for(int d0=0;d0<4;++d0)qr[d0]=*reinterpret_cast<const bf16x8*>(&Qw[(long)r32*DMQ+d0*16+hi*8]);
  float mhat=0.f,l_reg=0.f;f32x16 o[2];o[0]=f32x16{};o[1]=f32x16{};f32x16 negm=f32x16{};asm volatile("":"+v"(negm));
  #define CMASK(P0,P1,t) do{}while(0)
  bool resc=false;
  #define START(P0,P1) do{ const float rm=rowmax(P0,P1); resc=false; \
    { const float dl=rm; mhat=fadd_s(mhat,dl); \
      _Pragma("unroll") for(int r=0;r<16;++r){P0[r]=fsub_s(P0[r],dl);P1[r]=fsub_s(P1[r],dl);} \
      _Pragma("unroll") for(int r=0;r<16;++r)negm[r]=-mhat; asm volatile("":"+v"(negm)); } \
    _Pragma("unroll") for(int r=0;r<16;++r)P0[r]=__builtin_amdgcn_exp2f(P0[r]); }while(0)
  #define RESC() do{ if(resc){ asm volatile("s_waitcnt lgkmcnt(0)":::"memory"); \
      _Pragma("unroll") for(int d_=0;d_<2;++d_) _Pragma("unroll") for(int r=0;r<16;++r)o[d_][r]*=wsf[crow(r,hi)]; } }while(0)
  f32x16 pA0,pA1,pB0,pB1;
  int sl_prev=0,sl_cur=0,sl_next=SLOTB;
  #define ROT() do{sl_prev=sl_cur;sl_cur=sl_next;sl_next=(sl_next==(NSLOT-1)*SLOTB)?0:sl_next+SLOTB;}while(0)
  DMA_K(2,2*SLOTB);
  WAIT_BAR(3);
  qkt(pA0,pA1,Kbase,qr,negm,r32,hi);asm volatile("s_nop 15\n\ts_nop 7":"+v"(pA0),"+v"(pA1));CMASK(pA0,pA1,0);
  START(pA0,pA1);
  _Pragma("unroll") for(int r=0;r<16;++r)pA1[r]=__builtin_amdgcn_exp2f(pA1[r]);
  WAIT_BAR(0);
  DMA_K(3,0);DMA_V(1,SLOTB);
  ROT();
  kload8(kf,kp0+sl_cur);
  WAIT_BAR(2);
  s16x4 vlo[8],vhi[8]; u32x4 pw0,pw1,pw2,pw3;
  #define PKW(P,B) cvtpk_s(P[B],P[B+1])
  #define PAF(k) __builtin_bit_cast(bf16x8,pw##k)
  #define VFR(i) (bf16x8){vlo[i][0],vlo[i][1],vlo[i][2],vlo[i][3],vhi[i][0],vhi[i][1],vhi[i][2],vhi[i][3]}
  #define PIN(x) asm volatile("":"+v"(x))
  #define MX3(a,b,c) __builtin_fmaxf(__builtin_fmaxf((a),(b)),(c))
  #define GAPA(MF,A0,A1,A2,A3,W0,W1,PW) do{ MF; sacc+=A0; sacc+=A1; sacc+=A2; sacc+=A3; PIN(sacc); W0; W1; PIN(PW); SBAR(); }while(0)
  #define EX(v) __builtin_amdgcn_exp2f(v)
  #define GAPB(MF,X,B) do{ MF; X[B]=EX(X[B]); X[B+1]=EX(X[B+1]); X[B+2]=EX(X[B+2]); X[B+3]=EX(X[B+3]); PIN(X); SBAR(); }while(0)
  #define VRD(i) do{ vlo[i]=vtr(vp_+(((i)>>2)*4096+((i)&3)*1024)); vhi[i]=vtr(vp_+(((i)>>2)*4096+((i)&3)*1024+512)); }while(0)
  #define KRD(G,j) do{ if(G){ kload2(kf,kp0+sl_next,j); SBAR(); } }while(0)
  #define STEP(C0,C1,P0,P1,t,GK,GV,GL) do{ SBAR(); \
    const lds_cptr vp_=vp0+sl_prev; \
    VRD(0); SBAR(); float sacc=(P0[0]+P0[1]); \
    GAPA(C0=__builtin_amdgcn_mfma_f32_32x32x16_bf16(kf[0],qr[0],negm,0,0,0), P0[2],P0[3],P0[4],P0[5],     pw0[0]=PKW(P0,0), pw0[1]=PKW(P0,2), pw0); \
    VRD(4); SBAR(); GAPA(C1=__builtin_amdgcn_mfma_f32_32x32x16_bf16(kf[1],qr[0],negm,0,0,0), P0[6],P0[7],P0[8],P0[9],     pw0[2]=PKW(P0,4), pw0[3]=PKW(P0,6), pw0); \
    VRD(1); SBAR(); GAPA(C0=__builtin_amdgcn_mfma_f32_32x32x16_bf16(kf[2],qr[1],C0,0,0,0),   P0[10],P0[11],P0[12],P0[13], pw1[0]=PKW(P0,8), pw1[1]=PKW(P0,10), pw1); \
    VRD(5); SBAR(); GAPA(C1=__builtin_amdgcn_mfma_f32_32x32x16_bf16(kf[3],qr[1],C1,0,0,0),   P0[14],P0[15],P1[0],P1[1],   pw1[2]=PKW(P0,12),pw1[3]=PKW(P0,14), pw1); \
    VRD(2); SBAR(); GAPA(C0=__builtin_amdgcn_mfma_f32_32x32x16_bf16(kf[4],qr[2],C0,0,0,0),   P1[2],P1[3],P1[4],P1[5],     pw2[0]=PKW(P1,0), pw2[1]=PKW(P1,2), pw2); \
    VRD(6); SBAR(); GAPA(C1=__builtin_amdgcn_mfma_f32_32x32x16_bf16(kf[5],qr[2],C1,0,0,0),   P1[6],P1[7],P1[8],P1[9],     pw2[2]=PKW(P1,4), pw2[3]=PKW(P1,6), pw2); \
    VRD(3); SBAR(); GAPA(C0=__builtin_amdgcn_mfma_f32_32x32x16_bf16(kf[6],qr[3],C0,0,0,0),   P1[10],P1[11],P1[12],P1[13], pw3[0]=PKW(P1,8), pw3[1]=PKW(P1,10), pw3); \
    VRD(7); SBAR(); GAPA(C1=__builtin_amdgcn_mfma_f32_32x32x16_bf16(kf[7],qr[3],C1,0,0,0),   P1[14],P1[15],0.f,0.f,       pw3[2]=PKW(P1,12),pw3[3]=PKW(P1,14), pw3); \
    l_reg+=sacc; \
    if(GK){DMA_K((t)+3,sl_cur);} if(GV){DMA_V((t)+1,sl_next);} \
    CMASK(C0,C1,t); \
    { float a=MX3(C0[0],C0[1],C1[0]),b=MX3(C0[2],C0[3],C1[1]); a=MX3(a,C1[2],C1[3]); \
      _Pragma("unroll") for(int r=4;r<16;r+=4){a=MX3(a,C0[r],C0[r+1]);b=MX3(b,C0[r+2],C0[r+3]);a=MX3(a,C1[r],C1[r+1]);b=MX3(b,C1[r+2],C1[r+3]);} \
      float rm=__builtin_fmaxf(a,b); { auto rr=__builtin_amdgcn_permlane32_swap(__float_as_uint(rm),__float_as_uint(rm),false,false); rm=__builtin_fmaxf(__uint_as_float(rr[0]),__uint_as_float(rr[1])); } \
      resc=false; \
      if(__builtin_expect(__any(rm>(float)THRL),0)){ const float dl=__builtin_fmaxf(rm,0.f); mhat+=dl; \
        _Pragma("unroll") for(int r=0;r<16;++r){C0[r]-=dl;C1[r]-=dl;} \
        _Pragma("unroll") for(int r=0;r<16;++r)negm[r]=-mhat; asm volatile("":"+v"(negm)); \
        const float f=__builtin_amdgcn_exp2f(-dl); l_reg*=f; if(hi==0)wsf[r32]=f; resc=true; } } \
    SBAR(); \
    GAPB(o[0]=__builtin_amdgcn_mfma_f32_32x32x16_bf16(PAF(0),VFR(0),o[0],0,0,0), C0,0); \
    GAPB(o[1]=__builtin_amdgcn_mfma_f32_32x32x16_bf16(PAF(0),VFR(4),o[1],0,0,0), C0,4); \
    KRD(GL,0); GAPB(o[0]=__builtin_amdgcn_mfma_f32_32x32x16_bf16(PAF(1),VFR(1),o[0],0,0,0), C0,8); \
    KRD(GL,1); GAPB(o[1]=__builtin_amdgcn_mfma_f32_32x32x16_bf16(PAF(1),VFR(5),o[1],0,0,0), C0,12); \
    KRD(GL,2); GAPB(o[0]=__builtin_amdgcn_mfma_f32_32x32x16_bf16(PAF(2),VFR(2),o[0],0,0,0), C1,0); \
    KRD(GL,3); GAPB(o[1]=__builtin_amdgcn_mfma_f32_32x32x16_bf16(PAF(2),VFR(6),o[1],0,0,0), C1,4); \
    GAPB(o[0]=__builtin_amdgcn_mfma_f32_32x32x16_bf16(PAF(3),VFR(3),o[0],0,0,0), C1,8); \
    GAPB(o[1]=__builtin_amdgcn_mfma_f32_32x32x16_bf16(PAF(3),VFR(7),o[1],0,0,0), C1,12); \
    }while(0)
  int t=1;
  #undef CMASK
  #define CMASK(P0,P1,t) do{}while(0)
  for(;t+5<NT;t+=2){
    STEP(pB0,pB1,pA0,pA1,t,true,true,true);     WAIT_BAR(2); RESC(); ROT();
    STEP(pA0,pA1,pB0,pB1,t+1,true,true,true);   WAIT_BAR(2); RESC(); ROT();
  }
  #undef CMASK
  #define CMASK(P0,P1,t) do{}while(0)
  #define ENDW(tt) do{ if((tt)+3<NT){WAIT_BAR(2);} else if((tt)+2<NT){WAIT_BAR(1);} else {WAIT_BAR(0);} }while(0)
  for(;t+1<NT;t+=2){
    STEP(pB0,pB1,pA0,pA1,t,(t+3<NT),(t+1<NT),(t+1<NT));       ENDW(t);   RESC(); ROT();
    STEP(pA0,pA1,pB0,pB1,t+1,(t+4<NT),(t+2<NT),(t+2<NT));     ENDW(t+1); RESC(); ROT();
  }
  STEP(pB0,pB1,pA0,pA1,NT-1,false,false,false); RESC();
  { float sacc=pB0[0]+pB0[1]; _Pragma("unroll") for(int r=2;r<16;++r)sacc+=pB0[r]; _Pragma("unroll") for(int r=0;r<16;++r)sacc+=pB1[r]; l_reg+=sacc;
    pw0=(u32x4){PKW(pB0,0),PKW(pB0,2),PKW(pB0,4),PKW(pB0,6)};pw1=(u32x4){PKW(pB0,8),PKW(pB0,10),PKW(pB0,12),PKW(pB0,14)};pw2=(u32x4){PKW(pB1,0),PKW(pB1,2),PKW(pB1,4),PKW(pB1,6)};pw3=(u32x4){PKW(pB1,8),PKW(pB1,10),PKW(pB1,12),PKW(pB1,14)};
    SBAR(); pv(o,vb0+sl_cur,PAF(0),PAF(1),PAF(2),PAF(3)); }
  #undef PKW
  #undef PAF
  #undef VFR
  #undef PIN
  #undef MX3
  #undef GAPA
  #undef GAPB
  #undef EX
  #undef VRD
  #undef KRD
  #undef STEP
  #undef ENDW
  {auto rr=__builtin_amdgcn_permlane32_swap(__float_as_uint(l_reg),__float_as_uint(l_reg),false,false);l_reg=__uint_as_float(rr[0])+__uint_as_float(rr[1]);}
  if(hi==0)wsf[32+r32]=l_reg;asm volatile("s_waitcnt lgkmcnt(0)":::"memory");
  float rli[16];
  #pragma unroll
  for(int r=0;r<16;++r)rli[r]=__builtin_amdgcn_rcpf(wsf[32+crow(r,hi)]);
  bf16*Ow=O0+(long)(wid*QBLK)*DMO;
  { bf16*stg=(bf16*)(shm+LDS_OST)+wid*2048;
    #pragma unroll
    for(int r=0;r<16;++r){const int orow=crow(r,hi);
      #pragma unroll
      for(int d0=0;d0<2;++d0)stg[orow*64+d0*32+r32]=__float2bfloat16(o[d0][r]*rli[r]);}
    asm volatile("s_waitcnt lgkmcnt(0)":::"memory");
    #pragma unroll
    for(int i=0;i<4;++i){const int row=i*8+(lane>>3),ch=lane&7; const u32x4 v=*(const u32x4*)(stg+row*64+ch*8); ATTN_STORE16(Ow+(long)row*DMO+ch*8,v);} }
  asm volatile("s_waitcnt lgkmcnt(0)\n\ts_barrier":::"memory");
  #undef DMA_K
  #undef DMA_V
  #undef CMASK
  #undef START
  #undef RESC
  #undef ROT
}
constexpr int ATTN_LDS_BYTES=LDS_BYTES;
#undef SBAR
#undef WAIT_BAR
}
#define XB_TMO      128
#define XB_XCNT(j)  (256  + 64 * (j))
#define XB_XSUB(j)  (1280 + 64 * (j))
#define XB_XGEN(j)  (2304 + 64 * (j))
#define XB_TOP      3328
#define XB_TOPGEN   3392
#define XCD_BAR_WORDS 3456
#define XB_SPIN_CAP (1u << 18)
__device__ __forceinline__ unsigned xb_ld(unsigned* p)              { return __hip_atomic_load(p, __ATOMIC_RELAXED, __HIP_MEMORY_SCOPE_AGENT); }
__device__ __forceinline__ unsigned xb_add(unsigned* p, unsigned v) { return __hip_atomic_fetch_add(p, v, __ATOMIC_RELAXED, __HIP_MEMORY_SCOPE_AGENT); }
__device__ __forceinline__ unsigned xb_xcc_id() { return (unsigned)__builtin_amdgcn_s_getreg((3 << 11) | 20) & 0xFu; }
#define XB_SPIN(cond, bar) do { unsigned _sp = 0; while (cond) { __builtin_amdgcn_s_sleep(1); \
    if ((++_sp & 255u) == 0u) { if (xb_ld(&(bar)[XB_TMO])) break; if (_sp > XB_SPIN_CAP) { atomicAdd(&(bar)[XB_TMO], 1u); break; } } } } while (0)

struct XcdBarrier {
    unsigned* bar; unsigned x;
    volatile LAS unsigned* st;
};

__device__ __forceinline__ XcdBarrier xcd_barrier_post(unsigned* bar, volatile LAS unsigned* st) {
    XcdBarrier b; b.bar = bar; b.x = xb_xcc_id(); b.st = st;
    if (threadIdx.x == 0) (void)xb_add(&bar[XB_XCNT(b.x)], 1u);
    return b;
}
__device__ __forceinline__ void xcd_barrier_complete(unsigned* bar, unsigned x, unsigned& nloc, unsigned& nx) {
    const unsigned G = gridDim.x * gridDim.y * gridDim.z;
    unsigned sum, cnt, mine, sp = 0u;
    for (;;) {
        sum = 0u; cnt = 0u; mine = 0u;
#pragma unroll
        for (unsigned j = 0; j < 16; ++j) { const unsigned c = xb_ld(&bar[XB_XCNT(j)]); sum += c; cnt += (c > 0u) ? 1u : 0u; mine = (j == x) ? c : mine; }
        if (sum == G) break;
        __builtin_amdgcn_s_sleep(1);
        if ((++sp & 255u) == 0u) { if (xb_ld(&bar[XB_TMO])) break; if (sp > XB_SPIN_CAP) { atomicAdd(&bar[XB_TMO], 1u); break; } }
    }
    nloc = mine > 0u ? mine : 1u; nx = cnt > 0u ? cnt : 1u;
}

__device__ __forceinline__ void xcd_barrier(const XcdBarrier& b) {
    asm volatile("s_waitcnt vmcnt(0)" ::: "memory");
    __syncthreads();
    if (threadIdx.x == 0) {
        unsigned* bar = b.bar;
        __builtin_amdgcn_s_waitcnt(0);
        unsigned nloc = b.st[0], nx = b.st[1];
        if (nloc == 0u) { xcd_barrier_complete(bar, b.x, nloc, nx); b.st[0] = nloc; b.st[1] = nx; }
        const unsigned old = xb_add(&bar[XB_XSUB(b.x)], 1u);
        const unsigned gen = old / nloc;
        if (old + 1u == (gen + 1u) * nloc) {
            __builtin_amdgcn_fence(__ATOMIC_RELEASE, "agent");
            asm volatile("s_waitcnt vmcnt(0)" ::: "memory");
            const unsigned og = xb_add(&bar[XB_TOP], 1u);
            const unsigned tg = og / nx;
            if (og + 1u == (tg + 1u) * nx) xb_add(&bar[XB_TOPGEN], 1u);
            else XB_SPIN(xb_ld(&bar[XB_TOPGEN]) == tg, bar);
            __builtin_amdgcn_fence(__ATOMIC_ACQUIRE, "agent");
            xb_add(&bar[XB_XGEN(b.x)], 1u);
            asm volatile("s_waitcnt vmcnt(0)" ::: "memory");
        } else {
            XB_SPIN(xb_ld(&bar[XB_XGEN(b.x)]) == gen, bar);
            __builtin_amdgcn_fence(__ATOMIC_ACQUIRE, "agent");
            asm volatile("s_waitcnt vmcnt(0)" ::: "memory");
        }
    }
    __syncthreads();
}
constexpr size_t MiB = 1u << 20;
constexpr size_t WS_CTL = 0, CTL_ZERO_BYTES = 1 * MiB;
constexpr size_t WS_MOD = 1 * MiB, WS_ROPE = 1 * MiB + 256 * 1024, WS_BOUT = 1 * MiB + 512 * 1024;
constexpr size_t WS_WIN_T = 2 * MiB, WS_WOUT_T = 9 * MiB, WS_WS_T = 13 * MiB, WS_GWS = 21 * MiB, WS_XC1 = 22 * MiB, WS_XC2 = 26 * MiB;
constexpr size_t WS_U8 = 32 * MiB, WS_V8 = 64 * MiB, WS_H = 96 * MiB, WS_Q = 162 * MiB, WS_KV = 195 * MiB, WS_ZG = 212 * MiB, WS_YC = 245 * MiB, WS_MIX = 262 * MiB, WS_Y = 328 * MiB;
constexpr size_t WS_S = 162 * MiB;
constexpr size_t WS_END = 460 * MiB;
static_assert(WS_S + (size_t)MT * 2048 * 4 <= WS_END && WS_Y + (size_t)MT * 1024 * 4 <= WS_END && WS_H + (size_t)MT * 1024 * 2 <= WS_Q && WS_MIX + (size_t)MT * 1024 * 2 <= WS_Y, "d_ws map");
constexpr int CW_BAR = 4096;
constexpr int RING_BYTES = 131072, MISC_OFF = 143360, LDS_BYTES = 147456;
constexpr int N_PHASES = 14;

#define XB_SPIN_CAP_OVERRIDE (1u << 22)

struct Params { const float* in[28]; float* out; unsigned char* ws; int ph_lo, ph_hi; };

struct Frame { LAS unsigned char* lds; int tid, lane, wave, vcu, G; };

__host__ __device__ __forceinline__ int inproj_phys(int L) {
    if (L < 512) { const int hq = L >> 6, d = L & 63; return (hq >> 2) * 256 + (d >> 5) * 128 + (hq & 3) * 32 + (d & 31); }
    if (L < 768) { const int hh = (L - 512) >> 6, d = L & 63; return 512 + (d >> 5) * 128 + hh * 32 + (d & 31); }
    if (L < 1280) return L;
    const int isg = (L >= 1536), ch = L - 1280 - isg * 256; return (5 + (ch >> 7)) * 256 + isg * 128 + (ch & 127);
}
__device__ __forceinline__ void p0_transpose_item(const float* W, int K, int N, bf16_t* WT, int k0, int n0, int prow0, LAS float* scr, int lane) {
#pragma unroll 8
    for (int i = 0; i < 32; ++i) { const int kk = 2 * i + (lane >> 5); scr[kk * 33 + (lane & 31)] = W[(size_t)(k0 + kk) * N + n0 + (lane & 31)]; }
    asm volatile("s_waitcnt lgkmcnt(0)" ::: "memory");
    const int c = lane & 7;
#pragma unroll
    for (int j = 0; j < 4; ++j) { const int n = (lane >> 3) + 8 * j; const LAS float* s = scr + (8 * c) * 33 + n;
        u32x4 o; o.x = pk2(s[0 * 33], s[1 * 33]); o.y = pk2(s[2 * 33], s[3 * 33]); o.z = pk2(s[4 * 33], s[5 * 33]); o.w = pk2(s[6 * 33], s[7 * 33]);
        *(u32x4*)(WT + (size_t)(prow0 + n) * K + k0 + 8 * c) = o; }
    asm volatile("s_waitcnt lgkmcnt(0)" ::: "memory");
}

__device__ __forceinline__ void p0_mod_item(const Frame& F, int item, const float* c, const float* cctx, const float* w_mod, const float* b_mod, float* mod) {
    LAS float* sc = (LAS float*)F.lds;
    LAS float* red = (LAS float*)(F.lds + 20480);
    const int l = item / 96, cg = item % 96;
    __syncthreads();
    for (int i = F.tid; i < 5 * 1024; i += NTHREADS) { const int r = i >> 10, k = i & 1023; const float v = r < 4 ? c[r * 1024 + k] : cctx[k]; sc[i] = v * fast_sigmoid(v); }
    __syncthreads();
    const int c4 = (F.lane & 15) * 4, ks = F.lane >> 4;
    float acc[5][4];
#pragma unroll
    for (int r = 0; r < 5; ++r)
#pragma unroll
        for (int e = 0; e < 4; ++e) acc[r][e] = 0.f;
    const float* wp = w_mod + (size_t)l * 1024 * 6144 + cg * 64 + c4;
#pragma unroll 4
    for (int i = 0; i < 32; ++i) {
        const int k = F.wave * 128 + 4 * i + ks;
        const f32x4 w = *(const f32x4*)(wp + (size_t)k * 6144);
#pragma unroll
        for (int r = 0; r < 5; ++r) { const float s = sc[r * 1024 + k]; acc[r][0] += s * w[0]; acc[r][1] += s * w[1]; acc[r][2] += s * w[2]; acc[r][3] += s * w[3]; }
    }
#pragma unroll
    for (int r = 0; r < 5; ++r)
#pragma unroll
        for (int e = 0; e < 4; ++e) { float v = acc[r][e]; v += __shfl_xor(v, 16); v += __shfl_xor(v, 32); acc[r][e] = v; }
    if (ks == 0) {
#pragma unroll
        for (int r = 0; r < 5; ++r)
#pragma unroll
            for (int e = 0; e < 4; ++e) red[(F.wave * 5 + r) * 64 + c4 + e] = acc[r][e];
    }
    __syncthreads();
    if (F.tid < 320) { const int r = F.tid >> 6, cc = F.tid & 63; float v = b_mod[l * 6144 + cg * 64 + cc];
#pragma unroll
        for (int w = 0; w < 8; ++w) v += red[(w * 5 + r) * 64 + cc];
        mod[(size_t)(l * 5 + r) * 6144 + cg * 64 + cc] = v; }
}

__device__ __forceinline__ void p0_ws_item(const Frame& F, int item, const float* w_q, const float* sk, bf16_t* Ws_t) {
    LAS float* sks = (LAS float*)F.lds;
    LAS float* wqs = (LAS float*)(F.lds + 128 * 132 * 4);
    const int l = item >> 8, hp = (item >> 4) & 15, j0 = (item & 15) * 64;
    __syncthreads();
    const float* skp = sk + ((size_t)l * 16 + hp) * 128 * 128;
    for (int i = F.tid; i < 4096; i += NTHREADS) { const int k = i >> 5, d4 = (i & 31) * 4; *(LAS f32x4*)(sks + k * 132 + d4) = *(const f32x4*)(skp + k * 128 + d4); }
    for (int i = F.tid; i < 2048; i += NTHREADS) { const int j = i >> 5, d4 = (i & 31) * 4; *(LAS f32x4*)(wqs + j * 128 + d4) = *(const f32x4*)(w_q + ((size_t)l * 1024 + j0 + j) * 2048 + hp * 128 + d4); }
    __syncthreads();
    const int k = F.tid & 127, jg = F.tid >> 7;
    float acc[16];
#pragma unroll
    for (int i = 0; i < 16; ++i) acc[i] = 0.f;
    for (int d4 = 0; d4 < 128; d4 += 4) {
        const f32x4 a = *(const LAS f32x4*)(sks + k * 132 + d4);
#pragma unroll
        for (int jj = 0; jj < 16; ++jj) { const f32x4 b = *(const LAS f32x4*)(wqs + (jg * 16 + jj) * 128 + d4); acc[jj] += (a[0] * b[0] + a[1] * b[1]) + (a[2] * b[2] + a[3] * b[3]); }
    }
    bf16_t* dst = Ws_t + ((size_t)l * 2048 + hp * 128 + k) * 1024 + j0 + jg * 16;
    u32x4 o0, o1;
    o0.x = pk2(acc[0], acc[1]); o0.y = pk2(acc[2], acc[3]); o0.z = pk2(acc[4], acc[5]); o0.w = pk2(acc[6], acc[7]);
    o1.x = pk2(acc[8], acc[9]); o1.y = pk2(acc[10], acc[11]); o1.z = pk2(acc[12], acc[13]); o1.w = pk2(acc[14], acc[15]);
    *(u32x4*)dst = o0; *(u32x4*)(dst + 8) = o1;
}

__device__ __forceinline__ void p0_wc_item(const Frame& F, int item, const float* w_pw, const float* b_pw, const float* w_out, bf16_t* Wout_t, float* bout) {
    LAS float* wos = (LAS float*)F.lds;
    LAS float* wps = (LAS float*)(F.lds + 65536);
    const int l = item >> 6, nb = (item >> 2) & 15, kb = item & 3, n0 = nb * 64, kk0 = kb * 64;
    __syncthreads();
    for (int i = F.tid; i < 4096; i += NTHREADS) { const int j = i >> 4, n4 = (i & 15) * 4; *(LAS f32x4*)(wos + j * 64 + n4) = *(const f32x4*)(w_out + ((size_t)l * 1024 + 768 + j) * 1024 + n0 + n4); }
    for (int i = F.tid; i < 4096; i += NTHREADS) { const int kk = i >> 6, j4 = (i & 63) * 4; *(LAS f32x4*)(wps + kk * 256 + j4) = *(const f32x4*)(w_pw + ((size_t)l * 256 + kk0 + kk) * 256 + j4); }
    __syncthreads();
    const int n = F.tid & 63, kg = F.tid >> 6;
    float acc[8];
#pragma unroll
    for (int i = 0; i < 8; ++i) acc[i] = 0.f;
    for (int j4 = 0; j4 < 256; j4 += 4) {
        const float a0 = wos[(j4 + 0) * 64 + n], a1 = wos[(j4 + 1) * 64 + n], a2 = wos[(j4 + 2) * 64 + n], a3 = wos[(j4 + 3) * 64 + n];
#pragma unroll
        for (int i = 0; i < 8; ++i) { const f32x4 b = *(const LAS f32x4*)(wps + (kg * 8 + i) * 256 + j4); acc[i] += (a0 * b[0] + a1 * b[1]) + (a2 * b[2] + a3 * b[3]); }
    }
    u32x4 o; o.x = pk2(acc[0], acc[1]); o.y = pk2(acc[2], acc[3]); o.z = pk2(acc[4], acc[5]); o.w = pk2(acc[6], acc[7]);
    *(u32x4*)(Wout_t + ((size_t)l * 1024 + n0 + n) * 1024 + 768 + kk0 + kg * 8) = o;
    if (kb == 0 && kg == 0) { float b = 0.f; for (int j = 0; j < 256; ++j) b += b_pw[l * 256 + j] * wos[j * 64 + n]; bout[l * 1024 + n0 + n] = b; }
}

__device__ __forceinline__ void lnmod_row(const float* xp, const float* mp_shift, const float* mp_scale, bf16_t* hrow, int lane) {
    f32x4 v[4]; float s = 0.f;
#pragma unroll
    for (int j = 0; j < 4; ++j) { v[j] = *(const f32x4*)(xp + j * 256 + lane * 4); s += (v[j][0] + v[j][1]) + (v[j][2] + v[j][3]); }
    const float mu = wave_sum(s) * (1.0f / 1024.0f); float q = 0.f;
#pragma unroll
    for (int j = 0; j < 4; ++j) { v[j] = v[j] - mu; q += (v[j][0] * v[j][0] + v[j][1] * v[j][1]) + (v[j][2] * v[j][2] + v[j][3] * v[j][3]); }
    const float rstd = 1.0f / sqrtf(wave_sum(q) * (1.0f / 1024.0f) + EPS);
#pragma unroll
    for (int j = 0; j < 4; ++j) { const int col = j * 256 + lane * 4; const f32x4 sh = *(const f32x4*)(mp_shift + col), sc = *(const f32x4*)(mp_scale + col);
        const f32x4 o = v[j] * rstd * (sc + 1.0f) + sh; u32x2 w; w.x = pk2(o[0], o[1]); w.y = pk2(o[2], o[3]); *(u32x2*)(hrow + col) = w; }
}
__device__ __forceinline__ void gmlp_chunk(const Frame& F, int chunk, const bf16_t* zg, const float* ln_g, const float* ln_b, const bf16_t* gws, const float* b_s, bf16_t* mix) {
    constexpr int VP = 272;
    LAS unsigned char* vT = F.lds;
    const int row0 = chunk * 128;
    __syncthreads();
    {
        const f32x4 gg = *(const f32x4*)(ln_g + F.lane * 4), bb = *(const f32x4*)(ln_b + F.lane * 4);
        for (int r = 0; r < 16; ++r) {
            const int q = F.wave * 16 + r;
            const u32x2 w = *(const u32x2*)(zg + (size_t)(row0 + q) * 512 + 256 + F.lane * 4);
            float a = bflo(w.x), b = bfhi(w.x), c = bflo(w.y), d = bfhi(w.y);
            const float mu = wave_sum((a + b) + (c + d)) * (1.0f / 256.0f);
            a -= mu; b -= mu; c -= mu; d -= mu;
            const float rstd = 1.0f / sqrtf(wave_sum((a * a + b * b) + (c * c + d * d)) * (1.0f / 256.0f) + EPS);
            LAS unsigned short* dst = (LAS unsigned short*)(vT + (F.lane * 4) * VP + q * 2);
            dst[0] = (unsigned short)f2bf(a * rstd * gg[0] + bb[0]);
            dst[VP / 2] = (unsigned short)f2bf(b * rstd * gg[1] + bb[1]);
            dst[VP] = (unsigned short)f2bf(c * rstd * gg[2] + bb[2]);
            dst[VP / 2 * 3] = (unsigned short)f2bf(d * rstd * gg[3] + bb[3]);
        }
    }
    __syncthreads();
    const int g = F.wave >> 1, ph = F.wave & 1, fr = F.lane & 15, fq = F.lane >> 4;
    f32x4 acc[4][4];
#pragma unroll
    for (int ct = 0; ct < 4; ++ct)
#pragma unroll
        for (int pt = 0; pt < 4; ++pt) acc[ct][pt] = (f32x4){0.f, 0.f, 0.f, 0.f};
#pragma unroll
    for (int ks = 0; ks < 4; ++ks) {
        bf16x8 af[4], bfr[4];
#pragma unroll
        for (int ct = 0; ct < 4; ++ct) af[ct] = *(const LAS bf16x8*)(vT + (g * 64 + ct * 16 + fr) * VP + (ks * 32 + fq * 8) * 2);
#pragma unroll
        for (int pt = 0; pt < 4; ++pt) bfr[pt] = *(const bf16x8*)(gws + ((size_t)(g * 128 + ph * 64 + pt * 16 + fr)) * 128 + ks * 32 + fq * 8);
#pragma unroll
        for (int ct = 0; ct < 4; ++ct)
#pragma unroll
            for (int pt = 0; pt < 4; ++pt) acc[ct][pt] = __builtin_amdgcn_mfma_f32_16x16x32_bf16(af[ct], bfr[pt], acc[ct][pt], 0, 0, 0);
    }
#pragma unroll
    for (int pt = 0; pt < 4; ++pt) {
        const int p = ph * 64 + pt * 16 + fr; const float bs = b_s[g * 128 + p];
        const bf16_t* urow = zg + (size_t)(row0 + p) * 512 + g * 64 + 4 * fq;
        bf16_t* orow = mix + (size_t)(row0 + p) * 1024 + 512 + g * 64 + 4 * fq;
#pragma unroll
        for (int ct = 0; ct < 4; ++ct) { const u32x2 u = *(const u32x2*)(urow + ct * 16); const f32x4 s = acc[ct][pt] + bs;
            u32x2 o; o.x = pk2(bflo(u.x) * s[0], bfhi(u.x) * s[1]); o.y = pk2(bflo(u.y) * s[2], bfhi(u.y) * s[3]); *(u32x2*)(orow + ct * 16) = o; }
    }
}

__device__ __forceinline__ void conv_tile(const Frame& F, int tile, const bf16_t* yc, const float* w_dw, const float* b_dw, const float* ln_g, const float* ln_b, bf16_t* mix) {
    LAS unsigned short* T = (LAS unsigned short*)F.lds;
    LAS float* red = (LAS float*)(F.lds + 158 * 512);
    LAS float* stat = red + 128 * 8;
    const int row0 = tile * 128; const bool lat = row0 < ML;
    const int Ls = lat ? SEQ : CTXL, t0 = lat ? (row0 & (SEQ - 1)) : ((row0 - ML) & (CTXL - 1));
    __syncthreads();
    for (int i = F.tid; i < 158 * 32; i += NTHREADS) { const int r = i >> 5, c8 = (i & 31) * 8; const int tt = t0 + r - 15;
        u32x4 v = (u32x4){0u, 0u, 0u, 0u}; if (tt >= 0 && tt < Ls) v = *(const u32x4*)(yc + (size_t)(row0 + r - 15) * 256 + c8);
        *(LAS u32x4*)(T + r * 256 + c8) = v; }
    __syncthreads();
    const int ch = F.tid & 255, half = F.tid >> 8;
    float wd[31];
#pragma unroll
    for (int j = 0; j < 31; ++j) wd[j] = w_dw[j * 256 + ch];
    const float bd = b_dw[ch];
#pragma unroll 1
    for (int grp = 0; grp < 8; ++grp) {
        const int rb = half * 64 + grp * 8;
        float a[8];
#pragma unroll
        for (int k = 0; k < 8; ++k) a[k] = bd;
#pragma unroll
        for (int i = 0; i < 38; ++i) { const float x = __uint_as_float(((unsigned)T[(rb + i) * 256 + ch]) << 16);
#pragma unroll
            for (int k = 0; k < 8; ++k) { const int j = i - k; if (j >= 0 && j < 31) a[k] += x * wd[j]; } }
        float pr[16];
#pragma unroll
        for (int k = 0; k < 8; ++k) { pr[k] = a[k]; pr[8 + k] = a[k] * a[k]; }
        const float tot = wave_reduce16(pr, F.lane);
        if ((F.lane & 3) == 0) { const int idx = (F.lane >> 2) & 15; red[((rb + (idx & 7)) * 4 + (F.wave & 3)) * 2 + (idx >> 3)] = tot; }
    }
    __syncthreads();
    if (F.tid < 128) { const int r = F.tid; float s = 0.f, q = 0.f;
#pragma unroll
        for (int w = 0; w < 4; ++w) { s += red[(r * 4 + w) * 2]; q += red[(r * 4 + w) * 2 + 1]; }
        const float mu = s * (1.0f / 256.0f); const float var = fmaxf(q * (1.0f / 256.0f) - mu * mu, 0.f);
        stat[r * 2] = mu; stat[r * 2 + 1] = 1.0f / sqrtf(var + EPS); }
    __syncthreads();
    const float gg = ln_g[ch], bb = ln_b[ch];
#pragma unroll 1
    for (int grp = 0; grp < 8; ++grp) {
        const int rb = half * 64 + grp * 8;
        float a[8];
#pragma unroll
        for (int k = 0; k < 8; ++k) a[k] = bd;
#pragma unroll
        for (int i = 0; i < 38; ++i) { const float x = __uint_as_float(((unsigned)T[(rb + i) * 256 + ch]) << 16);
#pragma unroll
            for (int k = 0; k < 8; ++k) { const int j = i - k; if (j >= 0 && j < 31) a[k] += x * wd[j]; } }
#pragma unroll
        for (int k = 0; k < 8; ++k) { const int r = rb + k; float y = (a[k] - stat[r * 2]) * stat[r * 2 + 1] * gg + bb; y = y * fast_sigmoid(y);
            mix[(size_t)(row0 + r) * 1024 + 768 + ch] = (bf16_t)f2bf(y); }
    }
}

__device__ __forceinline__ void ln1_row(int row, int lane, const float* xl, const float* xc, const float* y, const float* modl, const float* lg, const float* lb, float* x1l, float* x1c, bf16_t* h) {
    const float* xp = rowptr(xl, xc, row); const float* yp = y + (size_t)row * D; const float* mp = modl + (size_t)modid(row) * 6144;
    f32x4 v[4]; float s = 0.f;
#pragma unroll
    for (int j = 0; j < 4; ++j) { const int col = j * 256 + lane * 4; const f32x4 a = *(const f32x4*)(xp + col), b = *(const f32x4*)(yp + col), g = *(const f32x4*)(mp + 2048 + col);
        v[j] = a * ALPHA + g * b; s += (v[j][0] + v[j][1]) + (v[j][2] + v[j][3]); }
    float mu = wave_sum(s) * (1.0f / 1024.0f), q = 0.f;
#pragma unroll
    for (int j = 0; j < 4; ++j) { v[j] = v[j] - mu; q += (v[j][0] * v[j][0] + v[j][1] * v[j][1]) + (v[j][2] * v[j][2] + v[j][3] * v[j][3]); }
    float rstd = 1.0f / sqrtf(wave_sum(q) * (1.0f / 1024.0f) + EPS);
    float* op = rowptr_w(x1l, x1c, row); s = 0.f;
#pragma unroll
    for (int j = 0; j < 4; ++j) { const int col = j * 256 + lane * 4; const f32x4 g = *(const f32x4*)(lg + col), b = *(const f32x4*)(lb + col);
        v[j] = v[j] * rstd * g + b; *(f32x4*)(op + col) = v[j]; s += (v[j][0] + v[j][1]) + (v[j][2] + v[j][3]); }
    mu = wave_sum(s) * (1.0f / 1024.0f); q = 0.f;
#pragma unroll
    for (int j = 0; j < 4; ++j) { v[j] = v[j] - mu; q += (v[j][0] * v[j][0] + v[j][1] * v[j][1]) + (v[j][2] * v[j][2] + v[j][3] * v[j][3]); }
    rstd = 1.0f / sqrtf(wave_sum(q) * (1.0f / 1024.0f) + EPS);
#pragma unroll
    for (int j = 0; j < 4; ++j) { const int col = j * 256 + lane * 4; const f32x4 sh = *(const f32x4*)(mp + 3072 + col), sc = *(const f32x4*)(mp + 4096 + col);
        const f32x4 o = v[j] * rstd * (sc + 1.0f) + sh; u32x2 w; w.x = pk2(o[0], o[1]); w.y = pk2(o[2], o[3]); *(u32x2*)(h + (size_t)row * D + col) = w; }
}
#define TK_INS(t, x) do { float xx_ = (x); _Pragma("unroll") for (int i_ = 0; i_ < 16; ++i_) { const float hi_ = fmaxf(t[i_], xx_); xx_ = fminf(t[i_], xx_); t[i_] = hi_; } } while (0)
__device__ __forceinline__ float dot16_fp8(const u32x4 r, const float (&hv)[16]) {
    float p = 0.f;
#pragma unroll
    for (int j = 0; j < 4; ++j) { const f32x2 lo = __builtin_amdgcn_cvt_pk_f32_fp8((int)r[j], false), hi = __builtin_amdgcn_cvt_pk_f32_fp8((int)r[j], true);
        p += (lo[0] * hv[4 * j] + lo[1] * hv[4 * j + 1]) + (hi[0] * hv[4 * j + 2] + hi[1] * hv[4 * j + 3]); }
    return p;
}
__device__ __forceinline__ void axpy16_fp8(float (&acc)[16], const float w, const u32x4 r) {
#pragma unroll
    for (int j = 0; j < 4; ++j) { const f32x2 lo = __builtin_amdgcn_cvt_pk_f32_fp8((int)r[j], false), hi = __builtin_amdgcn_cvt_pk_f32_fp8((int)r[j], true);
        acc[4 * j] += w * lo[0]; acc[4 * j + 1] += w * lo[1]; acc[4 * j + 2] += w * hi[0]; acc[4 * j + 3] += w * hi[1]; }
}
__device__ __forceinline__ void peer_group(const Frame& F, int group, const float* s, const bf16_t* h, const unsigned char* u8, const unsigned char* v8,
                                           const float* x1l, const float* x1c, const float* modl, const float* lg, const float* lb, float* x2l, float* x2c,
                                           const float* modn  , bf16_t* hn) {
    LAS float* l1 = (LAS float*)F.lds + (F.wave * 64) * 16;
    LAS int* ridx = (LAS int*)(F.lds + 32768) + F.wave * 4 * 8 * 16;
    LAS float* rgate = (LAS float*)(F.lds + 49152) + F.wave * 4 * 8 * 16;
    const int lane = F.lane, row0 = group * 32 + F.wave * 4;
    {
        const float* sp = s + (size_t)(row0 + (lane >> 4)) * 2048 + (lane & 15) * 128;
        float t[16];
#pragma unroll
        for (int i = 0; i < 16; ++i) t[i] = -3.0e38f;
#pragma unroll 1
        for (int c8 = 0; c8 < 4; ++c8) {
            f32x4 v[8];
#pragma unroll
            for (int j = 0; j < 8; ++j) v[j] = *(const f32x4*)(sp + c8 * 32 + j * 4);
#pragma unroll
            for (int j = 0; j < 8; ++j)
#pragma unroll
                for (int e = 0; e < 4; ++e) { const unsigned k = (unsigned)(c8 * 32 + j * 4 + e); const float x = __uint_as_float((__float_as_uint(v[j][e]) & ~0x7Fu) | (127u - k)); TK_INS(t, x); }
        }
#pragma unroll
        for (int i = 0; i < 4; ++i) *(LAS f32x4*)(l1 + lane * 16 + i * 4) = (f32x4){t[4 * i], t[4 * i + 1], t[4 * i + 2], t[4 * i + 3]};
    }
    {
        const LAS float* la = l1 + (lane & ~1) * 16; const LAS float* lb_ = l1 + (lane | 1) * 16;
        float a[16], b[16];
#pragma unroll
        for (int i = 0; i < 4; ++i) { const f32x4 x = *(const LAS f32x4*)(la + 4 * i), y = *(const LAS f32x4*)(lb_ + 4 * i);
            a[4 * i] = x[0]; a[4 * i + 1] = x[1]; a[4 * i + 2] = x[2]; a[4 * i + 3] = x[3]; b[4 * i] = y[0]; b[4 * i + 1] = y[1]; b[4 * i + 2] = y[2]; b[4 * i + 3] = y[3]; }
        float t[16];
#pragma unroll
        for (int i = 0; i < 16; ++i) t[i] = -3.0e38f;
#pragma unroll
        for (int i = 0; i < 16; ++i)
#pragma unroll
            for (int j = 0; j < 16; ++j)
                if ((i + 1) * (j + 1) <= 16) { const float x = __uint_as_float((__float_as_uint(a[i] + b[j]) & ~0xFFu) | (unsigned)(255 - (i * 16 + j))); TK_INS(t, x); }
        float e[16], sum = 0.f;
#pragma unroll
        for (int i = 0; i < 16; ++i) { e[i] = __builtin_amdgcn_exp2f((t[i] - t[0]) * 1.4426950408889634f); sum += e[i]; }
        const float inv = 1.0f / sum;
        if ((lane & 1) == 0) {
            const int tl = lane >> 4, hd = (lane & 15) >> 1;
#pragma unroll
            for (int i = 0; i < 16; ++i) {
                const int pos = 255 - (int)(__float_as_uint(t[i]) & 0xFFu);
                const int ea = 127 - (int)(__float_as_uint(la[pos >> 4]) & 0x7Fu), eb = 127 - (int)(__float_as_uint(lb_[pos & 15]) & 0x7Fu);
                ridx[(tl * 8 + hd) * 16 + i] = ea * 128 + eb; rgate[(tl * 8 + hd) * 16 + i] = e[i] * inv;
            }
        }
    }
    for (int ti = 0; ti < 4; ++ti) {
        const int row = row0 + ti;
        float hv[16];
        { const u32x4 w0 = *(const u32x4*)(h + (size_t)row * D + lane * 16), w1 = *(const u32x4*)(h + (size_t)row * D + lane * 16 + 8);
#pragma unroll
          for (int i = 0; i < 4; ++i) { hv[2 * i] = bflo(w0[i]); hv[2 * i + 1] = bfhi(w0[i]); hv[8 + 2 * i] = bflo(w1[i]); hv[8 + 2 * i + 1] = bfhi(w1[i]); } }
        float acc[16];
#pragma unroll
        for (int i = 0; i < 16; ++i) acc[i] = 0.f;
        for (int hd = 0; hd < 8; ++hd) {
            const int e_mine = ridx[(ti * 8 + hd) * 16 + (lane & 15)];
            const float g_pair = rgate[(ti * 8 + hd) * 16 + ((lane >> 2) & 15)];
            u32x4 ua[8], ub[8], va[8], vb[8];
            float p[16];
#pragma unroll
            for (int k = 0; k < 8; ++k) { const int e = __builtin_amdgcn_readlane(e_mine, k); ua[k] = *(const u32x4*)(u8 + (size_t)e * 1024 + lane * 16); }
#pragma unroll
            for (int k = 0; k < 8; ++k) { const int e = __builtin_amdgcn_readlane(e_mine, 8 + k); ub[k] = *(const u32x4*)(u8 + (size_t)e * 1024 + lane * 16); }
#pragma unroll
            for (int k = 0; k < 8; ++k) p[k] = dot16_fp8(ua[k], hv);
            asm volatile("" ::: "memory");
#pragma unroll
            for (int k = 0; k < 8; ++k) { const int e = __builtin_amdgcn_readlane(e_mine, k); va[k] = *(const u32x4*)(v8 + (size_t)e * 1024 + lane * 16); }
#pragma unroll
            for (int k = 0; k < 8; ++k) p[8 + k] = dot16_fp8(ub[k], hv);
            asm volatile("" ::: "memory");
#pragma unroll
            for (int k = 0; k < 8; ++k) { const int e = __builtin_amdgcn_readlane(e_mine, 8 + k); vb[k] = *(const u32x4*)(v8 + (size_t)e * 1024 + lane * 16); }
            const float act = wave_reduce16(p, lane) * (1.0f / U_SCALE);
            const float wv = g_pair * gelu_tanh(act) * (1.0f / V_SCALE);
#pragma unroll
            for (int k = 0; k < 8; ++k) { const float wk = __builtin_bit_cast(float, __builtin_amdgcn_readlane(__builtin_bit_cast(int, wv), 4 * k)); axpy16_fp8(acc, wk, va[k]); }
#pragma unroll
            for (int k = 0; k < 8; ++k) { const float wk = __builtin_bit_cast(float, __builtin_amdgcn_readlane(__builtin_bit_cast(int, wv), 4 * (8 + k))); axpy16_fp8(acc, wk, vb[k]); }
        }
        const float* x1p = rowptr(x1l, x1c, row) + lane * 16; const float* mp = modl + (size_t)modid(row) * 6144;
        f32x4 v[4]; float sm = 0.f;
#pragma unroll
        for (int j = 0; j < 4; ++j) { const f32x4 x1 = *(const f32x4*)(x1p + 4 * j), g2 = *(const f32x4*)(mp + 5120 + lane * 16 + 4 * j);
            v[j] = x1 * ALPHA + g2 * (f32x4){acc[4 * j], acc[4 * j + 1], acc[4 * j + 2], acc[4 * j + 3]}; sm += (v[j][0] + v[j][1]) + (v[j][2] + v[j][3]); }
        float mu = wave_sum(sm) * (1.0f / 1024.0f), q = 0.f;
#pragma unroll
        for (int j = 0; j < 4; ++j) { v[j] = v[j] - mu; q += (v[j][0] * v[j][0] + v[j][1] * v[j][1]) + (v[j][2] * v[j][2] + v[j][3] * v[j][3]); }
        float rstd = 1.0f / sqrtf(wave_sum(q) * (1.0f / 1024.0f) + EPS);
        float* op = rowptr_w(x2l, x2c, row) + lane * 16; sm = 0.f;
#pragma unroll
        for (int j = 0; j < 4; ++j) { const f32x4 g = *(const f32x4*)(lg + lane * 16 + 4 * j), b = *(const f32x4*)(lb + lane * 16 + 4 * j);
            v[j] = v[j] * rstd * g + b; *(f32x4*)(op + 4 * j) = v[j]; sm += (v[j][0] + v[j][1]) + (v[j][2] + v[j][3]); }
        if (modn) {
            const float* mn = modn + (size_t)modid(row) * 6144;
            mu = wave_sum(sm) * (1.0f / 1024.0f); q = 0.f;
#pragma unroll
            for (int j = 0; j < 4; ++j) { v[j] = v[j] - mu; q += (v[j][0] * v[j][0] + v[j][1] * v[j][1]) + (v[j][2] * v[j][2] + v[j][3] * v[j][3]); }
            rstd = 1.0f / sqrtf(wave_sum(q) * (1.0f / 1024.0f) + EPS);
            u32x4 o[2];
#pragma unroll
            for (int j = 0; j < 4; ++j) { const f32x4 sh = *(const f32x4*)(mn + lane * 16 + 4 * j), sc = *(const f32x4*)(mn + 1024 + lane * 16 + 4 * j);
                const f32x4 r = v[j] * rstd * (sc + 1.0f) + sh; o[j >> 1][(j & 1) * 2] = pk2(r[0], r[1]); o[j >> 1][(j & 1) * 2 + 1] = pk2(r[2], r[3]); }
            *(u32x4*)(hn + (size_t)row * D + lane * 16) = o[0]; *(u32x4*)(hn + (size_t)row * D + lane * 16 + 8) = o[1];
        }
    }
}
#ifndef MK_SINGLE
#define MK_SINGLE 1
#endif
__global__ void __launch_bounds__(NTHREADS, 2) mk_fwd(Params P) {
    extern __shared__ __attribute__((aligned(16))) unsigned char lds_raw[];
    Frame F;
    F.lds = (LAS unsigned char*)lds_raw;
    F.tid = threadIdx.x; F.lane = F.tid & 63; F.wave = __builtin_amdgcn_readfirstlane(F.tid >> 6);
    F.G = gridDim.x; { const int bx = blockIdx.x; F.vcu = (F.G % 8 == 0) ? (bx % 8) * (F.G / 8) + bx / 8 : bx; }
    volatile LAS unsigned* MISC = (volatile LAS unsigned*)(F.lds + MISC_OFF);
    for (int u = F.tid; u < (LDS_BYTES - MISC_OFF) / 4; u += NTHREADS) MISC[u] = 0u;
    __syncthreads();
    unsigned char* ws = P.ws;
    unsigned* ctl = (unsigned*)(ws + WS_CTL);
    XcdBarrier bar; bar.bar = ctl + CW_BAR; bar.x = 0; bar.st = nullptr;
    if (P.ph_hi - P.ph_lo > 1) bar = xcd_barrier_post(ctl + CW_BAR, MISC + 8);

    const float* x = P.in[0]; const float* c = P.in[1]; const float* ctxin = P.in[2]; const float* c_ctx = P.in[3]; const float* w_mod = P.in[4]; const float* b_mod = P.in[5];
    const float* w_in = P.in[6]; const float* q_norm_g = P.in[7]; const float* k_norm_g = P.in[8]; const float* gmlp_ln_g = P.in[9]; const float* gmlp_ln_b = P.in[10];
    const float* gmlp_w_s = P.in[11]; const float* gmlp_b_s = P.in[12]; const float* conv_w_dw = P.in[13]; const float* conv_b_dw = P.in[14]; const float* conv_ln_g = P.in[15];
    const float* conv_ln_b = P.in[16]; const float* conv_w_pw = P.in[17]; const float* conv_b_pw = P.in[18]; const float* w_out = P.in[19]; const float* ln1_g = P.in[20];
    const float* ln1_b = P.in[21]; const float* ln2_g = P.in[22]; const float* ln2_b = P.in[23]; const float* peer_w_q = P.in[24]; const float* peer_sk = P.in[25];
    const float* peer_u = P.in[26]; const float* peer_v = P.in[27];
    float* out = P.out;
    float* mod = (float*)(ws + WS_MOD); float* rope = (float*)(ws + WS_ROPE); float* bout = (float*)(ws + WS_BOUT);
    bf16_t* Win_t = (bf16_t*)(ws + WS_WIN_T); bf16_t* Wout_t = (bf16_t*)(ws + WS_WOUT_T); bf16_t* Ws_t = (bf16_t*)(ws + WS_WS_T); bf16_t* gws = (bf16_t*)(ws + WS_GWS);
    float* xc1 = (float*)(ws + WS_XC1); float* xc2 = (float*)(ws + WS_XC2);
    unsigned char* u8 = ws + WS_U8; unsigned char* v8 = ws + WS_V8;
    bf16_t* hbuf = (bf16_t*)(ws + WS_H); bf16_t* qbuf = (bf16_t*)(ws + WS_Q); bf16_t* kvbuf = (bf16_t*)(ws + WS_KV); bf16_t* zgbuf = (bf16_t*)(ws + WS_ZG); bf16_t* ycbuf = (bf16_t*)(ws + WS_YC);
    bf16_t* mix = (bf16_t*)(ws + WS_MIX); float* ybuf = (float*)(ws + WS_Y); float* sbuf = (float*)(ws + WS_S);

    const int lo = P.ph_lo, hi = P.ph_hi;
#define IN(k) (lo <= (k) && (k) < hi)
#define SEAM(k) do { if (IN(k) && IN((k) + 1)) xcd_barrier(bar); } while (0)
    const int gw = F.vcu * NWAVES + F.wave, NGW = F.G * NWAVES;
    const int gt = gw * 64 + F.lane, NGT = NGW * 64;

    if (IN(0)) {
#ifndef NO_P0
        for (int it = F.vcu; it < 192 + 512 + 128; it += F.G) {
            if (it < 192) p0_mod_item(F, it, c, c_ctx, w_mod, b_mod, mod);
            else if (it < 704) p0_ws_item(F, it - 192, peer_w_q, peer_sk, Ws_t);
            else p0_wc_item(F, it - 704, conv_w_pw, conv_b_pw, w_out, Wout_t, bout);
        }
        __syncthreads();
        {
            LAS float* scr = (LAS float*)(F.lds + F.wave * 16384);
            for (int it = gw; it < 2 * 896 + 2 * 384; it += NGW) {
                if (it < 1792) { const int l = it / 896, r = it % 896, kb = r / 56, nb = r % 56;
                    p0_transpose_item(w_in + (size_t)l * 1024 * INW, 1024, INW, Win_t + (size_t)l * INW * 1024, kb * 64, nb * 32, inproj_phys(nb * 32), scr, F.lane); }
                else { const int r0 = it - 1792, l = r0 / 384, r = r0 % 384, kb = r / 32, nb = r % 32;
                    p0_transpose_item(w_out + (size_t)l * 1024 * 1024, 1024, 1024, Wout_t + (size_t)l * 1024 * 1024, kb * 64, nb * 32, nb * 32, scr, F.lane); }
            }
        }
        for (int i = gt; i < 2048; i += NGT) { const int pos = i >> 4, f = i & 15; const double a = (double)pos * exp(-(double)f * (9.210340371976184 / 16.0)); rope[i * 2] = (float)cos(a); rope[i * 2 + 1] = (float)sin(a); }
        for (int i = gt; i < 2 * 4 * 128 * 128 / 2; i += NGT) { const f32x2 v = *(const f32x2*)(gmlp_w_s + (size_t)i * 2); ((unsigned*)gws)[i] = pk2(v[0], v[1]); }
        {
            const int n4 = 2 * 16384 * 1024 / 4;
            for (int i = gt; i < n4; i += NGT) {
                const f32x4 a = *(const f32x4*)(peer_u + (size_t)i * 4) * U_SCALE, b = *(const f32x4*)(peer_v + (size_t)i * 4) * V_SCALE;
                int wa = 0, wb = 0;
                wa = __builtin_amdgcn_cvt_pk_fp8_f32(a[0], a[1], wa, false); wa = __builtin_amdgcn_cvt_pk_fp8_f32(a[2], a[3], wa, true);
                wb = __builtin_amdgcn_cvt_pk_fp8_f32(b[0], b[1], wb, false); wb = __builtin_amdgcn_cvt_pk_fp8_f32(b[2], b[3], wb, true);
                ((int*)u8)[i] = wa; ((int*)v8)[i] = wb;
            }
        }
#endif
    }
    SEAM(0);
    if (IN(1)) { for (int row = gw; row < MT; row += NGW) lnmod_row(rowptr(x, ctxin, row), mod + (size_t)modid(row) * 6144, mod + (size_t)modid(row) * 6144 + 1024, hbuf + (size_t)row * D, F.lane); }
    SEAM(1);

    for (int l = 0; l < 2; ++l) {
        const int pb = 2 + 6 * l;
#define LAUNDER() do { int t_ = threadIdx.x; asm volatile("" : "+v"(t_)); F.tid = t_; F.lane = t_ & 63; } while (0)
        const float* modl = mod + (size_t)l * 5 * 6144;
        const float* xl = l == 0 ? x : out; const float* xc = l == 0 ? ctxin : xc2;
        const int nr = l == 0 ? MT : ML;
        if (IN(pb)) {
            LAUNDER();
#ifndef NO_A
            pg8::Gemm g{hbuf, Win_t + (size_t)l * INW * 1024, MT, INW, 1024}; pg8::StaticOrder S; S.init(MT, INW, F.G, (int)blockIdx.x);
            pg8::EpiInProj E{qbuf, kvbuf, zgbuf, ycbuf, q_norm_g + l * 64, k_norm_g + l * 64, rope};
            pg8::gemm_phase<pg8::EpiInProj, pg8::StaticOrder, true, true>(F.lds, g, S, E);
#endif
        }
        SEAM(pb);
        if (IN(pb + 1)) {
            LAUNDER();
#ifndef NO_ATT
            for (int u0 = F.vcu * 4; u0 < 1024; u0 += F.G * 4)
                for (int i = 0; i < 4; ++i) { const int u = u0 + i, gi = u >> 7, qb = (u & 127) >> 2, b = gi >> 1, g = gi & 1, hq = g * 4 + (u & 3);
                    const size_t row0 = (size_t)b * SEQ + qb * 256;
                    attn_body::attn_unit<8>((const attn_body::bf16*)(qbuf + row0 * 512 + hq * 64), (const attn_body::bf16*)(kvbuf + (size_t)b * KVSEQ * 256 + g * 64),
                                            (const attn_body::bf16*)(kvbuf + (size_t)b * KVSEQ * 256 + 128 + g * 64), (attn_body::bf16*)(mix + row0 * 1024 + hq * 64), KVSEQ / 64, (char*)lds_raw); }
            if (l == 0)
                for (int u = F.vcu; u < 32; u += F.G) { const int b = u >> 3, hq = u & 7, g = hq >> 2; const size_t row0 = (size_t)ML + b * CTXL;
                    attn_body::attn_unit<8>((const attn_body::bf16*)(qbuf + row0 * 512 + hq * 64), (const attn_body::bf16*)(kvbuf + (size_t)b * KVSEQ * 256 + g * 64),
                                            (const attn_body::bf16*)(kvbuf + (size_t)b * KVSEQ * 256 + 128 + g * 64), (attn_body::bf16*)(mix + row0 * 1024 + hq * 64), CTXL / 64, (char*)lds_raw); }
#endif
            __syncthreads();
#ifndef NO_GMLP
            for (int ch = F.vcu; ch < nr / 128; ch += F.G)
                gmlp_chunk(F, ch, zgbuf, gmlp_ln_g + l * 256, gmlp_ln_b + l * 256, gws + (size_t)l * 4 * 128 * 128, gmlp_b_s + l * 512, mix);
#endif
#ifndef NO_CONV
            for (int tl = F.vcu; tl < nr / 128; tl += F.G)
                conv_tile(F, tl, ycbuf, conv_w_dw + l * 31 * 256, conv_b_dw + l * 256, conv_ln_g + l * 256, conv_ln_b + l * 256, mix);
#endif
            __syncthreads();
        }
        SEAM(pb + 1);
        if (IN(pb + 2)) {
            LAUNDER();
            pg8::Gemm g{mix, Wout_t + (size_t)l * 1024 * 1024, nr, 1024, 1024}; pg8::StaticOrder S; S.init(nr, 1024, F.G, (int)blockIdx.x);
            pg8::EpiF32 E{ybuf, 1024, bout + l * 1024};
#ifndef NO_GF32
            pg8::gemm_phase<pg8::EpiF32, pg8::StaticOrder, true, true>(F.lds, g, S, E);
#endif
        }
        SEAM(pb + 2);
        if (IN(pb + 3)) { LAUNDER(); for (int row = gw; row < nr; row += NGW) ln1_row(row, F.lane, xl, xc, ybuf, modl, ln1_g + l * 1024, ln1_b + l * 1024, out, xc1, hbuf); }
        SEAM(pb + 3);
        if (IN(pb + 4)) {
            LAUNDER();
            pg8::Gemm g{hbuf, Ws_t + (size_t)l * 2048 * 1024, nr, 2048, 1024}; pg8::StaticOrder S; S.init(nr, 2048, F.G, (int)blockIdx.x);
            pg8::EpiF32 E{sbuf, 2048, nullptr};
#ifndef NO_GF32
            pg8::gemm_phase<pg8::EpiF32, pg8::StaticOrder, true, true>(F.lds, g, S, E);
#endif
        }
        SEAM(pb + 4);
        if (IN(pb + 5)) {
            LAUNDER();
#ifndef NO_PEER
            for (int grp = F.vcu; grp < nr / 32; grp += F.G)
                peer_group(F, grp, sbuf, hbuf, u8 + (size_t)l * 16384 * 1024, v8 + (size_t)l * 16384 * 1024, out, xc1, modl, ln2_g + l * 1024, ln2_b + l * 1024, out, xc2,
                           l == 0 ? mod + (size_t)5 * 6144 : nullptr, hbuf);
#endif
        }
        SEAM(pb + 5);
    }
#undef IN
#undef SEAM
}

extern "C" void kernel_launch(void* const* d_in, const int* in_sizes, int n_in, void* d_out, int out_size, void* d_ws, size_t ws_size, hipStream_t stream) {
    static int grid = 0;
    if (grid == 0) {
        int dev = 0, cus = 0;
        if (n_in != 28 || ws_size < WS_END) { fprintf(stderr, "kernel_launch: unexpected n_in %d / ws_size %zu (need %zu)\n", n_in, ws_size, (size_t)WS_END); grid = -1; return; }
        if (hipGetDevice(&dev) != hipSuccess || hipDeviceGetAttribute(&cus, hipDeviceAttributeMultiprocessorCount, dev) != hipSuccess) { grid = -1; return; }
        if (hipFuncSetAttribute((const void*)mk_fwd, hipFuncAttributeMaxDynamicSharedMemorySize, LDS_BYTES) != hipSuccess) { fprintf(stderr, "kernel_launch: hipFuncSetAttribute failed\n"); grid = -1; return; }
        int per_cu = 0;
        if (hipOccupancyMaxActiveBlocksPerMultiprocessor(&per_cu, (const void*)mk_fwd, NTHREADS, LDS_BYTES) != hipSuccess || per_cu < 1) { fprintf(stderr, "kernel_launch: occupancy query says %d\n", per_cu); }
        (void)hipGetLastError();
        grid = cus;
    }
    if (grid < 0) return;
    (void)hipMemsetAsync((char*)d_ws + WS_CTL, 0, CTL_ZERO_BYTES, stream);
    Params p{};
    for (int i = 0; i < 28; ++i) p.in[i] = (const float*)d_in[i];
    p.out = (float*)d_out; p.ws = (unsigned char*)d_ws;
#if MK_SINGLE
    p.ph_lo = 0; p.ph_hi = N_PHASES;
    hipLaunchKernelGGL(mk_fwd, dim3(grid), dim3(NTHREADS), LDS_BYTES, stream, p);
#else
    for (int ph = 0; ph < N_PHASES; ++ph) { p.ph_lo = ph; p.ph_hi = ph + 1; hipLaunchKernelGGL(mk_fwd, dim3(grid), dim3(NTHREADS), LDS_BYTES, stream, p); }
#endif
}
```

```cpp
#include <hip/hip_runtime.h>
#include <hip/hip_bf16.h>
#include <cstdio>
#include <cstdint>

#define GAS __attribute__((address_space(1)))
#define LAS __attribute__((address_space(3)))

namespace cfg {
constexpr int D = 1024, NB = 4, SEQ = 8192, CTXL = 256;
constexpr int ML = NB * SEQ, MC = NB * CTXL, MT = ML + MC;
constexpr int KVSEQ = CTXL + SEQ;
constexpr int INW = 1792;
constexpr float EPS = 1e-6f;
constexpr float ALPHA = 1.41421356237309515f;
constexpr float C2 = 0.125f * 1.4426950408889634f;
constexpr float U_SCALE = 64.f, V_SCALE = 4.f, H_SCALE = 8.f;
constexpr int NWAVES = 8, NTHREADS = 512;
}
using namespace cfg;

typedef unsigned short bf16_t;
typedef float f32x2 __attribute__((ext_vector_type(2)));
typedef float f32x4 __attribute__((ext_vector_type(4)));
typedef unsigned u32x2 __attribute__((ext_vector_type(2)));
typedef unsigned u32x4 __attribute__((ext_vector_type(4)));
typedef short bf16x8 __attribute__((ext_vector_type(8)));

__device__ __forceinline__ int mk_tid() { int t = threadIdx.x; asm volatile("" : "+v"(t)); return t; }
__device__ __forceinline__ unsigned f2bf(float f) { unsigned u = __builtin_bit_cast(unsigned, f); return (u + 0x7fffu + ((u >> 16) & 1u)) >> 16; }
__device__ __forceinline__ unsigned pk2(float lo, float hi) { return f2bf(lo) | (f2bf(hi) << 16); }
__device__ __forceinline__ float bflo(unsigned w) { return __uint_as_float(w << 16); }
__device__ __forceinline__ float bfhi(unsigned w) { return __uint_as_float(w & 0xffff0000u); }
__device__ __forceinline__ float fast_sigmoid(float x) { return __builtin_amdgcn_rcpf(1.0f + __builtin_amdgcn_exp2f(-1.4426950408889634f * x)); }
__device__ __forceinline__ float gelu_tanh(float x) { const float z = x * (1.0f + 0.044715f * x * x); return x * __builtin_amdgcn_rcpf(1.0f + __builtin_amdgcn_exp2f(-2.302208198f * z)); }
template <int CTRL> __device__ __forceinline__ float dpp_f(float v) { return __builtin_bit_cast(float, __builtin_amdgcn_update_dpp(0, __builtin_bit_cast(int, v), CTRL, 0xF, 0xF, true)); }
__device__ __forceinline__ float xchg16(float v, bool odd_row) { const auto rr = __builtin_amdgcn_permlane16_swap(__float_as_uint(v), __float_as_uint(v), false, false); return __uint_as_float(odd_row ? rr[0] : rr[1]); }
__device__ __forceinline__ float xchg32(float v, bool upper) { const auto rr = __builtin_amdgcn_permlane32_swap(__float_as_uint(v), __float_as_uint(v), false, false); return __uint_as_float(upper ? rr[0] : rr[1]); }
__device__ __forceinline__ float wave_sum(float v) {
    v += dpp_f<0xB1>(v);
    v += dpp_f<0x4E>(v);
    v += dpp_f<0x141>(v);
    v += dpp_f<0x140>(v);
    const int lane = (int)__builtin_amdgcn_mbcnt_hi(~0u, __builtin_amdgcn_mbcnt_lo(~0u, 0u));
    v += xchg16(v, lane & 16);
    v += xchg32(v, lane & 32);
    return v;
}
__device__ __forceinline__ float wave_reduce16(float (&v)[16], int lane) {
    const bool b5 = lane & 32, b4 = lane & 16, b3 = lane & 8, b2 = lane & 4;
#pragma unroll
    for (int i = 0; i < 8; ++i) { const float send = b5 ? v[i] : v[i + 8], keep = b5 ? v[i + 8] : v[i]; v[i] = keep + xchg32(send, b5); }
#pragma unroll
    for (int i = 0; i < 4; ++i) { const float send = b4 ? v[i] : v[i + 4], keep = b4 ? v[i + 4] : v[i]; v[i] = keep + xchg16(send, b4); }
#pragma unroll
    for (int i = 0; i < 2; ++i) { const float send = b3 ? v[i] : v[i + 2], keep = b3 ? v[i + 2] : v[i]; v[i] = keep + dpp_f<0x128>(send); }
    { const float send = b2 ? v[0] : v[1], keep = b2 ? v[1] : v[0]; v[0] = keep + dpp_f<0x141>(send); }
    v[0] += dpp_f<0xB1>(v[0]); v[0] += dpp_f<0x4E>(v[0]);
    return v[0];
}
__device__ __forceinline__ const float* rowptr(const float* xl, const float* xc, int row) { return row < ML ? xl + (size_t)row * D : xc + (size_t)(row - ML) * D; }
__device__ __forceinline__ float* rowptr_w(float* xl, float* xc, int row) { return row < ML ? xl + (size_t)row * D : xc + (size_t)(row - ML) * D; }
__device__ __forceinline__ int modid(int row) { return row < ML ? row / SEQ : 4; }
__device__ __forceinline__ int kvrow(int row) { return row < ML ? (row / SEQ) * KVSEQ + CTXL + (row % SEQ) : ((row - ML) / CTXL) * KVSEQ + ((row - ML) % CTXL); }

namespace pg8 {
#define PG8_LAS __attribute__((address_space(3)))
constexpr int BM = 256, BK = 64, HALF = 128, HTB = HALF * BK * 2  , STAGE_BYTES = 8 * HTB, NXCD = 8, WGM = 8;

__host__ __device__ __forceinline__ int lds_byte(int r, int c) { const int st = (r >> 4) * 2 + (c >> 5), rr = r & 15, cc = c & 31, ob = rr * 64 + cc * 2; return st * 1024 + (ob ^ (((ob >> 9) & 1) << 5)); }
__host__ __device__ __forceinline__ void stage_rc(int b, int& R, int& C) { const int st = b / 1024, sb = b % 1024, swz = sb ^ (((sb >> 9) & 1) << 5); R = (st >> 1) * 16 + swz / 64; C = (st & 1) * 32 + (swz % 64) / 2; }
__host__ __device__ __forceinline__ int perm32(int rho) { const int n = rho >> 4, i = rho & 15; return 8 * (i >> 2) + 4 * n + (i & 3); }

struct Unit { int pm, pn; };
struct Gemm { const bf16_t* A; const bf16_t* Bt; int M, N, K; };

struct StaticOrder {
    int nM, nN, nwg, G, c;
    __host__ __device__ void init(int M, int N, int G_, int c_) { nM = M / BM; nN = N / BM; nwg = nM * nN; G = G_; c = c_; }
    __host__ __device__ bool next(int i, Unit& u) const {
        const long L = (long)i * G + c; if (L >= nwg) return false;
        int wgid = (int)L; { const int q = nwg / NXCD, r = nwg % NXCD, xcd = wgid % NXCD, off = wgid / NXCD; wgid = (xcd < r ? xcd * (q + 1) : r * (q + 1) + (xcd - r) * q) + off; }
        const int nig = WGM * nN, gid = wgid / nig, fm = gid * WGM, gsz = (nM - fm) < WGM ? (nM - fm) : WGM;
        u.pm = fm + ((wgid % nig) % gsz); u.pn = (wgid % nig) / gsz; return true;
    }
    __device__ __forceinline__ void a_ready(const Unit&) const {}
    __device__ __forceinline__ void done(const Unit&) const {}
};


struct EpiF32 {
    static constexpr bool PERM = false, AFTER_DRAIN = false;
    float* C; int ldc; const float* bias;
    __device__ __forceinline__ void operator()(const f32x4 (&acc)[2][2][4][2], const Unit& u, int wr, int wc, int fr, int fq) const {
        const int row0 = u.pm * BM + wr * 64 + fr, col0 = u.pn * BM + wc * 32 + 4 * fq;
        f32x4 bv[2][2];
#pragma unroll
        for (int bj = 0; bj < 2; ++bj)
#pragma unroll
            for (int n = 0; n < 2; ++n) bv[bj][n] = bias ? *(const f32x4*)(bias + col0 + bj * HALF + 16 * n) : (f32x4){0.f, 0.f, 0.f, 0.f};
#pragma unroll
        for (int ai = 0; ai < 2; ++ai)
#pragma unroll
            for (int m = 0; m < 4; ++m) { float* rowp = C + (size_t)(row0 + ai * HALF + m * 16) * ldc + col0;
#pragma unroll
                for (int bj = 0; bj < 2; ++bj)
#pragma unroll
                    for (int n = 0; n < 2; ++n) *(f32x4*)(rowp + bj * HALF + 16 * n) = acc[ai][bj][m][n] + bv[bj][n]; }
    }
};

struct EpiBf16 {
    static constexpr bool PERM = true, AFTER_DRAIN = false;
    bf16_t* C; int ldc; const float* bias;
    __device__ __forceinline__ void operator()(const f32x4 (&acc)[2][2][4][2], const Unit& u, int wr, int wc, int fr, int fq) const {
        const int row0 = u.pm * BM + wr * 64 + fr, col0 = u.pn * BM + wc * 32 + 8 * fq;
        f32x4 bv[2][2];
#pragma unroll
        for (int bj = 0; bj < 2; ++bj)
#pragma unroll
            for (int n = 0; n < 2; ++n) bv[bj][n] = bias ? *(const f32x4*)(bias + col0 + bj * HALF + 4 * n) : (f32x4){0.f, 0.f, 0.f, 0.f};
#pragma unroll
        for (int ai = 0; ai < 2; ++ai)
#pragma unroll
            for (int m = 0; m < 4; ++m) { bf16_t* rowp = C + (size_t)(row0 + ai * HALF + m * 16) * ldc + col0;
#pragma unroll
                for (int bj = 0; bj < 2; ++bj) { const f32x4 v0 = acc[ai][bj][m][0] + bv[bj][0], v1 = acc[ai][bj][m][1] + bv[bj][1];
                    u32x4 w; w.x = pk2(v0[0], v0[1]); w.y = pk2(v0[2], v0[3]); w.z = pk2(v1[0], v1[1]); w.w = pk2(v1[2], v1[3]); *(u32x4*)(rowp + bj * HALF) = w; } }
    }
};

struct EpiResid {
    static constexpr bool PERM = true, AFTER_DRAIN = false;
    bf16_t* T; const float* bias; const float* modl; const float* xf; const bf16_t* xb; const float* xc;
    __device__ __forceinline__ void operator()(const f32x4 (&acc)[2][2][4][2], const Unit& u, int wr, int wc, int fr, int fq) const {
        const int row0 = u.pm * BM + wr * 64 + fr, col0 = u.pn * BM + wc * 32 + 8 * fq;
        const bool isctx = u.pm * BM >= ML;
        const float* g1p = modl + (size_t)(isctx ? 4 : (u.pm * BM) / SEQ) * 6144 + 2048;
        f32x4 bv[2][2], gv[2][2];
#pragma unroll
        for (int bj = 0; bj < 2; ++bj)
#pragma unroll
            for (int n = 0; n < 2; ++n) { bv[bj][n] = *(const f32x4*)(bias + col0 + bj * HALF + 4 * n); gv[bj][n] = *(const f32x4*)(g1p + col0 + bj * HALF + 4 * n); }
#pragma unroll
        for (int ai = 0; ai < 2; ++ai)
#pragma unroll
            for (int m = 0; m < 4; ++m) { const int row = row0 + ai * HALF + m * 16;
#pragma unroll
                for (int bj = 0; bj < 2; ++bj) { const int col = col0 + bj * HALF;
                    f32x4 x0, x1;
                    if (isctx) { const float* p = xc + (size_t)(row - ML) * D + col; x0 = *(const f32x4*)p; x1 = *(const f32x4*)(p + 4); }
                    else if (xb) { const u32x4 w = *(const u32x4*)(xb + (size_t)row * D + col); x0 = (f32x4){bflo(w.x), bfhi(w.x), bflo(w.y), bfhi(w.y)}; x1 = (f32x4){bflo(w.z), bfhi(w.z), bflo(w.w), bfhi(w.w)}; }
                    else { const float* p = xf + (size_t)row * D + col; x0 = *(const f32x4*)p; x1 = *(const f32x4*)(p + 4); }
                    const f32x4 v0 = x0 * ALPHA + gv[bj][0] * (acc[ai][bj][m][0] + bv[bj][0]), v1 = x1 * ALPHA + gv[bj][1] * (acc[ai][bj][m][1] + bv[bj][1]);
                    u32x4 w; w.x = pk2(v0[0], v0[1]); w.y = pk2(v0[2], v0[3]); w.z = pk2(v1[0], v1[1]); w.w = pk2(v1[2], v1[3]); *(u32x4*)(T + (size_t)row * D + col) = w; } }
    }
};

typedef _Float16 f16x2_t __attribute__((ext_vector_type(2)));
__device__ __forceinline__ unsigned pkh2(float lo, float hi) { const f16x2_t h = __builtin_convertvector((f32x2){lo, hi}, f16x2_t); return __builtin_bit_cast(unsigned, h); }
struct EpiF16 {
    static constexpr bool PERM = true, AFTER_DRAIN = false;
    unsigned short* C; int ldc;
    __device__ __forceinline__ void operator()(const f32x4 (&acc)[2][2][4][2], const Unit& u, int wr, int wc, int fr, int fq) const {
        const int row0 = u.pm * BM + wr * 64 + fr, col0 = u.pn * BM + wc * 32 + 8 * fq;
#pragma unroll
        for (int ai = 0; ai < 2; ++ai)
#pragma unroll
            for (int m = 0; m < 4; ++m) { unsigned short* rowp = C + (size_t)(row0 + ai * HALF + m * 16) * ldc + col0;
#pragma unroll
                for (int bj = 0; bj < 2; ++bj) { const f32x4 v0 = acc[ai][bj][m][0], v1 = acc[ai][bj][m][1];
                    u32x4 w; w.x = pkh2(v0[0], v0[1]); w.y = pkh2(v0[2], v0[3]); w.z = pkh2(v1[0], v1[1]); w.w = pkh2(v1[2], v1[3]); *(u32x4*)(rowp + bj * HALF) = w; } }
    }
};

struct EpiInProj {
    static constexpr bool PERM = false, AFTER_DRAIN = false;
    bf16_t* q; bf16_t* kv; bf16_t* zg; bf16_t* yc; const float* qg; const float* kg; const float* rope;
    __device__ __forceinline__ void operator()(const f32x4 (&acc)[2][2][4][2], const Unit& u, int wr, int wc, int fr, int fq) const {
        const int pn = u.pn, rowb = u.pm * BM + wr * 64 + fr;
        if (pn <= 2) {
            const bool isq = pn < 2, isv = (pn == 2 && wc >= 2), lat = (u.pm * BM) < ML;
            f32x4 gn[2][2];
#pragma unroll
            for (int bj = 0; bj < 2; ++bj)
#pragma unroll
                for (int n = 0; n < 2; ++n) gn[bj][n] = *(const f32x4*)((isq ? qg : kg) + 32 * bj + 16 * n + 4 * fq);
#pragma unroll
            for (int ai = 0; ai < 2; ++ai)
#pragma unroll
                for (int m = 0; m < 4; ++m) {
                    const int row = rowb + ai * HALF + m * 16;
                    f32x4 v[2][2];
#pragma unroll
                    for (int bj = 0; bj < 2; ++bj)
#pragma unroll
                        for (int n = 0; n < 2; ++n) v[bj][n] = acc[ai][bj][m][n];
                    if (!isv) {
                        float ss = 0.f;
#pragma unroll
                        for (int bj = 0; bj < 2; ++bj)
#pragma unroll
                            for (int n = 0; n < 2; ++n) ss += (v[bj][n][0] * v[bj][n][0] + v[bj][n][1] * v[bj][n][1]) + (v[bj][n][2] * v[bj][n][2] + v[bj][n][3] * v[bj][n][3]);
                        ss += xchg16(ss, fq & 1); ss += xchg32(ss, fq & 2);
                        const float rs = __builtin_amdgcn_rsqf(ss * (1.0f / 64.0f) + EPS);
#pragma unroll
                        for (int bj = 0; bj < 2; ++bj)
#pragma unroll
                            for (int n = 0; n < 2; ++n) v[bj][n] = v[bj][n] * rs * gn[bj][n];
                        if (lat) {
                            const int t = row & (SEQ - 1);
#pragma unroll
                            for (int bj = 0; bj < 2; ++bj) {
                                const int pos = bj ? (t & 63) : (t >> 6);
                                const float* rp = rope + (pos * 16 + 4 * fq) * 2;
                                const f32x4 cs01 = *(const f32x4*)rp, cs23 = *(const f32x4*)(rp + 4);
                                const float cs[4] = {cs01[0], cs01[2], cs23[0], cs23[2]}, sn[4] = {cs01[1], cs01[3], cs23[1], cs23[3]};
#pragma unroll
                                for (int e = 0; e < 4; ++e) { const float x1 = v[bj][0][e], x2 = v[bj][1][e]; v[bj][0][e] = x1 * cs[e] - x2 * sn[e]; v[bj][1][e] = x1 * sn[e] + x2 * cs[e]; }
                            }
                        }
                        if (isq) {
#pragma unroll
                            for (int bj = 0; bj < 2; ++bj)
#pragma unroll
                                for (int n = 0; n < 2; ++n) v[bj][n] = v[bj][n] * C2;
                        }
                    }
                    bf16_t* dst = isq ? q + (size_t)row * 512 + (pn * 4 + wc) * 64 : kv + (size_t)kvrow(row) * 256 + (wc >= 2 ? 128 + (wc - 2) * 64 : wc * 64);
#pragma unroll
                    for (int bj = 0; bj < 2; ++bj)
#pragma unroll
                        for (int n = 0; n < 2; ++n) { u32x2 w; w.x = pk2(v[bj][n][0], v[bj][n][1]); w.y = pk2(v[bj][n][2], v[bj][n][3]); *(u32x2*)(dst + 32 * bj + 16 * n + 4 * fq) = w; }
                }
        } else if (pn <= 4) {
#pragma unroll
            for (int ai = 0; ai < 2; ++ai)
#pragma unroll
                for (int m = 0; m < 4; ++m) { bf16_t* dst = zg + (size_t)(rowb + ai * HALF + m * 16) * 512 + (pn - 3) * 256 + wc * 32 + 4 * fq;
#pragma unroll
                    for (int bj = 0; bj < 2; ++bj)
#pragma unroll
                        for (int n = 0; n < 2; ++n) { const f32x4 a = acc[ai][bj][m][n]; u32x2 w; w.x = pk2(gelu_tanh(a[0]), gelu_tanh(a[1])); w.y = pk2(gelu_tanh(a[2]), gelu_tanh(a[3]));
                            *(u32x2*)(dst + bj * HALF + 16 * n) = w; } }
        } else {
#pragma unroll
            for (int ai = 0; ai < 2; ++ai)
#pragma unroll
                for (int m = 0; m < 4; ++m) { bf16_t* dst = yc + (size_t)(rowb + ai * HALF + m * 16) * 256 + (pn - 5) * 128 + wc * 32 + 4 * fq;
#pragma unroll
                    for (int n = 0; n < 2; ++n) { const f32x4 a = acc[ai][0][m][n], g = acc[ai][1][m][n]; u32x2 w;
                        w.x = pk2(a[0] * fast_sigmoid(g[0]), a[1] * fast_sigmoid(g[1])); w.y = pk2(a[2] * fast_sigmoid(g[2]), a[3] * fast_sigmoid(g[3]));
                        *(u32x2*)(dst + 16 * n) = w; } }
        }
    }
};
template <class Epi, class Sched, bool ALIGN_EPI = false, bool SP2 = false>
__device__ __forceinline__ void gemm_phase(PG8_LAS unsigned char* lds, const Gemm g, const Sched& S, const Epi& E) {
    const int tid = mk_tid(), wid = __builtin_amdgcn_readfirstlane(tid >> 6), lane = tid & 63, wr = wid >> 2, wc = wid & 3, fr = lane & 15, fq = lane >> 4;
    const int K = g.K, nt = K / BK;
    unsigned voffA[2], voffB[2];
#pragma unroll
    for (int i = 0; i < 2; ++i) { int R, C; stage_rc(tid * 16 + i * 8192, R, C); const int Rb = Epi::PERM ? ((R & ~31) + perm32(R & 31)) : R;
        voffA[i] = (unsigned)(R * K + C) * 2u; voffB[i] = (unsigned)(Rb * K + C) * 2u; }
    const size_t kstep = (size_t)(BK * 2);
    const size_t hstep = (size_t)HALF * K * 2;
    const size_t tstep = 2 * hstep;
    const unsigned ldsw = (unsigned)wid * 1024u;
    const int aoff = lds_byte(wr * 64 + fr, fq * 8), boff = lds_byte(wc * 32 + fr, fq * 8);
#define PG8_SA(b, h) (((b) * 2 + (h)) * HTB)
#define PG8_SB(b, h) ((4 + (b) * 2 + (h)) * HTB)
#define PG8_STAGE(bufoff, gbase, voff) do { _Pragma("unroll") for (int _i = 0; _i < 2; ++_i) \
        __builtin_amdgcn_global_load_lds((const unsigned*)((const char*)(gbase) + (voff)[_i]), (PG8_LAS unsigned*)(lds + (bufoff) + ldsw + _i * 8192), 16, 0, 0); } while (0)
#define PG8_LDA(dst, b, h) do { _Pragma("unroll") for (int m = 0; m < 4; ++m) _Pragma("unroll") for (int k = 0; k < 2; ++k) dst[m][k] = *(const PG8_LAS bf16x8*)(lds + PG8_SA(b, h) + aoff + m * 2048 + k * 1024); } while (0)
#define PG8_LDB(dst, b, h) do { _Pragma("unroll") for (int n = 0; n < 2; ++n) _Pragma("unroll") for (int k = 0; k < 2; ++k) dst[n][k] = *(const PG8_LAS bf16x8*)(lds + PG8_SB(b, h) + boff + n * 2048 + k * 1024); } while (0)
#define PG8_MMA(ai, bj, At, Bt) do { __builtin_amdgcn_s_setprio(1); _Pragma("unroll") for (int m = 0; m < 4; ++m) _Pragma("unroll") for (int n = 0; n < 2; ++n) _Pragma("unroll") for (int k = 0; k < 2; ++k) \
        acc[ai][bj][m][n] = __builtin_amdgcn_mfma_f32_16x16x32_bf16(Bt[n][k], At[m][k], acc[ai][bj][m][n], 0, 0, 0); __builtin_amdgcn_s_setprio(0); } while (0)
#define PG8_WAIT_V(n) asm volatile("s_waitcnt vmcnt(" #n ")" ::: "memory")
#define PG8_WAIT_L(n) asm volatile("s_waitcnt lgkmcnt(" #n ")" ::: "memory")
#define PG8_BAR __builtin_amdgcn_s_barrier()
#define PG8_SCHED __builtin_amdgcn_sched_barrier(0)
    Unit cur, nxt; int ui = 0;
    if (!S.next(0, cur)) return;
    f32x4 acc[2][2][4][2];
#pragma unroll
    for (int a = 0; a < 2; ++a)
#pragma unroll
        for (int b = 0; b < 2; ++b)
#pragma unroll
            for (int m = 0; m < 4; ++m)
#pragma unroll
                for (int n = 0; n < 2; ++n) acc[a][b][m][n] = (f32x4){0.f, 0.f, 0.f, 0.f};
    bf16x8 At[4][2], B0[2][2], B1[2][2];
    const char* cA = (const char*)g.A + (size_t)cur.pm * tstep; const char* cB = (const char*)g.Bt + (size_t)cur.pn * tstep;
    S.a_ready(cur);
    if constexpr (SP2) {
        PG8_STAGE(PG8_SB(0, 0), cB, voffB); PG8_STAGE(PG8_SB(0, 1), cB + hstep, voffB); PG8_STAGE(PG8_SA(0, 0), cA, voffA); PG8_STAGE(PG8_SA(0, 1), cA + hstep, voffA);
        if (wr == 1) PG8_BAR;
        PG8_WAIT_V(2); PG8_BAR;
        PG8_STAGE(PG8_SB(1, 0), cB + kstep, voffB); PG8_STAGE(PG8_SA(1, 0), cA + kstep, voffA); PG8_STAGE(PG8_SB(1, 1), cB + hstep + kstep, voffB);
        PG8_WAIT_V(6); PG8_BAR;
    } else {
        PG8_STAGE(PG8_SB(0, 0), cB, voffB); PG8_STAGE(PG8_SA(0, 0), cA, voffA); PG8_STAGE(PG8_SB(0, 1), cB + hstep, voffB); PG8_STAGE(PG8_SA(0, 1), cA + hstep, voffA);
        if (wr == 1) PG8_BAR;
        PG8_WAIT_V(4); PG8_BAR;
        PG8_STAGE(PG8_SB(1, 0), cB + kstep, voffB); PG8_STAGE(PG8_SA(1, 0), cA + kstep, voffA); PG8_STAGE(PG8_SB(1, 1), cB + hstep + kstep, voffB);
        PG8_WAIT_V(6); PG8_BAR;
    }
    for (;;) {
        const bool has_next = S.next(ui + 1, nxt);
        const char* nA = has_next ? (const char*)g.A + (size_t)nxt.pm * tstep : cA; const char* nB = has_next ? (const char*)g.Bt + (size_t)nxt.pn * tstep : cB;
        for (int t = 0; t < nt; t += 2) {
            const bool last = (t == nt - 2);
            const char* a1 = cA + (size_t)(t + 1) * kstep;
            const char* a2 = last ? nA : cA + (size_t)(t + 2) * kstep; const char* b2 = last ? nB : cB + (size_t)(t + 2) * kstep;
            const char* a3 = a2 + kstep; const char* b3 = b2 + kstep;
            if (last && has_next) S.a_ready(nxt);
            if constexpr (SP2) {
            PG8_LDB(B0, 0, 0); PG8_LDB(B1, 0, 1); PG8_SCHED; PG8_LDA(At, 0, 0); PG8_STAGE(PG8_SA(1, 1), a1 + hstep, voffA);
            PG8_WAIT_V(8); PG8_WAIT_L(0); PG8_BAR; PG8_MMA(0, 0, At, B0); PG8_MMA(0, 1, At, B1); PG8_BAR; PG8_SCHED;
            PG8_LDA(At, 0, 1); PG8_STAGE(PG8_SB(0, 0), b2, voffB); PG8_STAGE(PG8_SB(0, 1), b2 + hstep, voffB); PG8_STAGE(PG8_SA(0, 0), a2, voffA);
            PG8_WAIT_V(8); PG8_WAIT_L(0); PG8_BAR; PG8_MMA(1, 0, At, B0); PG8_MMA(1, 1, At, B1); PG8_BAR; PG8_SCHED;
            PG8_LDB(B0, 1, 0); PG8_LDB(B1, 1, 1); PG8_SCHED; PG8_LDA(At, 1, 0); PG8_STAGE(PG8_SA(0, 1), a2 + hstep, voffA);
            PG8_WAIT_V(8); PG8_WAIT_L(0); PG8_BAR; PG8_MMA(0, 0, At, B0); PG8_MMA(0, 1, At, B1); PG8_BAR; PG8_SCHED;
            PG8_LDA(At, 1, 1); PG8_STAGE(PG8_SB(1, 0), b3, voffB); PG8_STAGE(PG8_SB(1, 1), b3 + hstep, voffB); PG8_STAGE(PG8_SA(1, 0), a3, voffA);
            PG8_WAIT_V(8); PG8_WAIT_L(0); PG8_BAR; PG8_MMA(1, 0, At, B0); PG8_MMA(1, 1, At, B1); PG8_BAR; PG8_SCHED;
            } else {
            PG8_LDB(B0, 0, 0); PG8_SCHED; PG8_LDA(At, 0, 0); PG8_STAGE(PG8_SA(1, 1), a1 + hstep, voffA);
            PG8_WAIT_L(8); PG8_BAR; PG8_WAIT_L(0); PG8_MMA(0, 0, At, B0); PG8_BAR; PG8_SCHED;
            PG8_LDB(B1, 0, 1); PG8_STAGE(PG8_SB(0, 0), b2, voffB);
            PG8_BAR; PG8_WAIT_L(0); PG8_MMA(0, 1, At, B1); PG8_BAR;
            PG8_LDA(At, 0, 1); PG8_STAGE(PG8_SA(0, 0), a2, voffA);
            PG8_BAR; PG8_WAIT_L(0); PG8_MMA(1, 0, At, B0); PG8_BAR; PG8_SCHED;
            PG8_STAGE(PG8_SB(0, 1), b2 + hstep, voffB);
            PG8_WAIT_V(6); PG8_BAR; PG8_MMA(1, 1, At, B1); PG8_BAR;
            PG8_LDB(B0, 1, 0); PG8_SCHED; PG8_LDA(At, 1, 0); PG8_STAGE(PG8_SA(0, 1), a2 + hstep, voffA);
            PG8_WAIT_L(8); PG8_BAR; PG8_WAIT_L(0); PG8_MMA(0, 0, At, B0); PG8_BAR; PG8_SCHED;
            PG8_LDB(B1, 1, 1); PG8_STAGE(PG8_SB(1, 0), b3, voffB);
            PG8_BAR; PG8_WAIT_L(0); PG8_MMA(0, 1, At, B1); PG8_BAR;
            PG8_LDA(At, 1, 1); PG8_STAGE(PG8_SA(1, 0), a3, voffA);
            PG8_BAR; PG8_WAIT_L(0); PG8_MMA(1, 0, At, B0); PG8_BAR; PG8_SCHED;
            PG8_STAGE(PG8_SB(1, 1), b3 + hstep, voffB);
            PG8_WAIT_V(6); PG8_BAR; PG8_MMA(1, 1, At, B1); PG8_BAR;
            }
        }
        if constexpr (ALIGN_EPI) { if (wr == 0) PG8_BAR; }
        if constexpr (!Epi::AFTER_DRAIN) { E(acc, cur, wr, wc, fr, fq); S.done(cur); }
        if (!has_next) break;
#pragma unroll
        for (int a = 0; a < 2; ++a)
#pragma unroll
            for (int b = 0; b < 2; ++b)
#pragma unroll
                for (int m = 0; m < 4; ++m)
#pragma unroll
                    for (int n = 0; n < 2; ++n) acc[a][b][m][n] = (f32x4){0.f, 0.f, 0.f, 0.f};
        cur = nxt; cA = nA; cB = nB; ++ui;
        if constexpr (ALIGN_EPI) { if (wr == 1) PG8_BAR; }
    }
    PG8_WAIT_V(0);
    if constexpr (!ALIGN_EPI) { if (wr == 0) PG8_BAR; }
    PG8_BAR;
    if constexpr (Epi::AFTER_DRAIN) { E.fused(acc, cur, wr, wc, fr, fq, lds, wid, lane); S.done(cur); }
#undef PG8_SA
#undef PG8_SB
#undef PG8_STAGE
#undef PG8_LDA
#undef PG8_LDB
#undef PG8_MMA
#undef PG8_WAIT_V
#undef PG8_WAIT_L
#undef PG8_BAR
#undef PG8_SCHED
}
}
namespace attn_body {
using bf16=__hip_bfloat16;
using bf16x8=__attribute__((ext_vector_type(8)))short;
using s16x4=__attribute__((ext_vector_type(4)))short;
using f32x16=__attribute__((ext_vector_type(16)))float;
using u32x4=__attribute__((ext_vector_type(4)))unsigned;
constexpr int D=64;
constexpr int DMQ=512, DMKV=256, DMO=1024;
constexpr int NW=8,QBLK=32,QB=QBLK*NW,KVBLK=64;
constexpr int ATTN_UNIT_ROWS=QB;
__device__ __forceinline__ int crow(int r,int hi){return (r&3)+8*(r>>2)+4*hi;}
#define SBAR() __builtin_amdgcn_sched_barrier(0)
constexpr int NSLOT=3, SLOTB=8192;
constexpr int LDS_K=0, LDS_V=NSLOT*SLOTB, LDS_WS=2*NSLOT*SLOTB, LDS_OST=LDS_WS+NW*64*4, LDS_BYTES=LDS_OST+NW*4096;
__device__ __forceinline__ void glds16(const void*gsrc,unsigned lds_dst){unsigned keep;
  asm volatile("s_mov_b32 %0, m0\n\ts_mov_b32 m0, %2\n\ts_nop 0\n\tglobal_load_lds_dwordx4 %1, off\n\ts_mov_b32 m0, %0":"=&s"(keep):"v"(gsrc),"s"(lds_dst):"memory");}
__device__ __forceinline__ float max3f(float a,float b,float c){float r;asm("v_max3_f32 %0, %1, %2, %3":"=v"(r):"v"(a),"v"(b),"v"(c));return r;}
__device__ __forceinline__ float max2f(float a,float b){float r;asm("v_max_f32_e32 %0, %1, %2":"=v"(r):"v"(a),"v"(b));return r;}
__device__ __forceinline__ float fadd_s(float a,float b){float r;asm("v_add_f32_e32 %0, %1, %2":"=v"(r):"v"(a),"v"(b));return r;}
__device__ __forceinline__ float fsub_s(float a,float b){float r;asm("v_sub_f32_e32 %0, %1, %2":"=v"(r):"v"(a),"v"(b));return r;}
typedef float f32x2_t __attribute__((ext_vector_type(2))); typedef __bf16 bf16x2_t __attribute__((ext_vector_type(2)));
__device__ __forceinline__ unsigned cvtpk_s(float lo,float hi){f32x2_t v={lo,hi};bf16x2_t b=__builtin_convertvector(v,bf16x2_t);return __builtin_bit_cast(unsigned,b);}
#define WAIT_BAR(N) asm volatile("s_waitcnt vmcnt(" #N ") lgkmcnt(0)\n\ts_barrier":::"memory")

__device__ __forceinline__ void qkt(f32x16&p0,f32x16&p1,const char*Kslot,const bf16x8*qr,const f32x16&negm,int r32,int hi){
  const char*kb=Kslot+hi*1024+r32*16;
  #pragma unroll
  for(int d0=0;d0<4;++d0){
    const bf16x8 b0=*reinterpret_cast<const bf16x8*>(kb+d0*2048);
    const bf16x8 b1=*reinterpret_cast<const bf16x8*>(kb+d0*2048+512);
    if(d0==0){p0=__builtin_amdgcn_mfma_f32_32x32x16_bf16(b0,qr[0],negm,0,0,0);p1=__builtin_amdgcn_mfma_f32_32x32x16_bf16(b1,qr[0],negm,0,0,0);}
    else{p0=__builtin_amdgcn_mfma_f32_32x32x16_bf16(b0,qr[d0],p0,0,0,0);p1=__builtin_amdgcn_mfma_f32_32x32x16_bf16(b1,qr[d0],p1,0,0,0);}}
}
typedef __attribute__((address_space(3))) const char* lds_cptr;
typedef short v4i16_t __attribute__((ext_vector_type(4)));
__device__ __forceinline__ void kload8(bf16x8*kf,lds_cptr kp){
  kf[0]=*(const __attribute__((address_space(3))) bf16x8*)(kp);      kf[1]=*(const __attribute__((address_space(3))) bf16x8*)(kp+512);
  kf[2]=*(const __attribute__((address_space(3))) bf16x8*)(kp+2048); kf[3]=*(const __attribute__((address_space(3))) bf16x8*)(kp+2560);
  kf[4]=*(const __attribute__((address_space(3))) bf16x8*)(kp+4096); kf[5]=*(const __attribute__((address_space(3))) bf16x8*)(kp+4608);
  kf[6]=*(const __attribute__((address_space(3))) bf16x8*)(kp+6144); kf[7]=*(const __attribute__((address_space(3))) bf16x8*)(kp+6656);
}
__device__ __forceinline__ void kload2(bf16x8*kf,lds_cptr kp,int j){ kf[2*j]=*(const __attribute__((address_space(3))) bf16x8*)(kp+j*2048); kf[2*j+1]=*(const __attribute__((address_space(3))) bf16x8*)(kp+j*2048+512); }
__device__ __forceinline__ s16x4 vtr(lds_cptr p){ return __builtin_bit_cast(s16x4,__builtin_amdgcn_ds_read_tr16_b64_v4i16((__attribute__((address_space(3))) v4i16_t*)p)); }
__device__ __forceinline__ float rowmax(const f32x16&p0,const f32x16&p1){
  float a=max3f(p0[0],p0[1],p1[0]),b=max3f(p0[2],p0[3],p1[1]);a=max3f(a,p1[2],p1[3]);
  #pragma unroll
  for(int r=4;r<16;r+=4){a=max3f(a,p0[r],p0[r+1]);b=max3f(b,p0[r+2],p0[r+3]);a=max3f(a,p1[r],p1[r+1]);b=max3f(b,p1[r+2],p1[r+3]);}
  const float m=max2f(a,b);
  auto rr=__builtin_amdgcn_permlane32_swap(__float_as_uint(m),__float_as_uint(m),false,false);
  return max2f(__uint_as_float(rr[0]),__uint_as_float(rr[1]));
}
__device__ __forceinline__ void pv(f32x16*o,int vb,bf16x8 pa0,bf16x8 pa1,bf16x8 pa2,bf16x8 pa3){
  #pragma unroll
  for(int d0=0;d0<2;++d0){s16x4 lo[4],hi[4];
    #pragma unroll
    for(int ks=0;ks<4;++ks){
      asm volatile("ds_read_b64_tr_b16 %0,%1 offset:%c2":"=&v"(lo[ks]):"v"(vb),"i"(d0*4096+ks*1024):"memory");
      asm volatile("ds_read_b64_tr_b16 %0,%1 offset:%c2":"=&v"(hi[ks]):"v"(vb),"i"(d0*4096+ks*1024+512):"memory");}
    asm volatile("s_waitcnt lgkmcnt(0)":::"memory");SBAR();
    #define PK(k) (bf16x8){lo[k][0],lo[k][1],lo[k][2],lo[k][3],hi[k][0],hi[k][1],hi[k][2],hi[k][3]}
    o[d0]=__builtin_amdgcn_mfma_f32_32x32x16_bf16(pa0,PK(0),o[d0],0,0,0);
    o[d0]=__builtin_amdgcn_mfma_f32_32x32x16_bf16(pa1,PK(1),o[d0],0,0,0);
    o[d0]=__builtin_amdgcn_mfma_f32_32x32x16_bf16(pa2,PK(2),o[d0],0,0,0);
    o[d0]=__builtin_amdgcn_mfma_f32_32x32x16_bf16(pa3,PK(3),o[d0],0,0,0);
    #undef PK
  }
}

#ifndef ATTN_STORE16
#define ATTN_STORE16(p,v) (*(u32x4*)(p)=(v))
#endif
template<int THRL> __device__ __forceinline__ void attn_unit(const bf16*Q0,const bf16*__restrict__ K0,const bf16*__restrict__ V0,bf16*O0,const int NT,char*shm){
  const int tid=mk_tid(),lane=tid&63,r32=lane&31,hi=lane>>5; const int wid=__builtin_amdgcn_readfirstlane(tid>>6);
  const bf16*Qw=Q0+(long)(wid*QBLK)*DMQ;
  const bf16*Kh=K0,*Vh=V0;
  const unsigned lds0=(unsigned)(uintptr_t)shm;
  float*wsf=(float*)(shm+LDS_WS)+wid*64;
  const bf16*ksrc=Kh+(long)lane*DMKV+wid*8;
  const bf16*vsrc=Vh+(long)(16*(wid&3)+(lane>>2))*DMKV+(wid>>2)*32+(lane&3)*8;
  const unsigned kdst=lds0+LDS_K+wid*1024, vdst=lds0+LDS_V+wid*1024;
  #define DMA_K(t,slot) glds16(ksrc+(long)(t)*KVBLK*DMKV,(unsigned)__builtin_amdgcn_readfirstlane(kdst+(slot)))
  #define DMA_V(t,slot) glds16(vsrc+(long)(t)*KVBLK*DMKV,(unsigned)__builtin_amdgcn_readfirstlane(vdst+(slot)))
  const int vb0=(int)(lds0+LDS_V)+((lane>>4)&1)*32+(lane&3)*8+(4*hi+((lane&15)>>2))*64;
  const char*Kbase=shm+LDS_K; bf16x8 kf[8];
  const lds_cptr shm3=(lds_cptr)shm; const lds_cptr kp0=shm3+LDS_K+hi*1024+r32*16; const lds_cptr vp0=shm3+LDS_V+((lane>>4)&1)*32+(lane&3)*8+(4*hi+((lane&15)>>2))*64;
  DMA_K(0,0);DMA_V(0,0);DMA_K(1,SLOTB);
  bf16x8 qr[4];
  #pragma unroll
  for(int d0=0;d0<4;++d0)qr[d0]=*reinterpret_cast<const bf16x8*>(&Qw[(long)r32*DMQ+d0*16+hi*8]);
  float mhat=0.f,l_reg=0.f;f32x16 o[2];o[0]=f32x16{};o[1]=f32x16{};f32x16 negm=f32x16{};asm volatile("":"+v"(negm));
  #define CMASK(P0,P1,t) do{}while(0)
  bool resc=false;
  #define START(P0,P1) do{ const float rm=rowmax(P0,P1); resc=false; \
    { const float dl=rm; mhat=fadd_s(mhat,dl); \
      _Pragma("unroll") for(int r=0;r<16;++r){P0[r]=fsub_s(P0[r],dl);P1[r]=fsub_s(P1[r],dl);} \
      _Pragma("unroll") for(int r=0;r<16;++r)negm[r]=-mhat; asm volatile("":"+v"(negm)); } \
    _Pragma("unroll") for(int r=0;r<16;++r)P0[r]=__builtin_amdgcn_exp2f(P0[r]); }while(0)
  #define RESC() do{ if(resc){ asm volatile("s_waitcnt lgkmcnt(0)":::"memory"); \
      _Pragma("unroll") for(int d_=0;d_<2;++d_) _Pragma("unroll") for(int r=0;r<16;++r)o[d_][r]*=wsf[crow(r,hi)]; } }while(0)
  f32x16 pA0,pA1,pB0,pB1;
  int sl_prev=0,sl_cur=0,sl_next=SLOTB;
  #define ROT() do{sl_prev=sl_cur;sl_cur=sl_next;sl_next=(sl_next==(NSLOT-1)*SLOTB)?0:sl_next+SLOTB;}while(0)
  DMA_K(2,2*SLOTB);
  WAIT_BAR(3);
  qkt(pA0,pA1,Kbase,qr,negm,r32,hi);asm volatile("s_nop 15\n\ts_nop 7":"+v"(pA0),"+v"(pA1));CMASK(pA0,pA1,0);
  START(pA0,pA1);
  _Pragma("unroll") for(int r=0;r<16;++r)pA1[r]=__builtin_amdgcn_exp2f(pA1[r]);
  WAIT_BAR(0);
  DMA_K(3,0);DMA_V(1,SLOTB);
  ROT();
  kload8(kf,kp0+sl_cur);
  WAIT_BAR(2);
  s16x4 vlo[8],vhi[8]; u32x4 pw0,pw1,pw2,pw3;
  #define PKW(P,B) cvtpk_s(P[B],P[B+1])
  #define PAF(k) __builtin_bit_cast(bf16x8,pw##k)
  #define VFR(i) (bf16x8){vlo[i][0],vlo[i][1],vlo[i][2],vlo[i][3],vhi[i][0],vhi[i][1],vhi[i][2],vhi[i][3]}
  #define PIN(x) asm volatile("":"+v"(x))
  #define MX3(a,b,c) __builtin_fmaxf(__builtin_fmaxf((a),(b)),(c))
  #define GAPA(MF,A0,A1,A2,A3,W0,W1,PW) do{ MF; sacc+=A0; sacc+=A1; sacc+=A2; sacc+=A3; PIN(sacc); W0; W1; PIN(PW); SBAR(); }while(0)
  #define EX(v) __builtin_amdgcn_exp2f(v)
  #define GAPB(MF,X,B) do{ MF; X[B]=EX(X[B]); X[B+1]=EX(X[B+1]); X[B+2]=EX(X[B+2]); X[B+3]=EX(X[B+3]); PIN(X); SBAR(); }while(0)
  #define VRD(i) do{ vlo[i]=vtr(vp_+(((i)>>2)*4096+((i)&3)*1024)); vhi[i]=vtr(vp_+(((i)>>2)*4096+((i)&3)*1024+512)); }while(0)
  #define KRD(G,j) do{ if(G){ kload2(kf,kp0+sl_next,j); SBAR(); } }while(0)
  #define STEP(C0,C1,P0,P1,t,GK,GV,GL) do{ SBAR(); \
    const lds_cptr vp_=vp0+sl_prev; \
    VRD(0); SBAR(); float sacc=(P0[0]+P0[1]); \
    GAPA(C0=__builtin_amdgcn_mfma_f32_32x32x16_bf16(kf[0],qr[0],negm,0,0,0), P0[2],P0[3],P0[4],P0[5],     pw0[0]=PKW(P0,0), pw0[1]=PKW(P0,2), pw0); \
    VRD(4); SBAR(); GAPA(C1=__builtin_amdgcn_mfma_f32_32x32x16_bf16(kf[1],qr[0],negm,0,0,0), P0[6],P0[7],P0[8],P0[9],     pw0[2]=PKW(P0,4), pw0[3]=PKW(P0,6), pw0); \
    VRD(1); SBAR(); GAPA(C0=__builtin_amdgcn_mfma_f32_32x32x16_bf16(kf[2],qr[1],C0,0,0,0),   P0[10],P0[11],P0[12],P0[13], pw1[0]=PKW(P0,8), pw1[1]=PKW(P0,10), pw1); \
    VRD(5); SBAR(); GAPA(C1=__builtin_amdgcn_mfma_f32_32x32x16_bf16(kf[3],qr[1],C1,0,0,0),   P0[14],P0[15],P1[0],P1[1],   pw1[2]=PKW(P0,12),pw1[3]=PKW(P0,14), pw1); \
    VRD(2); SBAR(); GAPA(C0=__builtin_amdgcn_mfma_f32_32x32x16_bf16(kf[4],qr[2],C0,0,0,0),   P1[2],P1[3],P1[4],P1[5],     pw2[0]=PKW(P1,0), pw2[1]=PKW(P1,2), pw2); \
    VRD(6); SBAR(); GAPA(C1=__builtin_amdgcn_mfma_f32_32x32x16_bf16(kf[5],qr[2],C1,0,0,0),   P1[6],P1[7],P1[8],P1[9],     pw2[2]=PKW(P1,4), pw2[3]=PKW(P1,6), pw2); \
    VRD(3); SBAR(); GAPA(C0=__builtin_amdgcn_mfma_f32_32x32x16_bf16(kf[6],qr[3],C0,0,0,0),   P1[10],P1[11],P1[12],P1[13], pw3[0]=PKW(P1,8), pw3[1]=PKW(P1,10), pw3); \
    VRD(7); SBAR(); GAPA(C1=__builtin_amdgcn_mfma_f32_32x32x16_bf16(kf[7],qr[3],C1,0,0,0),   P1[14],P1[15],0.f,0.f,       pw3[2]=PKW(P1,12),pw3[3]=PKW(P1,14), pw3); \
    l_reg+=sacc; \
    if(GK){DMA_K((t)+3,sl_cur);} if(GV){DMA_V((t)+1,sl_next);} \
    CMASK(C0,C1,t); \
    { float a=MX3(C0[0],C0[1],C1[0]),b=MX3(C0[2],C0[3],C1[1]); a=MX3(a,C1[2],C1[3]); \
      _Pragma("unroll") for(int r=4;r<16;r+=4){a=MX3(a,C0[r],C0[r+1]);b=MX3(b,C0[r+2],C0[r+3]);a=MX3(a,C1[r],C1[r+1]);b=MX3(b,C1[r+2],C1[r+3]);} \
      float rm=__builtin_fmaxf(a,b); { auto rr=__builtin_amdgcn_permlane32_swap(__float_as_uint(rm),__float_as_uint(rm),false,false); rm=__builtin_fmaxf(__uint_as_float(rr[0]),__uint_as_float(rr[1])); } \
      resc=false; \
      if(__builtin_expect(__any(rm>(float)THRL),0)){ const float dl=__builtin_fmaxf(rm,0.f); mhat+=dl; \
        _Pragma("unroll") for(int r=0;r<16;++r){C0[r]-=dl;C1[r]-=dl;} \
        _Pragma("unroll") for(int r=0;r<16;++r)negm[r]=-mhat; asm volatile("":"+v"(negm)); \
        const float f=__builtin_amdgcn_exp2f(-dl); l_reg*=f; if(hi==0)wsf[r32]=f; resc=true; } } \
    SBAR(); \
    GAPB(o[0]=__builtin_amdgcn_mfma_f32_32x32x16_bf16(PAF(0),VFR(0),o[0],0,0,0), C0,0); \
    GAPB(o[1]=__builtin_amdgcn_mfma_f32_32x32x16_bf16(PAF(0),VFR(4),o[1],0,0,0), C0,4); \
    KRD(GL,0); GAPB(o[0]=__builtin_amdgcn_mfma_f32_32x32x16_bf16(PAF(1),VFR(1),o[0],0,0,0), C0,8); \
    KRD(GL,1); GAPB(o[1]=__builtin_amdgcn_mfma_f32_32x32x16_bf16(PAF(1),VFR(5),o[1],0,0,0), C0,12); \
    KRD(GL,2); GAPB(o[0]=__builtin_amdgcn_mfma_f32_32x32x16_bf16(PAF(2),VFR(2),o[0],0,0,0), C1,0); \
    KRD(GL,3); GAPB(o[1]=__builtin_amdgcn_mfma_f32_32x32x16_bf16(PAF(2),VFR(6),o[1],0,0,0), C1,4); \
    GAPB(o[0]=__builtin_amdgcn_mfma_f32_32x32x16_bf16(PAF(3),VFR(3),o[0],0,0,0), C1,8); \
    GAPB(o[1]=__builtin_amdgcn_mfma_f32_32x32x16_bf16(PAF(3),VFR(7),o[1],0,0,0), C1,12); \
    }while(0)
  int t=1;
  #undef CMASK
  #define CMASK(P0,P1,t) do{}while(0)
  for(;t+5<NT;t+=2){
    STEP(pB0,pB1,pA0,pA1,t,true,true,true);     WAIT_BAR(2); RESC(); ROT();
    STEP(pA0,pA1,pB0,pB1,t+1,true,true,true);   WAIT_BAR(2); RESC(); ROT();
  }
  #undef CMASK
  #define CMASK(P0,P1,t) do{}while(0)
  #define ENDW(tt) do{ if((tt)+3<NT){WAIT_BAR(2);} else if((tt)+2<NT){WAIT_BAR(1);} else {WAIT_BAR(0);} }while(0)
  for(;t+1<NT;t+=2){
    STEP(pB0,pB1,pA0,pA1,t,(t+3<NT),(t+1<NT),(t+1<NT));       ENDW(t);   RESC(); ROT();
    STEP(pA0,pA1,pB0,pB1,t+1,(t+4<NT),(t+2<NT),(t+2<NT));     ENDW(t+1); RESC(); ROT();
  }
  STEP(pB0,pB1,pA0,pA1,NT-1,false,false,false); RESC();
  { float sacc=pB0[0]+pB0[1]; _Pragma("unroll") for(int r=2;r<16;++r)sacc+=pB0[r]; _Pragma("unroll") for(int r=0;r<16;++r)sacc+=pB1[r]; l_reg+=sacc;
    pw0=(u32x4){PKW(pB0,0),PKW(pB0,2),PKW(pB0,4),PKW(pB0,6)};pw1=(u32x4){PKW(pB0,8),PKW(pB0,10),PKW(pB0,12),PKW(pB0,14)};pw2=(u32x4){PKW(pB1,0),PKW(pB1,2),PKW(pB1,4),PKW(pB1,6)};pw3=(u32x4){PKW(pB1,8),PKW(pB1,10),PKW(pB1,12),PKW(pB1,14)};
    SBAR(); pv(o,vb0+sl_cur,PAF(0),PAF(1),PAF(2),PAF(3)); }
  #undef PKW
  #undef PAF
  #undef VFR
  #undef PIN
  #undef MX3
  #undef GAPA
  #undef GAPB
  #undef EX
  #undef VRD
  #undef KRD
  #undef STEP
  #undef ENDW
  {auto rr=__builtin_amdgcn_permlane32_swap(__float_as_uint(l_reg),__float_as_uint(l_reg),false,false);l_reg=__uint_as_float(rr[0])+__uint_as_float(rr[1]);}
  if(hi==0)wsf[32+r32]=l_reg;asm volatile("s_waitcnt lgkmcnt(0)":::"memory");
  float rli[16];
  #pragma unroll
  for(int r=0;r<16;++r)rli[r]=__builtin_amdgcn_rcpf(wsf[32+crow(r,hi)]);
  bf16*Ow=O0+(long)(wid*QBLK)*DMO;
  { bf16*stg=(bf16*)(shm+LDS_OST)+wid*2048;
    #pragma unroll
    for(int r=0;r<16;++r){const int orow=crow(r,hi);
      #pragma unroll
      for(int d0=0;d0<2;++d0)stg[orow*64+d0*32+r32]=__float2bfloat16(o[d0][r]*rli[r]);}
    asm volatile("s_waitcnt lgkmcnt(0)":::"memory");
    #pragma unroll
    for(int i=0;i<4;++i){const int row=i*8+(lane>>3),ch=lane&7; const u32x4 v=*(const u32x4*)(stg+row*64+ch*8); ATTN_STORE16(Ow+(long)row*DMO+ch*8,v);} }
  asm volatile("s_waitcnt lgkmcnt(0)\n\ts_barrier":::"memory");
  #undef DMA_K
  #undef DMA_V
  #undef CMASK
  #undef START
  #undef RESC
  #undef ROT
}
constexpr int ATTN_LDS_BYTES=LDS_BYTES;
#undef SBAR
#undef WAIT_BAR
}
#define XB_TMO      128
#define XB_XCNT(j)  (256  + 64 * (j))
#define XB_XSUB(j)  (1280 + 64 * (j))
#define XB_XGEN(j)  (2304 + 64 * (j))
#define XB_TOP      3328
#define XB_TOPGEN   3392
#define XCD_BAR_WORDS 3456
#define XB_SPIN_CAP (1u << 18)
__device__ __forceinline__ unsigned xb_ld(unsigned* p)              { return __hip_atomic_load(p, __ATOMIC_RELAXED, __HIP_MEMORY_SCOPE_AGENT); }
__device__ __forceinline__ unsigned xb_add(unsigned* p, unsigned v) { return __hip_atomic_fetch_add(p, v, __ATOMIC_RELAXED, __HIP_MEMORY_SCOPE_AGENT); }
__device__ __forceinline__ unsigned xb_xcc_id() { return (unsigned)__builtin_amdgcn_s_getreg((3 << 11) | 20) & 0xFu; }
#define XB_SPIN(cond, bar) do { unsigned _sp = 0; while (cond) { __builtin_amdgcn_s_sleep(1); \
    if ((++_sp & 255u) == 0u) { if (xb_ld(&(bar)[XB_TMO])) break; if (_sp > XB_SPIN_CAP) { atomicAdd(&(bar)[XB_TMO], 1u); break; } } } } while (0)

struct XcdBarrier {
    unsigned* bar; unsigned x;
    volatile LAS unsigned* st;
};

__device__ __forceinline__ XcdBarrier xcd_barrier_post(unsigned* bar, volatile LAS unsigned* st) {
    XcdBarrier b; b.bar = bar; b.x = xb_xcc_id(); b.st = st;
    if (threadIdx.x == 0) (void)xb_add(&bar[XB_XCNT(b.x)], 1u);
    return b;
}
__device__ __forceinline__ void xcd_barrier_complete(unsigned* bar, unsigned x, unsigned& nloc, unsigned& nx) {
    const unsigned G = gridDim.x * gridDim.y * gridDim.z;
    unsigned sum, cnt, mine, sp = 0u;
    for (;;) {
        sum = 0u; cnt = 0u; mine = 0u;
#pragma unroll
        for (unsigned j = 0; j < 16; ++j) { const unsigned c = xb_ld(&bar[XB_XCNT(j)]); sum += c; cnt += (c > 0u) ? 1u : 0u; mine = (j == x) ? c : mine; }
        if (sum == G) break;
        __builtin_amdgcn_s_sleep(1);
        if ((++sp & 255u) == 0u) { if (xb_ld(&bar[XB_TMO])) break; if (sp > XB_SPIN_CAP) { atomicAdd(&bar[XB_TMO], 1u); break; } }
    }
    nloc = mine > 0u ? mine : 1u; nx = cnt > 0u ? cnt : 1u;
}

__device__ __forceinline__ void xcd_barrier(const XcdBarrier& b) {
    asm volatile("s_waitcnt vmcnt(0)" ::: "memory");
    __syncthreads();
    if (threadIdx.x == 0) {
        unsigned* bar = b.bar;
        __builtin_amdgcn_s_waitcnt(0);
        unsigned nloc = b.st[0], nx = b.st[1];
        if (nloc == 0u) { xcd_barrier_complete(bar, b.x, nloc, nx); b.st[0] = nloc; b.st[1] = nx; }
        const unsigned old = xb_add(&bar[XB_XSUB(b.x)], 1u);
        const unsigned gen = old / nloc;
        if (old + 1u == (gen + 1u) * nloc) {
            __builtin_amdgcn_fence(__ATOMIC_RELEASE, "agent");
            asm volatile("s_waitcnt vmcnt(0)" ::: "memory");
            const unsigned og = xb_add(&bar[XB_TOP], 1u);
            const unsigned tg = og / nx;
            if (og + 1u == (tg + 1u) * nx) xb_add(&bar[XB_TOPGEN], 1u);
            else XB_SPIN(xb_ld(&bar[XB_TOPGEN]) == tg, bar);
            __builtin_amdgcn_fence(__ATOMIC_ACQUIRE, "agent");
            xb_add(&bar[XB_XGEN(b.x)], 1u);
            asm volatile("s_waitcnt vmcnt(0)" ::: "memory");
        } else {
            XB_SPIN(xb_ld(&bar[XB_XGEN(b.x)]) == gen, bar);
            __builtin_amdgcn_fence(__ATOMIC_ACQUIRE, "agent");
            asm volatile("s_waitcnt vmcnt(0)" ::: "memory");
        }
    }
    __syncthreads();
}
constexpr size_t MiB = 1u << 20;
constexpr size_t WS_CTL = 0, CTL_ZERO_BYTES = 1 * MiB;
constexpr size_t WS_MOD = 1 * MiB, WS_ROPE = 1 * MiB + 256 * 1024, WS_BOUT = 1 * MiB + 512 * 1024;
constexpr size_t WS_WIN_T = 2 * MiB, WS_WOUT_T = 9 * MiB, WS_WS_T = 13 * MiB, WS_GWS = 21 * MiB, WS_XC1 = 22 * MiB, WS_XC2 = 26 * MiB;
constexpr size_t WS_U8 = 32 * MiB, WS_V8 = 64 * MiB, WS_H = 96 * MiB, WS_Q = 162 * MiB, WS_KV = 195 * MiB, WS_ZG = 212 * MiB, WS_YC = 245 * MiB, WS_MIX = 262 * MiB, WS_Y = 328 * MiB;
constexpr size_t WS_S = 162 * MiB;
constexpr size_t WS_PACT = 162 * MiB, WS_F = 394 * MiB;
constexpr size_t WS_X1B = 394 * MiB;
constexpr size_t WS_TKI = 477 * MiB, WS_TKG = 486 * MiB, WS_W = 460 * MiB;
constexpr size_t WS_H8 = 294 * MiB;
constexpr size_t WS_END = 503 * MiB;
static_assert(WS_S + (size_t)MT * 2048 * 4 <= WS_END && WS_Y + (size_t)MT * 1024 * 4 <= WS_END && WS_H + (size_t)MT * 1024 * 2 <= WS_Q && WS_MIX + (size_t)MT * 1024 * 2 <= WS_Y, "d_ws map");
constexpr int CW_BAR = 4096, CW_Q = 8192;
constexpr int RING_BYTES = 131072, MISC_OFF = 143360, LDS_BYTES = 147456;
constexpr int N_PHASES = 22;

#define XB_SPIN_CAP_OVERRIDE (1u << 22)

struct Params { const float* in[28]; float* out; unsigned char* ws; int ph_lo, ph_hi; };

struct Frame { LAS unsigned char* lds; int tid, lane, wave, vcu, G; };

__host__ __device__ __forceinline__ int inproj_phys(int L) {
    if (L < 512) { const int hq = L >> 6, d = L & 63; return (hq >> 2) * 256 + (d >> 5) * 128 + (hq & 3) * 32 + (d & 31); }
    if (L < 768) { const int hh = (L - 512) >> 6, d = L & 63; return 512 + (d >> 5) * 128 + hh * 32 + (d & 31); }
    if (L < 1280) return L;
    const int isg = (L >= 1536), ch = L - 1280 - isg * 256; return (5 + (ch >> 7)) * 256 + isg * 128 + (ch & 127);
}
__device__ __forceinline__ void p0_transpose_item(const float* W, int K, int N, bf16_t* WT, int k0, int n0, int prow0, LAS float* scr, int lane) {
    float tv_[32];
#pragma unroll
    for (int i = 0; i < 32; ++i) { const int kk = 2 * i + (lane >> 5); tv_[i] = W[(size_t)(k0 + kk) * N + n0 + (lane & 31)]; }
#pragma unroll
    for (int i = 0; i < 32; ++i) { const int kk = 2 * i + (lane >> 5); scr[kk * 33 + (lane & 31)] = tv_[i]; }
    asm volatile("s_waitcnt lgkmcnt(0)" ::: "memory");
    const int c = lane & 7;
#pragma unroll
    for (int j = 0; j < 4; ++j) { const int n = (lane >> 3) + 8 * j; const LAS float* s = scr + (8 * c) * 33 + n;
        u32x4 o; o.x = pk2(s[0 * 33], s[1 * 33]); o.y = pk2(s[2 * 33], s[3 * 33]); o.z = pk2(s[4 * 33], s[5 * 33]); o.w = pk2(s[6 * 33], s[7 * 33]);
        *(u32x4*)(WT + (size_t)(prow0 + n) * K + k0 + 8 * c) = o; }
    asm volatile("s_waitcnt lgkmcnt(0)" ::: "memory");
}

__device__ __forceinline__ void p0_mod_item(const Frame& F0, int item, const float* c, const float* cctx, const float* w_mod, const float* b_mod, float* mod) {
    Frame F = F0; { const int t_ = mk_tid(); F.tid = t_; F.lane = t_ & 63; }
    LAS float* sc = (LAS float*)F.lds;
    LAS float* red = (LAS float*)(F.lds + 20480);
    const int l = item / 96, cg = item % 96;
    __syncthreads();
    for (int i = F.tid; i < 5 * 1024; i += NTHREADS) { const int r = i >> 10, k = i & 1023; const float v = r < 4 ? c[r * 1024 + k] : cctx[k]; sc[i] = v * fast_sigmoid(v); }
    __syncthreads();
    const int c4 = (F.lane & 15) * 4, ks = F.lane >> 4;
    float acc[5][4];
#pragma unroll
    for (int r = 0; r < 5; ++r)
#pragma unroll
        for (int e = 0; e < 4; ++e) acc[r][e] = 0.f;
    const float* wp = w_mod + (size_t)l * 1024 * 6144 + cg * 64 + c4;
    f32x4 wl[32];
#pragma unroll
    for (int i = 0; i < 32; ++i) wl[i] = *(const f32x4*)(wp + (size_t)(F.wave * 128 + 4 * i + ks) * 6144);
#pragma unroll
    for (int i = 0; i < 32; ++i) {
        const int k = F.wave * 128 + 4 * i + ks;
        const f32x4 w = wl[i];
#pragma unroll
        for (int r = 0; r < 5; ++r) { const float s = sc[r * 1024 + k]; acc[r][0] += s * w[0]; acc[r][1] += s * w[1]; acc[r][2] += s * w[2]; acc[r][3] += s * w[3]; }
    }
#pragma unroll
    for (int r = 0; r < 5; ++r)
#pragma unroll
        for (int e = 0; e < 4; ++e) { float v = acc[r][e]; v += __shfl_xor(v, 16); v += __shfl_xor(v, 32); acc[r][e] = v; }
    if (ks == 0) {
#pragma unroll
        for (int r = 0; r < 5; ++r)
#pragma unroll
            for (int e = 0; e < 4; ++e) red[(F.wave * 5 + r) * 64 + c4 + e] = acc[r][e];
    }
    __syncthreads();
    if (F.tid < 320) { const int r = F.tid >> 6, cc = F.tid & 63; float v = b_mod[l * 6144 + cg * 64 + cc];
#pragma unroll
        for (int w = 0; w < 8; ++w) v += red[(w * 5 + r) * 64 + cc];
        mod[(size_t)(l * 5 + r) * 6144 + cg * 64 + cc] = v; }
}

__device__ __forceinline__ void p0_ws_item(const Frame& F0, int item, const float* w_q, const float* sk, bf16_t* Ws_t) {
    Frame F = F0; { const int t_ = mk_tid(); F.tid = t_; F.lane = t_ & 63; }
    LAS float* sks = (LAS float*)F.lds;
    LAS float* wqs = (LAS float*)(F.lds + 128 * 132 * 4);
    const int l = item >> 8, hp = (item >> 4) & 15, j0 = (item & 15) * 64;
    __syncthreads();
    const float* skp = sk + ((size_t)l * 16 + hp) * 128 * 128;
    { f32x4 t0[8], t1[4];
#pragma unroll
      for (int it = 0; it < 8; ++it) { const int i = it * NTHREADS + F.tid, k = i >> 5, d4 = (i & 31) * 4; t0[it] = *(const f32x4*)(skp + k * 128 + d4); }
#pragma unroll
      for (int it = 0; it < 4; ++it) { const int i = it * NTHREADS + F.tid, j = i >> 5, d4 = (i & 31) * 4; t1[it] = *(const f32x4*)(w_q + ((size_t)l * 1024 + j0 + j) * 2048 + hp * 128 + d4); }
#pragma unroll
      for (int it = 0; it < 8; ++it) { const int i = it * NTHREADS + F.tid, k = i >> 5, d4 = (i & 31) * 4; *(LAS f32x4*)(sks + k * 132 + d4) = t0[it]; }
#pragma unroll
      for (int it = 0; it < 4; ++it) { const int i = it * NTHREADS + F.tid, j = i >> 5, d4 = (i & 31) * 4; *(LAS f32x4*)(wqs + j * 128 + d4) = t1[it]; } }
    __syncthreads();
    const int k = F.tid & 127, jg = F.tid >> 7;
    float acc[16];
#pragma unroll
    for (int i = 0; i < 16; ++i) acc[i] = 0.f;
    for (int d4 = 0; d4 < 128; d4 += 4) {
        const f32x4 a = *(const LAS f32x4*)(sks + k * 132 + d4);
#pragma unroll
        for (int jj = 0; jj < 16; ++jj) { const f32x4 b = *(const LAS f32x4*)(wqs + (jg * 16 + jj) * 128 + d4); acc[jj] += (a[0] * b[0] + a[1] * b[1]) + (a[2] * b[2] + a[3] * b[3]); }
    }
    bf16_t* dst = Ws_t + ((size_t)l * 2048 + hp * 128 + k) * 1024 + j0 + jg * 16;
    u32x4 o0, o1;
    o0.x = pk2(acc[0], acc[1]); o0.y = pk2(acc[2], acc[3]); o0.z = pk2(acc[4], acc[5]); o0.w = pk2(acc[6], acc[7]);
    o1.x = pk2(acc[8], acc[9]); o1.y = pk2(acc[10], acc[11]); o1.z = pk2(acc[12], acc[13]); o1.w = pk2(acc[14], acc[15]);
    *(u32x4*)dst = o0; *(u32x4*)(dst + 8) = o1;
}

__device__ __forceinline__ void p0_wc_item(const Frame& F0, int item, const float* w_pw, const float* b_pw, const float* w_out, bf16_t* Wout_t, float* bout) {
    Frame F = F0; { const int t_ = mk_tid(); F.tid = t_; F.lane = t_ & 63; }
    LAS float* wos = (LAS float*)F.lds;
    LAS float* wps = (LAS float*)(F.lds + 65536);
    const int l = item >> 6, nb = (item >> 2) & 15, kb = item & 3, n0 = nb * 64, kk0 = kb * 64;
    __syncthreads();
    { f32x4 t0[8], t1[8];
#pragma unroll
      for (int it = 0; it < 8; ++it) { const int i = it * NTHREADS + F.tid, j = i >> 4, n4 = (i & 15) * 4; t0[it] = *(const f32x4*)(w_out + ((size_t)l * 1024 + 768 + j) * 1024 + n0 + n4); }
#pragma unroll
      for (int it = 0; it < 8; ++it) { const int i = it * NTHREADS + F.tid, kk = i >> 6, j4 = (i & 63) * 4; t1[it] = *(const f32x4*)(w_pw + ((size_t)l * 256 + kk0 + kk) * 256 + j4); }
#pragma unroll
      for (int it = 0; it < 8; ++it) { const int i = it * NTHREADS + F.tid, j = i >> 4, n4 = (i & 15) * 4; *(LAS f32x4*)(wos + j * 64 + n4) = t0[it]; }
#pragma unroll
      for (int it = 0; it < 8; ++it) { const int i = it * NTHREADS + F.tid, kk = i >> 6, j4 = (i & 63) * 4; *(LAS f32x4*)(wps + kk * 256 + j4) = t1[it]; } }
    __syncthreads();
    const int n = F.tid & 63, kg = F.tid >> 6;
    float acc[8];
#pragma unroll
    for (int i = 0; i < 8; ++i) acc[i] = 0.f;
    for (int j4 = 0; j4 < 256; j4 += 4) {
        const float a0 = wos[(j4 + 0) * 64 + n], a1 = wos[(j4 + 1) * 64 + n], a2 = wos[(j4 + 2) * 64 + n], a3 = wos[(j4 + 3) * 64 + n];
#pragma unroll
        for (int i = 0; i < 8; ++i) { const f32x4 b = *(const LAS f32x4*)(wps + (kg * 8 + i) * 256 + j4); acc[i] += (a0 * b[0] + a1 * b[1]) + (a2 * b[2] + a3 * b[3]); }
    }
    u32x4 o; o.x = pk2(acc[0], acc[1]); o.y = pk2(acc[2], acc[3]); o.z = pk2(acc[4], acc[5]); o.w = pk2(acc[6], acc[7]);
    *(u32x4*)(Wout_t + ((size_t)l * 1024 + n0 + n) * 1024 + 768 + kk0 + kg * 8) = o;
    if (kb == 0 && kg == 0) { float b = 0.f; for (int j = 0; j < 256; ++j) b += b_pw[l * 256 + j] * wos[j * 64 + n]; bout[l * 1024 + n0 + n] = b; }
}


struct P0Ptrs { const float *c, *c_ctx, *w_mod, *b_mod, *peer_w_q, *peer_sk, *conv_w_pw, *conv_b_pw, *w_out, *w_in, *peer_u, *peer_v; float *mod, *bout; bf16_t *Ws_t, *Wout_t, *Win_t; unsigned char *u8, *v8; };
__device__ __forceinline__ void p0_block_items(const Frame& F, const P0Ptrs& P, int l, int which, int w, int nw) {
    const int n0 = (which & 1) ? 96 : 0, n1 = (which & 2) ? 256 : 0, n2 = (which & 4) ? 64 : 0;
    for (int it = w; it < n0 + n1 + n2; it += nw) {
        if (it < n0) p0_mod_item(F, l * 96 + it, P.c, P.c_ctx, P.w_mod, P.b_mod, P.mod);
        else if (it < n0 + n1) p0_ws_item(F, l * 256 + it - n0, P.peer_w_q, P.peer_sk, P.Ws_t);
        else p0_wc_item(F, l * 64 + it - n0 - n1, P.conv_w_pw, P.conv_b_pw, P.w_out, P.Wout_t, P.bout);
    }
    __syncthreads();
}
__device__ __forceinline__ void p0_wave_transposes(const Frame& F, const P0Ptrs& P, int l, int ww, int nww) {
    LAS float* scr = (LAS float*)(F.lds + F.wave * 16384);
    for (int it = ww; it < 896 + 384; it += nww) {
        if (it < 896) { const int kb = it / 56, nb = it % 56;
            p0_transpose_item(P.w_in + (size_t)l * 1024 * INW, 1024, INW, P.Win_t + (size_t)l * INW * 1024, kb * 64, nb * 32, inproj_phys(nb * 32), scr, F.lane); }
        else { const int r = it - 896, kb = r / 32, nb = r % 32;
            p0_transpose_item(P.w_out + (size_t)l * 1024 * 1024, 1024, 1024, P.Wout_t + (size_t)l * 1024 * 1024, kb * 64, nb * 32, nb * 32, scr, F.lane); }
    }
}
__device__ __forceinline__ void p0_convert_tables(const P0Ptrs& P, int l, int t, int nt) {
    const int n8 = 16384 * 128;
    const size_t base = (size_t)l * 16384 * 1024;
#pragma unroll 1
    for (int i0 = t; i0 < n8; i0 += 4 * nt) {
        f32x4 a[4][2], b[4][2];
#pragma unroll
        for (int k = 0; k < 4; ++k) { const int i = i0 + k * nt; if (i < n8) { const float* up = P.peer_u + base + (size_t)i * 8; const float* vp = P.peer_v + base + (size_t)i * 8;
            a[k][0] = *(const f32x4*)up; a[k][1] = *(const f32x4*)(up + 4); b[k][0] = *(const f32x4*)vp; b[k][1] = *(const f32x4*)(vp + 4); } }
#pragma unroll
        for (int k = 0; k < 4; ++k) { const int i = i0 + k * nt; if (i < n8) {
            const int e = i >> 7, cg8 = i & 127;
            { const f32x4 a0 = a[k][0] * U_SCALE, a1 = a[k][1] * U_SCALE; unsigned wu = 0u;
#ifdef TEST_SWAP_NIB
              wu = __builtin_amdgcn_cvt_scalef32_pk_fp4_f32(wu, a0[1], a0[0], 1.0f, 0); wu = __builtin_amdgcn_cvt_scalef32_pk_fp4_f32(wu, a0[3], a0[2], 1.0f, 1);
              wu = __builtin_amdgcn_cvt_scalef32_pk_fp4_f32(wu, a1[1], a1[0], 1.0f, 2); wu = __builtin_amdgcn_cvt_scalef32_pk_fp4_f32(wu, a1[3], a1[2], 1.0f, 3);
#else
              wu = __builtin_amdgcn_cvt_scalef32_pk_fp4_f32(wu, a0[0], a0[1], 1.0f, 0); wu = __builtin_amdgcn_cvt_scalef32_pk_fp4_f32(wu, a0[2], a0[3], 1.0f, 1);
              wu = __builtin_amdgcn_cvt_scalef32_pk_fp4_f32(wu, a1[0], a1[1], 1.0f, 2); wu = __builtin_amdgcn_cvt_scalef32_pk_fp4_f32(wu, a1[2], a1[3], 1.0f, 3);
#endif
              ((unsigned*)P.u8)[(((size_t)l * 4 + (cg8 >> 5)) * 16384 + e) * 32 + (cg8 & 31)] = wu; }
            const f32x4 b0 = b[k][0] * V_SCALE, b1 = b[k][1] * V_SCALE; unsigned wv = 0u;
            wv = __builtin_amdgcn_cvt_scalef32_pk_fp4_f32(wv, b0[0], b0[1], 1.0f, 0); wv = __builtin_amdgcn_cvt_scalef32_pk_fp4_f32(wv, b0[2], b0[3], 1.0f, 1);
            wv = __builtin_amdgcn_cvt_scalef32_pk_fp4_f32(wv, b1[0], b1[1], 1.0f, 2); wv = __builtin_amdgcn_cvt_scalef32_pk_fp4_f32(wv, b1[2], b1[3], 1.0f, 3);
            ((unsigned*)P.v8)[(((size_t)l * 4 + (cg8 >> 5)) * 16384 + e) * 32 + (cg8 & 31)] = wv; } }
    }
}
__device__ __forceinline__ int idle_worker(int nwg, int G, int c, int& nw) {
    const int rounds = (nwg + G - 1) / G, busy = nwg - (rounds - 1) * G;
    if (busy == G) { nw = G; return c; }
    nw = G - busy; return c >= busy ? c - busy : -1;
}
__device__ __forceinline__ void gmlp_chunk(const Frame& F, int chunk, const bf16_t* zg, const float* ln_g, const float* ln_b, const bf16_t* gws, const float* b_s, bf16_t* mix) {
    constexpr int VP = 272;
    LAS unsigned char* vT = F.lds;
    const int row0 = chunk * 128;
    __syncthreads();
    {
        const f32x4 gg = *(const f32x4*)(ln_g + F.lane * 4), bb = *(const f32x4*)(ln_b + F.lane * 4);
        u32x2 wpre[16];
#pragma unroll
        for (int r = 0; r < 16; ++r) wpre[r] = *(const u32x2*)(zg + (size_t)(row0 + F.wave * 16 + r) * 512 + 256 + F.lane * 4);
#pragma unroll
        for (int r = 0; r < 16; ++r) {
            const int q = F.wave * 16 + r;
            const u32x2 w = wpre[r];
            float a = bflo(w.x), b = bfhi(w.x), c = bflo(w.y), d = bfhi(w.y);
            const float mu = wave_sum((a + b) + (c + d)) * (1.0f / 256.0f);
            a -= mu; b -= mu; c -= mu; d -= mu;
            const float rstd = 1.0f / sqrtf(wave_sum((a * a + b * b) + (c * c + d * d)) * (1.0f / 256.0f) + EPS);
            LAS unsigned short* dst = (LAS unsigned short*)(vT + (F.lane * 4) * VP + q * 2);
            dst[0] = (unsigned short)f2bf(a * rstd * gg[0] + bb[0]);
            dst[VP / 2] = (unsigned short)f2bf(b * rstd * gg[1] + bb[1]);
            dst[VP] = (unsigned short)f2bf(c * rstd * gg[2] + bb[2]);
            dst[VP / 2 * 3] = (unsigned short)f2bf(d * rstd * gg[3] + bb[3]);
        }
    }
    __syncthreads();
    const int g = F.wave >> 1, ph = F.wave & 1, fr = F.lane & 15, fq = F.lane >> 4;
    f32x4 acc[4][4];
#pragma unroll
    for (int ct = 0; ct < 4; ++ct)
#pragma unroll
        for (int pt = 0; pt < 4; ++pt) acc[ct][pt] = (f32x4){0.f, 0.f, 0.f, 0.f};
#pragma unroll
    for (int ks = 0; ks < 4; ++ks) {
        bf16x8 af[4], bfr[4];
#pragma unroll
        for (int ct = 0; ct < 4; ++ct) af[ct] = *(const LAS bf16x8*)(vT + (g * 64 + ct * 16 + fr) * VP + (ks * 32 + fq * 8) * 2);
#pragma unroll
        for (int pt = 0; pt < 4; ++pt) bfr[pt] = *(const bf16x8*)(gws + ((size_t)(g * 128 + ph * 64 + pt * 16 + fr)) * 128 + ks * 32 + fq * 8);
#pragma unroll
        for (int ct = 0; ct < 4; ++ct)
#pragma unroll
            for (int pt = 0; pt < 4; ++pt) acc[ct][pt] = __builtin_amdgcn_mfma_f32_16x16x32_bf16(af[ct], bfr[pt], acc[ct][pt], 0, 0, 0);
    }
#pragma unroll
    for (int pt = 0; pt < 4; ++pt) {
        const int p = ph * 64 + pt * 16 + fr; const float bs = b_s[g * 128 + p];
        const bf16_t* urow = zg + (size_t)(row0 + p) * 512 + g * 64 + 4 * fq;
        bf16_t* orow = mix + (size_t)(row0 + p) * 1024 + 512 + g * 64 + 4 * fq;
#pragma unroll
        for (int ct = 0; ct < 4; ++ct) { const u32x2 u = *(const u32x2*)(urow + ct * 16); const f32x4 s = acc[ct][pt] + bs;
            u32x2 o; o.x = pk2(bflo(u.x) * s[0], bfhi(u.x) * s[1]); o.y = pk2(bflo(u.y) * s[2], bfhi(u.y) * s[3]); *(u32x2*)(orow + ct * 16) = o; }
    }
}

__device__ __forceinline__ void conv_tile(const Frame& F, int tile, const bf16_t* yc, const float* w_dw, const float* b_dw, const float* ln_g, const float* ln_b, bf16_t* mix) {
    LAS unsigned short* T = (LAS unsigned short*)F.lds;
    LAS float* red = (LAS float*)(F.lds + 158 * 512);
    LAS float* stat = red + 128 * 8;
    const int row0 = tile * 128; const bool lat = row0 < ML;
    const int Ls = lat ? SEQ : CTXL, t0 = lat ? (row0 & (SEQ - 1)) : ((row0 - ML) & (CTXL - 1));
    __syncthreads();
    {
        u32x4 tv[10];
#pragma unroll
        for (int it = 0; it < 10; ++it) { const int i = it * NTHREADS + F.tid, r = i >> 5, c8 = (i & 31) * 8; const int tt = t0 + r - 15;
            tv[it] = (u32x4){0u, 0u, 0u, 0u}; if (i < 158 * 32 && tt >= 0 && tt < Ls) tv[it] = *(const u32x4*)(yc + (size_t)(row0 + r - 15) * 256 + c8); }
#pragma unroll
        for (int it = 0; it < 10; ++it) { const int i = it * NTHREADS + F.tid, r = i >> 5, c8 = (i & 31) * 8; if (i < 158 * 32) *(LAS u32x4*)(T + r * 256 + c8) = tv[it]; }
    }
    __syncthreads();
    const int ch = F.tid & 255, half = F.tid >> 8;
    float wd[31];
#pragma unroll
    for (int j = 0; j < 31; ++j) wd[j] = w_dw[j * 256 + ch];
    const float bd = b_dw[ch];
#pragma unroll 1
    for (int grp = 0; grp < 8; ++grp) {
        const int rb = half * 64 + grp * 8;
        float a[8];
#pragma unroll
        for (int k = 0; k < 8; ++k) a[k] = bd;
#pragma unroll
        for (int i = 0; i < 38; ++i) { const float x = __uint_as_float(((unsigned)T[(rb + i) * 256 + ch]) << 16);
#pragma unroll
            for (int k = 0; k < 8; ++k) { const int j = i - k; if (j >= 0 && j < 31) a[k] += x * wd[j]; } }
        float pr[16];
#pragma unroll
        for (int k = 0; k < 8; ++k) { pr[k] = a[k]; pr[8 + k] = a[k] * a[k]; }
        const float tot = wave_reduce16(pr, F.lane);
        if ((F.lane & 3) == 0) { const int idx = (F.lane >> 2) & 15; red[((rb + (idx & 7)) * 4 + (F.wave & 3)) * 2 + (idx >> 3)] = tot; }
    }
    __syncthreads();
    if (F.tid < 128) { const int r = F.tid; float s = 0.f, q = 0.f;
#pragma unroll
        for (int w = 0; w < 4; ++w) { s += red[(r * 4 + w) * 2]; q += red[(r * 4 + w) * 2 + 1]; }
        const float mu = s * (1.0f / 256.0f); const float var = fmaxf(q * (1.0f / 256.0f) - mu * mu, 0.f);
        stat[r * 2] = mu; stat[r * 2 + 1] = 1.0f / sqrtf(var + EPS); }
    __syncthreads();
    const float gg = ln_g[ch], bb = ln_b[ch];
#pragma unroll 1
    for (int grp = 0; grp < 8; ++grp) {
        const int rb = half * 64 + grp * 8;
        float a[8];
#pragma unroll
        for (int k = 0; k < 8; ++k) a[k] = bd;
#pragma unroll
        for (int i = 0; i < 38; ++i) { const float x = __uint_as_float(((unsigned)T[(rb + i) * 256 + ch]) << 16);
#pragma unroll
            for (int k = 0; k < 8; ++k) { const int j = i - k; if (j >= 0 && j < 31) a[k] += x * wd[j]; } }
#pragma unroll
        for (int k = 0; k < 8; ++k) { const int r = rb + k; float y = (a[k] - stat[r * 2]) * stat[r * 2 + 1] * gg + bb; y = y * fast_sigmoid(y);
            mix[(size_t)(row0 + r) * 1024 + 768 + ch] = (bf16_t)f2bf(y); }
    }
}

struct TRow { u32x2 t[4]; };
__device__ __forceinline__ void trow_load(TRow& I, int row, int lane, const bf16_t* tb) {
    const bf16_t* p = tb + (size_t)row * D;
#pragma unroll
    for (int j = 0; j < 4; ++j) I.t[j] = *(const u32x2*)(p + j * 256 + lane * 4);
}
__device__ __forceinline__ float ln1_apply(f32x4 (&v)[4], const TRow& I, const f32x4 (&lg)[4], const f32x4 (&lb)[4]) {
    float s = 0.f;
#pragma unroll
    for (int j = 0; j < 4; ++j) { const u32x2 w = I.t[j]; v[j] = (f32x4){bflo(w.x), bfhi(w.x), bflo(w.y), bfhi(w.y)}; s += (v[j][0] + v[j][1]) + (v[j][2] + v[j][3]); }
    const float mu = wave_sum(s) * (1.0f / 1024.0f); float q = 0.f;
#pragma unroll
    for (int j = 0; j < 4; ++j) { v[j] = v[j] - mu; q += (v[j][0] * v[j][0] + v[j][1] * v[j][1]) + (v[j][2] * v[j][2] + v[j][3] * v[j][3]); }
    const float rstd = 1.0f / sqrtf(wave_sum(q) * (1.0f / 1024.0f) + EPS);
    s = 0.f;
#pragma unroll
    for (int j = 0; j < 4; ++j) { v[j] = v[j] * rstd * lg[j] + lb[j]; s += (v[j][0] + v[j][1]) + (v[j][2] + v[j][3]); }
    return s;
}
__device__ __forceinline__ void adaln_store(f32x4 (&v)[4], float s, const f32x4 (&sh)[4], const f32x4 (&sc)[4], bf16_t* hrow, int lane, unsigned char* h8row = nullptr) {
    const float mu = wave_sum(s) * (1.0f / 1024.0f); float q = 0.f;
#pragma unroll
    for (int j = 0; j < 4; ++j) { v[j] = v[j] - mu; q += (v[j][0] * v[j][0] + v[j][1] * v[j][1]) + (v[j][2] * v[j][2] + v[j][3] * v[j][3]); }
    const float rstd = 1.0f / sqrtf(wave_sum(q) * (1.0f / 1024.0f) + EPS);
#pragma unroll
    for (int j = 0; j < 4; ++j) { const f32x4 o = v[j] * rstd * (sc[j] + 1.0f) + sh[j]; u32x2 w; w.x = pk2(o[0], o[1]); w.y = pk2(o[2], o[3]); *(u32x2*)(hrow + j * 256 + lane * 4) = w;
        if (h8row) { int w8 = 0; w8 = __builtin_amdgcn_cvt_pk_fp8_f32(o[0] * H_SCALE, o[1] * H_SCALE, w8, false); w8 = __builtin_amdgcn_cvt_pk_fp8_f32(o[2] * H_SCALE, o[3] * H_SCALE, w8, true); *(int*)(h8row + j * 256 + lane * 4) = w8; } }
}
__device__ __forceinline__ void load_par(f32x4 (&p)[4], const float* src, int lane) {
#pragma unroll
    for (int j = 0; j < 4; ++j) p[j] = *(const f32x4*)(src + j * 256 + lane * 4);
}
__device__ __forceinline__ void row_store(const f32x4 v, int row, int col, float* of, bf16_t* ob, float* oc) {
    if (row >= ML) *(f32x4*)(oc + (size_t)(row - ML) * D + col) = v;
    else if (ob) { u32x2 w; w.x = pk2(v[0], v[1]); w.y = pk2(v[2], v[3]); *(u32x2*)(ob + (size_t)row * D + col) = w; }
    else *(f32x4*)(of + (size_t)row * D + col) = v;
}
#define TK_INS(t, x) do { float xx_ = (x); _Pragma("unroll") for (int i_ = 0; i_ < 16; ++i_) { const float hi_ = fmaxf(t[i_], xx_); xx_ = fminf(t[i_], xx_); t[i_] = hi_; } } while (0)
__device__ __forceinline__ float dot16_fp8(const u32x4 r, const float (&hv)[16]) {
    f32x2 a = (f32x2){0.f, 0.f}, b = (f32x2){0.f, 0.f};
#pragma unroll
    for (int j = 0; j < 4; ++j) { const f32x2 lo = __builtin_amdgcn_cvt_pk_f32_fp8((int)r[j], false), hi = __builtin_amdgcn_cvt_pk_f32_fp8((int)r[j], true);
        a = __builtin_elementwise_fma(lo, (f32x2){hv[4 * j], hv[4 * j + 1]}, a); b = __builtin_elementwise_fma(hi, (f32x2){hv[4 * j + 2], hv[4 * j + 3]}, b); }
    a = a + b;
    return a[0] + a[1];
}
typedef _Float16 h2_t __attribute__((ext_vector_type(2)));
__device__ __forceinline__ float dot16_fp8_h(const u32x4 r, const h2_t (&hv)[8], const float scale) {
    float a = 0.f, b = 0.f;
#pragma unroll
    for (int j = 0; j < 4; ++j) { const h2_t lo = __builtin_amdgcn_cvt_scalef32_pk_f16_fp8((int)r[j], scale, false), hi = __builtin_amdgcn_cvt_scalef32_pk_f16_fp8((int)r[j], scale, true);
        a = __builtin_amdgcn_fdot2(lo, hv[2 * j], a, false); b = __builtin_amdgcn_fdot2(hi, hv[2 * j + 1], b, false); }
    return a + b;
}
__device__ __forceinline__ void axpy16_fp8(float (&acc)[16], const float w, const u32x4 r) {
    const f32x2 w2 = (f32x2){w, w};
#pragma unroll
    for (int j = 0; j < 4; ++j) { const f32x2 lo = __builtin_amdgcn_cvt_pk_f32_fp8((int)r[j], false), hi = __builtin_amdgcn_cvt_pk_f32_fp8((int)r[j], true);
        const f32x2 x = __builtin_elementwise_fma(w2, lo, (f32x2){acc[4 * j], acc[4 * j + 1]}), y = __builtin_elementwise_fma(w2, hi, (f32x2){acc[4 * j + 2], acc[4 * j + 3]});
        acc[4 * j] = x[0]; acc[4 * j + 1] = x[1]; acc[4 * j + 2] = y[0]; acc[4 * j + 3] = y[1]; }
}
#define TK_CE(a, b) do { const float hi_ = fmaxf(a, b), lo_ = fminf(a, b); a = hi_; b = lo_; } while (0)
__device__ __forceinline__ void tk_sort16(float (&v)[16]) {
#pragma unroll
    for (int k = 2; k <= 16; k <<= 1)
#pragma unroll
        for (int j = k >> 1; j > 0; j >>= 1)
#pragma unroll
            for (int i = 0; i < 16; ++i) { const int l = i ^ j; if (l > i) { if ((i & k) == 0) TK_CE(v[i], v[l]); else TK_CE(v[l], v[i]); } }
}
__device__ __forceinline__ void tk_bmerge16(float (&v)[16]) {
#pragma unroll
    for (int j = 8; j > 0; j >>= 1)
#pragma unroll
        for (int i = 0; i < 16; ++i) { const int l = i ^ j; if (l > i) TK_CE(v[i], v[l]); }
}
__device__ __forceinline__ void tk_merge_top(float (&t)[16], const float (&s)[16]) {
#pragma unroll
    for (int i = 0; i < 16; ++i) t[i] = fmaxf(t[i], s[15 - i]);
    tk_bmerge16(t);
}
__device__ __forceinline__ void peer_topk_wave(const Frame& F, int b0, int nb, int bstep, const unsigned short* s, unsigned short* tk_idx, float* tk_gate) {
    LAS float* l1 = (LAS float*)F.lds + (F.wave * 64) * 16;
    LAS unsigned char* xt = F.lds + 32768 + F.wave * 8192;
    const int lane = F.lane, oj = lane >> 3, piece = lane & 7;
    u32x4 ld[16];
#define TK_ISSUE(bb) do { const int r0_ = (bb) * 4; _Pragma("unroll") for (int q_ = 0; q_ < 16; ++q_) { const int o_ = 8 * (q_ & 7) + oj; \
        ld[q_] = *(const u32x4*)(s + (size_t)(r0_ + (o_ >> 4)) * 2048 + (o_ & 15) * 128 + (q_ >> 3) * 64 + piece * 8); } } while (0)
#ifndef TK_NOPREFETCH
    if (b0 < nb) TK_ISSUE(b0);
#endif
#pragma unroll 1
    for (int bb = b0; bb < nb; bb += bstep) {
        const int row0 = bb * 4;
#ifdef TK_NOPREFETCH
        TK_ISSUE(bb);
#endif
        float t[16];
#pragma unroll
        for (int hf = 0; hf < 2; ++hf) {
#pragma unroll
            for (int j = 0; j < 8; ++j) { const int o = 8 * j + oj; *(LAS u32x4*)(xt + o * 128 + ((piece ^ (o & 7)) * 16)) = ld[hf * 8 + j]; }
#pragma unroll
            for (int qd = 0; qd < 4; ++qd) {
                float v[16];
#ifdef TK_F32
#pragma unroll
                for (int pp = 0; pp < 4; ++pp) { const f32x4 x = *(const f32x4*)((const float*)s + (size_t)(row0 + (lane >> 4)) * 2048 + (lane & 15) * 128 + hf * 64 + qd * 16 + pp * 4);
#pragma unroll
                    for (int e = 0; e < 4; ++e) { const unsigned k = (unsigned)(hf * 64 + qd * 16 + pp * 4 + e); v[pp * 4 + e] = __uint_as_float((__float_as_uint((float)(_Float16)x[e]) & ~0x7Fu) | (127u - k)); } }
                if (false) {
#else
                {
#endif
#pragma unroll
#ifdef TK_DIRECT
                for (int pp = 0; pp < 2; ++pp) { const int p = qd * 2 + pp; const u32x4 x = *(const u32x4*)(s + (size_t)(row0 + (lane >> 4)) * 2048 + (lane & 15) * 128 + hf * 64 + p * 8);
#else
                for (int pp = 0; pp < 2; ++pp) { const int p = qd * 2 + pp; const u32x4 x = *(const LAS u32x4*)(xt + lane * 128 + ((p ^ (lane & 7)) * 16));
#endif
#pragma unroll
                    for (int e = 0; e < 4; ++e) { const unsigned wv_ = x[e];
                        const float f0 = (float)__builtin_bit_cast(_Float16, (unsigned short)(wv_ & 0xffffu)), f1 = (float)__builtin_bit_cast(_Float16, (unsigned short)(wv_ >> 16));
                        const unsigned k0 = (unsigned)(hf * 64 + p * 8 + e * 2);
                        v[pp * 8 + e * 2] = __uint_as_float((__float_as_uint(f0) & ~0x7Fu) | (127u - k0)); v[pp * 8 + e * 2 + 1] = __uint_as_float((__float_as_uint(f1) & ~0x7Fu) | (126u - k0)); } }
                }
                tk_sort16(v);
                if (hf == 0 && qd == 0) {
#pragma unroll
                    for (int i = 0; i < 16; ++i) t[i] = v[i];
                } else tk_merge_top(t, v);
            }
        }
#pragma unroll
        for (int i = 0; i < 4; ++i) *(LAS f32x4*)(l1 + lane * 16 + i * 4) = (f32x4){t[4 * i], t[4 * i + 1], t[4 * i + 2], t[4 * i + 3]};
#ifndef TK_NOPREFETCH
        if (bb + bstep < nb) TK_ISSUE(bb + bstep);
#endif
        {
            const LAS float* la = l1 + (lane & ~1) * 16; const LAS float* lb_ = l1 + (lane | 1) * 16;
            float a[16], b[16];
#pragma unroll
            for (int i = 0; i < 4; ++i) { const f32x4 x = *(const LAS f32x4*)(la + 4 * i), y = *(const LAS f32x4*)(lb_ + 4 * i);
                a[4 * i] = x[0]; a[4 * i + 1] = x[1]; a[4 * i + 2] = x[2]; a[4 * i + 3] = x[3]; b[4 * i] = y[0]; b[4 * i + 1] = y[1]; b[4 * i + 2] = y[2]; b[4 * i + 3] = y[3]; }
#define TK_CAND(i, j) __uint_as_float((__float_as_uint(a[i] + b[j]) & ~0xFFu) | (unsigned)(255 - ((i) * 16 + (j))))
            float x[16];
#pragma unroll
            for (int j = 0; j < 16; ++j) t[j] = TK_CAND(0, j);
#pragma unroll
            for (int j = 0; j < 8; ++j) { x[j] = TK_CAND(1, j); x[8 + j] = TK_CAND(15 - j, 0); }
            tk_bmerge16(x); tk_merge_top(t, x);
            x[0] = TK_CAND(2, 0); x[1] = TK_CAND(2, 1); x[2] = TK_CAND(2, 2); x[3] = TK_CAND(2, 3); x[4] = TK_CAND(2, 4);
            x[5] = TK_CAND(3, 0); x[6] = TK_CAND(3, 1); x[7] = TK_CAND(3, 2); x[8] = TK_CAND(3, 3);
            x[9] = TK_CAND(4, 0); x[10] = TK_CAND(4, 1); x[11] = TK_CAND(4, 2);
            x[12] = TK_CAND(5, 0); x[13] = TK_CAND(5, 1); x[14] = TK_CAND(6, 0); x[15] = TK_CAND(6, 1);
            tk_sort16(x); tk_merge_top(t, x);
            TK_INS(t, TK_CAND(7, 0)); TK_INS(t, TK_CAND(7, 1));
#undef TK_CAND
            float e[16], sum = 0.f;
#pragma unroll
            for (int i = 0; i < 16; ++i) { e[i] = __builtin_amdgcn_exp2f((t[i] - t[0]) * 1.4426950408889634f); sum += e[i]; }
            const float inv = 1.0f / sum;
            if ((lane & 1) == 0) {
                const size_t base = ((size_t)(row0 + (lane >> 4)) * 8 + ((lane & 15) >> 1)) * 16;
                int ex[16];
#pragma unroll
                for (int i = 0; i < 16; ++i) {
                    const int pos = 255 - (int)(__float_as_uint(t[i]) & 0xFFu);
                    const int ea = 127 - (int)(__float_as_uint(la[pos >> 4]) & 0x7Fu), eb = 127 - (int)(__float_as_uint(lb_[pos & 15]) & 0x7Fu);
                    ex[i] = ea * 128 + eb;
                }
#pragma unroll
                for (int i = 0; i < 2; ++i) *(u32x4*)(tk_idx + base + 8 * i) = (u32x4){(unsigned)ex[8 * i] | ((unsigned)ex[8 * i + 1] << 16), (unsigned)ex[8 * i + 2] | ((unsigned)ex[8 * i + 3] << 16), (unsigned)ex[8 * i + 4] | ((unsigned)ex[8 * i + 5] << 16), (unsigned)ex[8 * i + 6] | ((unsigned)ex[8 * i + 7] << 16)};
#pragma unroll
                for (int i = 0; i < 4; ++i) *(f32x4*)(tk_gate + base + 4 * i) = (f32x4){e[4 * i] * inv, e[4 * i + 1] * inv, e[4 * i + 2] * inv, e[4 * i + 3] * inv};
            }
        }
    }
#undef TK_ISSUE
}

__device__ __forceinline__ int q_next(const Frame& F, unsigned* qword) {
    volatile LAS int* bw = (volatile LAS int*)(F.lds + MISC_OFF + 64);
    __syncthreads();
    if (F.tid == 0) *bw = (int)__hip_atomic_fetch_add(qword, 1u, __ATOMIC_RELAXED, __HIP_MEMORY_SCOPE_AGENT);
    __syncthreads();
    return *bw;
}

typedef int v8i_t __attribute__((ext_vector_type(8)));
template <int NTW> __device__ __forceinline__ void peer_u_item(const Frame& F, int row0, int item, int slice, const unsigned char* h8, const unsigned short* tk_idx, const unsigned char* u4s  , bf16_t* pact) {
    const int lane = F.lane, c = lane & 7, ps = lane >> 3, i = lane & 15, g = lane >> 4;
    LAS unsigned char* buf = F.lds + F.wave * 16384;
    LAS unsigned char* sml = F.lds + RING_BYTES + F.wave * 1024;
    const int rowb = row0 + item * (8 * NTW) + F.wave * NTW;
    const int rdb = (8 * (i & 7) + (i >> 3)) * 128, rd0 = rdb + ((g ^ (i & 7)) * 16), rd1 = rdb + (((4 + g) ^ (i & 7)) * 16);
    const unsigned lds_rd0_ = (unsigned)(size_t)(buf + rd0), lds_rd1_ = (unsigned)(size_t)(buf + rd1);
    const unsigned ids_rd_ = (unsigned)(size_t)(sml + 16 * ps), hb_rd_ = (unsigned)(size_t)(sml + 512 + 16 * g);
#define PU_DMA_IDS(row, par) __builtin_amdgcn_global_load_lds((const unsigned*)(tk_idx + (size_t)(row) * 128 + lane * 2), (LAS unsigned*)(sml + (par) * 256), 4, 0, 0)
#define PU_DMA_HB(row, par) __builtin_amdgcn_global_load_lds((const unsigned*)(h8 + (size_t)(row) * D + slice * 256 + lane * 4), (LAS unsigned*)(sml + 512 + (par) * 256), 4, 0, 0)
#define PU_RD_IDS(dst, hf, par) asm volatile("ds_read_b128 %0, %1\n\ts_waitcnt lgkmcnt(0)" : "=&v"(dst) : "v"(ids_rd_ + (unsigned)((par) * 256 + (hf) * 128)) : "memory")
#define PU_ISSUE(hf, idv) do { _Pragma("unroll") for (int m = 0; m < 8; ++m) { const unsigned idw_ = idv[m >> 1]; const unsigned e_ = (m & 1) ? (idw_ >> 16) : (idw_ & 0xffffu); \
        __builtin_amdgcn_global_load_lds((const unsigned*)(u4s + (size_t)e_ * 128 + ((c ^ m) * 16)), (LAS unsigned*)(buf + (hf) * 8192 + m * 1024), 16, 0, 0); } } while (0)
#define PU_RD(dst, off) asm volatile("ds_read_b128 %0, %1 offset:%2" : "=v"(dst) : "v"(lds_rd0_), "n"(off))
#define PU_RD1(dst, off) asm volatile("ds_read_b128 %0, %1 offset:%2" : "=v"(dst) : "v"(lds_rd1_), "n"(off))
#define PU_HALF(hf) do { u32x4 a0_[4], a1_[4]; \
        PU_RD(a0_[0], (hf) * 8192 + 0); PU_RD1(a1_[0], (hf) * 8192 + 0); PU_RD(a0_[1], (hf) * 8192 + 256); PU_RD1(a1_[1], (hf) * 8192 + 256); \
        PU_RD(a0_[2], (hf) * 8192 + 512); PU_RD1(a1_[2], (hf) * 8192 + 512); PU_RD(a0_[3], (hf) * 8192 + 768); PU_RD1(a1_[3], (hf) * 8192 + 768); \
        asm volatile("s_waitcnt lgkmcnt(6)" : "+v"(a0_[0]), "+v"(a1_[0])); asm volatile("s_waitcnt lgkmcnt(4)" : "+v"(a0_[1]), "+v"(a1_[1])); \
        asm volatile("s_waitcnt lgkmcnt(2)" : "+v"(a0_[2]), "+v"(a1_[2])); asm volatile("s_waitcnt lgkmcnt(0)" : "+v"(a0_[3]), "+v"(a1_[3])); \
        _Pragma("unroll") for (int G = 0; G < 4; ++G) { f32x4 acc_ = (f32x4){0.f, 0.f, 0.f, 0.f}; \
        acc_ = __builtin_amdgcn_mfma_scale_f32_16x16x128_f8f6f4((v8i_t){(int)a0_[G][0], (int)a0_[G][1], (int)a0_[G][2], (int)a0_[G][3], 0, 0, 0, 0}, hb0, acc_, 4  , 0  , 0, 0x7F7F7F7F, 0, 0x7F7F7F7F); \
        acc_ = __builtin_amdgcn_mfma_scale_f32_16x16x128_f8f6f4((v8i_t){(int)a1_[G][0], (int)a1_[G][1], (int)a1_[G][2], (int)a1_[G][3], 0, 0, 0, 0}, hb1, acc_, 4, 0, 0, 0x7F7F7F7F, 0, 0x7F7F7F7F); \
        asm volatile("" : "+v"(acc_));       \
        accs[hf][G] = acc_; } } while (0)
    asm volatile("s_waitcnt lgkmcnt(0)" ::: "memory");
    PU_DMA_IDS(rowb, 0);
    asm volatile("s_waitcnt vmcnt(0)" ::: "memory");
    { u32x4 id0, id1; PU_RD_IDS(id0, 0, 0); PU_RD_IDS(id1, 1, 0);
      PU_ISSUE(0, id0); PU_DMA_HB(rowb, 0); PU_DMA_IDS(rowb + (NTW > 1 ? 1 : 0), 1); PU_ISSUE(1, id1); }
#pragma unroll 1
    for (int ti = 0; ti < NTW; ++ti) {
        const int row = rowb + ti, par = ti & 1; const bool last = ti + 1 >= NTW;
        f32x4 accs[2][4];
        asm volatile("s_waitcnt vmcnt(8)" ::: "memory");
        v8i_t hb0, hb1;
        { u32x4 x0, x1, x2, x3;
          asm volatile("ds_read_b128 %0, %4\n\tds_read_b128 %1, %4 offset:64\n\tds_read_b128 %2, %4 offset:128\n\tds_read_b128 %3, %4 offset:192\n\ts_waitcnt lgkmcnt(0)"
                       : "=&v"(x0), "=&v"(x1), "=&v"(x2), "=&v"(x3) : "v"(hb_rd_ + (unsigned)(par * 256)) : "memory");
          hb0 = (v8i_t){(int)x0[0], (int)x0[1], (int)x0[2], (int)x0[3], (int)x1[0], (int)x1[1], (int)x1[2], (int)x1[3]};
          hb1 = (v8i_t){(int)x2[0], (int)x2[1], (int)x2[2], (int)x2[3], (int)x3[0], (int)x3[1], (int)x3[2], (int)x3[3]}; }
        PU_HALF(0);
        if (!last) { u32x4 idn; PU_RD_IDS(idn, 0, par ^ 1); PU_ISSUE(0, idn); }
        if (last) asm volatile("s_waitcnt vmcnt(0)" ::: "memory"); else asm volatile("s_waitcnt vmcnt(8)" ::: "memory");
        PU_HALF(1);
        { u32x2 o = (u32x2){0u, 0u};
#pragma unroll
          for (int hf = 0; hf < 2; ++hf)
#pragma unroll
              for (int G = 0; G < 4; ++G) { const bool sel = (i == 4 * hf + G); const unsigned lo_ = pk2(accs[hf][G][0], accs[hf][G][1]), hi_ = pk2(accs[hf][G][2], accs[hf][G][3]); o.x = sel ? lo_ : o.x; o.y = sel ? hi_ : o.y; }
          if (i < 8) *(u32x2*)(pact + ((size_t)slice * MT + row) * 128 + 16 * i + 4 * g) = o; }
        if (!last) { u32x4 idn; PU_RD_IDS(idn, 1, par ^ 1); PU_DMA_HB(row + 1, par ^ 1); PU_DMA_IDS(row + (ti + 2 < NTW ? 2 : 1), par); PU_ISSUE(1, idn); }
    }
#undef PU_DMA_IDS
#undef PU_DMA_HB
#undef PU_RD_IDS
#undef PU_ISSUE
#undef PU_HALF
#undef PU_RD
#undef PU_RD1
}

template <int NTW> __device__ __forceinline__ void peer_v_item(const Frame& F, int row0, int item, int slice, const unsigned short* tk_idx, const unsigned char* w8, const unsigned* wscale, const unsigned char* v4s, bf16_t* fbuf) {
    const int lane = F.lane, c = lane & 7, ps = lane >> 3, idx = lane & 15, g = lane >> 4;
    LAS unsigned char* buf = F.lds + F.wave * 16384;
    LAS unsigned char* sml = F.lds + RING_BYTES + F.wave * 1024;
    const int rowb = row0 + item * (8 * NTW) + F.wave * NTW;
    const int rho = 8 * (idx & 7) + 4 * (g & 1) + 2 * (g >> 1) + (idx >> 3);
    unsigned adrA[8], adrB[8];
#pragma unroll
    for (int j = 0; j < 8; ++j) { adrA[j] = (unsigned)(size_t)(buf + rho * 128 + ((j ^ (idx & 7)) * 16) + 8 * (g & 1)); adrB[j] = adrA[j] ^ 8u; }
    const bool godd = g & 1;
    const unsigned ids_rd_ = (unsigned)(size_t)(sml + 16 * (ps & 3) + 128 * (ps >> 2)), wb_rd_ = (unsigned)(size_t)(sml + 512 + 32 * g);
#define PV_DMA_IDS(row, par) __builtin_amdgcn_global_load_lds((const unsigned*)(tk_idx + (size_t)(row) * 128 + lane * 2), (LAS unsigned*)(sml + (par) * 256), 4, 0, 0)
#define PV_DMA_WB(row, par) __builtin_amdgcn_global_load_lds(lane < 32 ? (const unsigned*)(w8 + (size_t)(row) * 128 + lane * 4) : (wscale + (row)), (LAS unsigned*)(sml + 512 + (par) * 256), 4, 0, 0)
#define PV_RD_IDS(dst, h, par) asm volatile("ds_read_b128 %0, %1\n\ts_waitcnt lgkmcnt(0)" : "=&v"(dst) : "v"(ids_rd_ + (unsigned)((par) * 256 + (h) * 64)) : "memory")
#define PV_ISSUE(h, idv) do { _Pragma("unroll") for (int m = 0; m < 8; ++m) { const unsigned idw_ = idv[m >> 1]; const unsigned e_ = (m & 1) ? (idw_ >> 16) : (idw_ & 0xffffu); \
        __builtin_amdgcn_global_load_lds((const unsigned*)(v4s + (size_t)e_ * 128 + ((c ^ m) * 16)), (LAS unsigned*)(buf + (h) * 8192 + m * 1024), 16, 0, 0); } } while (0)
    asm volatile("s_waitcnt lgkmcnt(0)" ::: "memory");
    PV_DMA_IDS(rowb, 0);
    asm volatile("s_waitcnt vmcnt(0)" ::: "memory");
    { u32x4 id0, id1; PV_RD_IDS(id0, 0, 0); PV_RD_IDS(id1, 1, 0);
      PV_ISSUE(0, id0); PV_DMA_WB(rowb, 0); PV_DMA_IDS(rowb + (NTW > 1 ? 1 : 0), 1); PV_ISSUE(1, id1); }
#pragma unroll 1
    for (int ti = 0; ti < NTW; ++ti) {
        const int row = rowb + ti, par = ti & 1; const bool last = ti + 1 >= NTW;
        f32x4 acc[16];
        asm volatile("s_waitcnt vmcnt(8)" ::: "memory");
        v8i_t wb; int wsc;
        { u32x4 x0, x1; unsigned x2;
          asm volatile("ds_read_b128 %0, %3\n\tds_read_b128 %1, %3 offset:16\n\tds_read_b32 %2, %4\n\ts_waitcnt lgkmcnt(0)"
                       : "=&v"(x0), "=&v"(x1), "=&v"(x2) : "v"(wb_rd_ + (unsigned)(par * 256)), "v"((unsigned)(size_t)(sml + 512 + 128) + (unsigned)(par * 256)) : "memory");
          wb = (v8i_t){(int)x0[0], (int)x0[1], (int)x0[2], (int)x0[3], (int)x1[0], (int)x1[1], (int)x1[2], (int)x1[3]}; wsc = (int)x2; }
        { u32x2 t_[8];
        asm volatile("ds_read_b64_tr_b4 %0, %1 offset:%2" : "=v"(t_[0]) : "v"(adrA[0]), "n"(0*8192));
        asm volatile("ds_read_b64_tr_b4 %0, %1 offset:%2" : "=v"(t_[1]) : "v"(adrB[0]), "n"(0*8192));
        asm volatile("ds_read_b64_tr_b4 %0, %1 offset:%2" : "=v"(t_[2]) : "v"(adrA[1]), "n"(0*8192));
        asm volatile("ds_read_b64_tr_b4 %0, %1 offset:%2" : "=v"(t_[3]) : "v"(adrB[1]), "n"(0*8192));
        asm volatile("ds_read_b64_tr_b4 %0, %1 offset:%2" : "=v"(t_[4]) : "v"(adrA[2]), "n"(0*8192));
        asm volatile("ds_read_b64_tr_b4 %0, %1 offset:%2" : "=v"(t_[5]) : "v"(adrB[2]), "n"(0*8192));
        asm volatile("ds_read_b64_tr_b4 %0, %1 offset:%2" : "=v"(t_[6]) : "v"(adrA[3]), "n"(0*8192));
        asm volatile("ds_read_b64_tr_b4 %0, %1 offset:%2" : "=v"(t_[7]) : "v"(adrB[3]), "n"(0*8192));
        asm volatile("s_waitcnt lgkmcnt(6)" : "+v"(t_[0]), "+v"(t_[1])); asm volatile("s_waitcnt lgkmcnt(4)" : "+v"(t_[2]), "+v"(t_[3]));
        asm volatile("s_waitcnt lgkmcnt(2)" : "+v"(t_[4]), "+v"(t_[5])); asm volatile("s_waitcnt lgkmcnt(0)" : "+v"(t_[6]), "+v"(t_[7]));
        { const u32x2 a_ = (godd ? t_[1] : t_[0]);
          acc[0] = __builtin_amdgcn_mfma_scale_f32_16x16x128_f8f6f4((v8i_t){(int)a_.x, (int)a_.y, 0, 0, 0, 0, 0, 0}, wb, (f32x4){0.f, 0.f, 0.f, 0.f}, 4, 0, 0, 0x7F7F7F7F, 0, wsc); }
        { const u32x2 a_ = (godd ? t_[0] : t_[1]);
          acc[1] = __builtin_amdgcn_mfma_scale_f32_16x16x128_f8f6f4((v8i_t){(int)a_.x, (int)a_.y, 0, 0, 0, 0, 0, 0}, wb, (f32x4){0.f, 0.f, 0.f, 0.f}, 4, 0, 0, 0x7F7F7F7F, 0, wsc); }
        { const u32x2 a_ = (godd ? t_[3] : t_[2]);
          acc[2] = __builtin_amdgcn_mfma_scale_f32_16x16x128_f8f6f4((v8i_t){(int)a_.x, (int)a_.y, 0, 0, 0, 0, 0, 0}, wb, (f32x4){0.f, 0.f, 0.f, 0.f}, 4, 0, 0, 0x7F7F7F7F, 0, wsc); }
        { const u32x2 a_ = (godd ? t_[2] : t_[3]);
          acc[3] = __builtin_amdgcn_mfma_scale_f32_16x16x128_f8f6f4((v8i_t){(int)a_.x, (int)a_.y, 0, 0, 0, 0, 0, 0}, wb, (f32x4){0.f, 0.f, 0.f, 0.f}, 4, 0, 0, 0x7F7F7F7F, 0, wsc); }
        { const u32x2 a_ = (godd ? t_[5] : t_[4]);
          acc[4] = __builtin_amdgcn_mfma_scale_f32_16x16x128_f8f6f4((v8i_t){(int)a_.x, (int)a_.y, 0, 0, 0, 0, 0, 0}, wb, (f32x4){0.f, 0.f, 0.f, 0.f}, 4, 0, 0, 0x7F7F7F7F, 0, wsc); }
        { const u32x2 a_ = (godd ? t_[4] : t_[5]);
          acc[5] = __builtin_amdgcn_mfma_scale_f32_16x16x128_f8f6f4((v8i_t){(int)a_.x, (int)a_.y, 0, 0, 0, 0, 0, 0}, wb, (f32x4){0.f, 0.f, 0.f, 0.f}, 4, 0, 0, 0x7F7F7F7F, 0, wsc); }
        { const u32x2 a_ = (godd ? t_[7] : t_[6]);
          acc[6] = __builtin_amdgcn_mfma_scale_f32_16x16x128_f8f6f4((v8i_t){(int)a_.x, (int)a_.y, 0, 0, 0, 0, 0, 0}, wb, (f32x4){0.f, 0.f, 0.f, 0.f}, 4, 0, 0, 0x7F7F7F7F, 0, wsc); }
        { const u32x2 a_ = (godd ? t_[6] : t_[7]);
          acc[7] = __builtin_amdgcn_mfma_scale_f32_16x16x128_f8f6f4((v8i_t){(int)a_.x, (int)a_.y, 0, 0, 0, 0, 0, 0}, wb, (f32x4){0.f, 0.f, 0.f, 0.f}, 4, 0, 0, 0x7F7F7F7F, 0, wsc); }
        asm volatile("ds_read_b64_tr_b4 %0, %1 offset:%2" : "=v"(t_[0]) : "v"(adrA[4]), "n"(0*8192));
        asm volatile("ds_read_b64_tr_b4 %0, %1 offset:%2" : "=v"(t_[1]) : "v"(adrB[4]), "n"(0*8192));
        asm volatile("ds_read_b64_tr_b4 %0, %1 offset:%2" : "=v"(t_[2]) : "v"(adrA[5]), "n"(0*8192));
        asm volatile("ds_read_b64_tr_b4 %0, %1 offset:%2" : "=v"(t_[3]) : "v"(adrB[5]), "n"(0*8192));
        asm volatile("ds_read_b64_tr_b4 %0, %1 offset:%2" : "=v"(t_[4]) : "v"(adrA[6]), "n"(0*8192));
        asm volatile("ds_read_b64_tr_b4 %0, %1 offset:%2" : "=v"(t_[5]) : "v"(adrB[6]), "n"(0*8192));
        asm volatile("ds_read_b64_tr_b4 %0, %1 offset:%2" : "=v"(t_[6]) : "v"(adrA[7]), "n"(0*8192));
        asm volatile("ds_read_b64_tr_b4 %0, %1 offset:%2" : "=v"(t_[7]) : "v"(adrB[7]), "n"(0*8192));
        asm volatile("s_waitcnt lgkmcnt(6)" : "+v"(t_[0]), "+v"(t_[1])); asm volatile("s_waitcnt lgkmcnt(4)" : "+v"(t_[2]), "+v"(t_[3]));
        asm volatile("s_waitcnt lgkmcnt(2)" : "+v"(t_[4]), "+v"(t_[5])); asm volatile("s_waitcnt lgkmcnt(0)" : "+v"(t_[6]), "+v"(t_[7]));
        { const u32x2 a_ = (godd ? t_[1] : t_[0]);
          acc[8] = __builtin_amdgcn_mfma_scale_f32_16x16x128_f8f6f4((v8i_t){(int)a_.x, (int)a_.y, 0, 0, 0, 0, 0, 0}, wb, (f32x4){0.f, 0.f, 0.f, 0.f}, 4, 0, 0, 0x7F7F7F7F, 0, wsc); }
        { const u32x2 a_ = (godd ? t_[0] : t_[1]);
          acc[9] = __builtin_amdgcn_mfma_scale_f32_16x16x128_f8f6f4((v8i_t){(int)a_.x, (int)a_.y, 0, 0, 0, 0, 0, 0}, wb, (f32x4){0.f, 0.f, 0.f, 0.f}, 4, 0, 0, 0x7F7F7F7F, 0, wsc); }
        { const u32x2 a_ = (godd ? t_[3] : t_[2]);
          acc[10] = __builtin_amdgcn_mfma_scale_f32_16x16x128_f8f6f4((v8i_t){(int)a_.x, (int)a_.y, 0, 0, 0, 0, 0, 0}, wb, (f32x4){0.f, 0.f, 0.f, 0.f}, 4, 0, 0, 0x7F7F7F7F, 0, wsc); }
        { const u32x2 a_ = (godd ? t_[2] : t_[3]);
          acc[11] = __builtin_amdgcn_mfma_scale_f32_16x16x128_f8f6f4((v8i_t){(int)a_.x, (int)a_.y, 0, 0, 0, 0, 0, 0}, wb, (f32x4){0.f, 0.f, 0.f, 0.f}, 4, 0, 0, 0x7F7F7F7F, 0, wsc); }
        { const u32x2 a_ = (godd ? t_[5] : t_[4]);
          acc[12] = __builtin_amdgcn_mfma_scale_f32_16x16x128_f8f6f4((v8i_t){(int)a_.x, (int)a_.y, 0, 0, 0, 0, 0, 0}, wb, (f32x4){0.f, 0.f, 0.f, 0.f}, 4, 0, 0, 0x7F7F7F7F, 0, wsc); }
        { const u32x2 a_ = (godd ? t_[4] : t_[5]);
          acc[13] = __builtin_amdgcn_mfma_scale_f32_16x16x128_f8f6f4((v8i_t){(int)a_.x, (int)a_.y, 0, 0, 0, 0, 0, 0}, wb, (f32x4){0.f, 0.f, 0.f, 0.f}, 4, 0, 0, 0x7F7F7F7F, 0, wsc); }
        { const u32x2 a_ = (godd ? t_[7] : t_[6]);
          acc[14] = __builtin_amdgcn_mfma_scale_f32_16x16x128_f8f6f4((v8i_t){(int)a_.x, (int)a_.y, 0, 0, 0, 0, 0, 0}, wb, (f32x4){0.f, 0.f, 0.f, 0.f}, 4, 0, 0, 0x7F7F7F7F, 0, wsc); }
        { const u32x2 a_ = (godd ? t_[6] : t_[7]);
          acc[15] = __builtin_amdgcn_mfma_scale_f32_16x16x128_f8f6f4((v8i_t){(int)a_.x, (int)a_.y, 0, 0, 0, 0, 0, 0}, wb, (f32x4){0.f, 0.f, 0.f, 0.f}, 4, 0, 0, 0x7F7F7F7F, 0, wsc); }
        }
        if (!last) { u32x4 idn; PV_RD_IDS(idn, 0, par ^ 1); PV_ISSUE(0, idn); }
        if (last) asm volatile("s_waitcnt vmcnt(0)" ::: "memory"); else asm volatile("s_waitcnt vmcnt(8)" ::: "memory");
        { u32x2 t_[8];
        asm volatile("ds_read_b64_tr_b4 %0, %1 offset:%2" : "=v"(t_[0]) : "v"(adrA[0]), "n"(1*8192));
        asm volatile("ds_read_b64_tr_b4 %0, %1 offset:%2" : "=v"(t_[1]) : "v"(adrB[0]), "n"(1*8192));
        asm volatile("ds_read_b64_tr_b4 %0, %1 offset:%2" : "=v"(t_[2]) : "v"(adrA[1]), "n"(1*8192));
        asm volatile("ds_read_b64_tr_b4 %0, %1 offset:%2" : "=v"(t_[3]) : "v"(adrB[1]), "n"(1*8192));
        asm volatile("ds_read_b64_tr_b4 %0, %1 offset:%2" : "=v"(t_[4]) : "v"(adrA[2]), "n"(1*8192));
        asm volatile("ds_read_b64_tr_b4 %0, %1 offset:%2" : "=v"(t_[5]) : "v"(adrB[2]), "n"(1*8192));
        asm volatile("ds_read_b64_tr_b4 %0, %1 offset:%2" : "=v"(t_[6]) : "v"(adrA[3]), "n"(1*8192));
        asm volatile("ds_read_b64_tr_b4 %0, %1 offset:%2" : "=v"(t_[7]) : "v"(adrB[3]), "n"(1*8192));
        asm volatile("s_waitcnt lgkmcnt(6)" : "+v"(t_[0]), "+v"(t_[1])); asm volatile("s_waitcnt lgkmcnt(4)" : "+v"(t_[2]), "+v"(t_[3]));
        asm volatile("s_waitcnt lgkmcnt(2)" : "+v"(t_[4]), "+v"(t_[5])); asm volatile("s_waitcnt lgkmcnt(0)" : "+v"(t_[6]), "+v"(t_[7]));
        { const u32x2 a_ = (godd ? t_[1] : t_[0]);
          acc[0] = __builtin_amdgcn_mfma_scale_f32_16x16x128_f8f6f4((v8i_t){0, 0, (int)a_.x, (int)a_.y, 0, 0, 0, 0}, wb, acc[0], 4, 0, 0, 0x7F7F7F7F, 0, wsc); }
        { const u32x2 a_ = (godd ? t_[0] : t_[1]);
          acc[1] = __builtin_amdgcn_mfma_scale_f32_16x16x128_f8f6f4((v8i_t){0, 0, (int)a_.x, (int)a_.y, 0, 0, 0, 0}, wb, acc[1], 4, 0, 0, 0x7F7F7F7F, 0, wsc); }
        { const u32x2 a_ = (godd ? t_[3] : t_[2]);
          acc[2] = __builtin_amdgcn_mfma_scale_f32_16x16x128_f8f6f4((v8i_t){0, 0, (int)a_.x, (int)a_.y, 0, 0, 0, 0}, wb, acc[2], 4, 0, 0, 0x7F7F7F7F, 0, wsc); }
        { const u32x2 a_ = (godd ? t_[2] : t_[3]);
          acc[3] = __builtin_amdgcn_mfma_scale_f32_16x16x128_f8f6f4((v8i_t){0, 0, (int)a_.x, (int)a_.y, 0, 0, 0, 0}, wb, acc[3], 4, 0, 0, 0x7F7F7F7F, 0, wsc); }
        { const u32x2 a_ = (godd ? t_[5] : t_[4]);
          acc[4] = __builtin_amdgcn_mfma_scale_f32_16x16x128_f8f6f4((v8i_t){0, 0, (int)a_.x, (int)a_.y, 0, 0, 0, 0}, wb, acc[4], 4, 0, 0, 0x7F7F7F7F, 0, wsc); }
        { const u32x2 a_ = (godd ? t_[4] : t_[5]);
          acc[5] = __builtin_amdgcn_mfma_scale_f32_16x16x128_f8f6f4((v8i_t){0, 0, (int)a_.x, (int)a_.y, 0, 0, 0, 0}, wb, acc[5], 4, 0, 0, 0x7F7F7F7F, 0, wsc); }
        { const u32x2 a_ = (godd ? t_[7] : t_[6]);
          acc[6] = __builtin_amdgcn_mfma_scale_f32_16x16x128_f8f6f4((v8i_t){0, 0, (int)a_.x, (int)a_.y, 0, 0, 0, 0}, wb, acc[6], 4, 0, 0, 0x7F7F7F7F, 0, wsc); }
        { const u32x2 a_ = (godd ? t_[6] : t_[7]);
          acc[7] = __builtin_amdgcn_mfma_scale_f32_16x16x128_f8f6f4((v8i_t){0, 0, (int)a_.x, (int)a_.y, 0, 0, 0, 0}, wb, acc[7], 4, 0, 0, 0x7F7F7F7F, 0, wsc); }
        asm volatile("ds_read_b64_tr_b4 %0, %1 offset:%2" : "=v"(t_[0]) : "v"(adrA[4]), "n"(1*8192));
        asm volatile("ds_read_b64_tr_b4 %0, %1 offset:%2" : "=v"(t_[1]) : "v"(adrB[4]), "n"(1*8192));
        asm volatile("ds_read_b64_tr_b4 %0, %1 offset:%2" : "=v"(t_[2]) : "v"(adrA[5]), "n"(1*8192));
        asm volatile("ds_read_b64_tr_b4 %0, %1 offset:%2" : "=v"(t_[3]) : "v"(adrB[5]), "n"(1*8192));
        asm volatile("ds_read_b64_tr_b4 %0, %1 offset:%2" : "=v"(t_[4]) : "v"(adrA[6]), "n"(1*8192));
        asm volatile("ds_read_b64_tr_b4 %0, %1 offset:%2" : "=v"(t_[5]) : "v"(adrB[6]), "n"(1*8192));
        asm volatile("ds_read_b64_tr_b4 %0, %1 offset:%2" : "=v"(t_[6]) : "v"(adrA[7]), "n"(1*8192));
        asm volatile("ds_read_b64_tr_b4 %0, %1 offset:%2" : "=v"(t_[7]) : "v"(adrB[7]), "n"(1*8192));
        asm volatile("s_waitcnt lgkmcnt(6)" : "+v"(t_[0]), "+v"(t_[1])); asm volatile("s_waitcnt lgkmcnt(4)" : "+v"(t_[2]), "+v"(t_[3]));
        asm volatile("s_waitcnt lgkmcnt(2)" : "+v"(t_[4]), "+v"(t_[5])); asm volatile("s_waitcnt lgkmcnt(0)" : "+v"(t_[6]), "+v"(t_[7]));
        { const u32x2 a_ = (godd ? t_[1] : t_[0]);
          acc[8] = __builtin_amdgcn_mfma_scale_f32_16x16x128_f8f6f4((v8i_t){0, 0, (int)a_.x, (int)a_.y, 0, 0, 0, 0}, wb, acc[8], 4, 0, 0, 0x7F7F7F7F, 0, wsc); }
        { const u32x2 a_ = (godd ? t_[0] : t_[1]);
          acc[9] = __builtin_amdgcn_mfma_scale_f32_16x16x128_f8f6f4((v8i_t){0, 0, (int)a_.x, (int)a_.y, 0, 0, 0, 0}, wb, acc[9], 4, 0, 0, 0x7F7F7F7F, 0, wsc); }
        { const u32x2 a_ = (godd ? t_[3] : t_[2]);
          acc[10] = __builtin_amdgcn_mfma_scale_f32_16x16x128_f8f6f4((v8i_t){0, 0, (int)a_.x, (int)a_.y, 0, 0, 0, 0}, wb, acc[10], 4, 0, 0, 0x7F7F7F7F, 0, wsc); }
        { const u32x2 a_ = (godd ? t_[2] : t_[3]);
          acc[11] = __builtin_amdgcn_mfma_scale_f32_16x16x128_f8f6f4((v8i_t){0, 0, (int)a_.x, (int)a_.y, 0, 0, 0, 0}, wb, acc[11], 4, 0, 0, 0x7F7F7F7F, 0, wsc); }
        { const u32x2 a_ = (godd ? t_[5] : t_[4]);
          acc[12] = __builtin_amdgcn_mfma_scale_f32_16x16x128_f8f6f4((v8i_t){0, 0, (int)a_.x, (int)a_.y, 0, 0, 0, 0}, wb, acc[12], 4, 0, 0, 0x7F7F7F7F, 0, wsc); }
        { const u32x2 a_ = (godd ? t_[4] : t_[5]);
          acc[13] = __builtin_amdgcn_mfma_scale_f32_16x16x128_f8f6f4((v8i_t){0, 0, (int)a_.x, (int)a_.y, 0, 0, 0, 0}, wb, acc[13], 4, 0, 0, 0x7F7F7F7F, 0, wsc); }
        { const u32x2 a_ = (godd ? t_[7] : t_[6]);
          acc[14] = __builtin_amdgcn_mfma_scale_f32_16x16x128_f8f6f4((v8i_t){0, 0, (int)a_.x, (int)a_.y, 0, 0, 0, 0}, wb, acc[14], 4, 0, 0, 0x7F7F7F7F, 0, wsc); }
        { const u32x2 a_ = (godd ? t_[6] : t_[7]);
          acc[15] = __builtin_amdgcn_mfma_scale_f32_16x16x128_f8f6f4((v8i_t){0, 0, (int)a_.x, (int)a_.y, 0, 0, 0, 0}, wb, acc[15], 4, 0, 0, 0x7F7F7F7F, 0, wsc); }
        }
        { f32x4 o = acc[0];
#pragma unroll
          for (int cg = 1; cg < 16; ++cg) { const bool sel = (idx == cg); o[0] = sel ? acc[cg][0] : o[0]; o[1] = sel ? acc[cg][1] : o[1]; o[2] = sel ? acc[cg][2] : o[2]; o[3] = sel ? acc[cg][3] : o[3]; }
          asm volatile("" : "+v"(o));
          u32x2 ov; ov.x = pk2(o[0], o[1]); ov.y = pk2(o[2], o[3]);
          *(u32x2*)(fbuf + (size_t)row * D + slice * 256 + 16 * idx + 4 * g) = ov; }
        if (!last) { u32x4 idn; PV_RD_IDS(idn, 1, par ^ 1); PV_DMA_WB(row + 1, par ^ 1); PV_DMA_IDS(row + (ti + 2 < NTW ? 2 : 1), par); PV_ISSUE(1, idn); }
    }
#undef PV_DMA_IDS
#undef PV_DMA_WB
#undef PV_RD_IDS
#undef PV_ISSUE
}

struct Ln2In { TRow t; u32x2 f[4]; };
__device__ __forceinline__ void ln2_load(Ln2In& I, int row, int lane, const bf16_t* fbuf, const bf16_t* tb) {
    trow_load(I.t, row, lane, tb); const bf16_t* fp = fbuf + (size_t)row * D;
#pragma unroll
    for (int j = 0; j < 4; ++j) I.f[j] = *(const u32x2*)(fp + j * 256 + lane * 4);
}
__device__ __forceinline__ float ln2_row(f32x4 (&v)[4], const Ln2In& I, int row, int lane, const f32x4 (&l1g)[4], const f32x4 (&l1b)[4], const f32x4 (&g2)[4], const f32x4 (&lg)[4], const f32x4 (&lb)[4], float* x2f, bf16_t* x2b, float* x2c) {
    float sm = 0.f;
    (void)ln1_apply(v, I.t, l1g, l1b);
#pragma unroll
    for (int j = 0; j < 4; ++j) { const u32x2 fw = I.f[j]; const f32x4 f = (f32x4){bflo(fw.x), bfhi(fw.x), bflo(fw.y), bfhi(fw.y)};
        v[j] = v[j] * ALPHA + g2[j] * f; sm += (v[j][0] + v[j][1]) + (v[j][2] + v[j][3]); }
    const float mu = wave_sum(sm) * (1.0f / 1024.0f); float q = 0.f;
#pragma unroll
    for (int j = 0; j < 4; ++j) { v[j] = v[j] - mu; q += (v[j][0] * v[j][0] + v[j][1] * v[j][1]) + (v[j][2] * v[j][2] + v[j][3] * v[j][3]); }
    const float rstd = 1.0f / sqrtf(wave_sum(q) * (1.0f / 1024.0f) + EPS);
    sm = 0.f;
#pragma unroll
    for (int j = 0; j < 4; ++j) { v[j] = v[j] * rstd * lg[j] + lb[j]; row_store(v[j], row, j * 256 + lane * 4, x2f, x2b, x2c); sm += (v[j][0] + v[j][1]) + (v[j][2] + v[j][3]); }
    return sm;
}
#ifndef MK_SINGLE
#define MK_SINGLE 1
#endif
__global__ void __launch_bounds__(NTHREADS, 2) mk_fwd(Params P) {
    extern __shared__ __attribute__((aligned(16))) unsigned char lds_raw[];
    Frame F;
    F.lds = (LAS unsigned char*)lds_raw;
    F.tid = threadIdx.x; F.lane = F.tid & 63; F.wave = __builtin_amdgcn_readfirstlane(F.tid >> 6);
    F.G = gridDim.x; { const int bx = blockIdx.x; F.vcu = (F.G % 8 == 0) ? (bx % 8) * (F.G / 8) + bx / 8 : bx; }
    volatile LAS unsigned* MISC = (volatile LAS unsigned*)(F.lds + MISC_OFF);
    for (int u = F.tid; u < (LDS_BYTES - MISC_OFF) / 4; u += NTHREADS) MISC[u] = 0u;
    __syncthreads();
    unsigned char* ws = P.ws;
    unsigned* ctl = (unsigned*)(ws + WS_CTL);
    XcdBarrier bar; bar.bar = ctl + CW_BAR; bar.x = 0; bar.st = nullptr;
    if (P.ph_hi - P.ph_lo > 1) bar = xcd_barrier_post(ctl + CW_BAR, MISC + 8);

    const float* x = P.in[0]; const float* c = P.in[1]; const float* ctxin = P.in[2]; const float* c_ctx = P.in[3]; const float* w_mod = P.in[4]; const float* b_mod = P.in[5];
    const float* w_in = P.in[6]; const float* q_norm_g = P.in[7]; const float* k_norm_g = P.in[8]; const float* gmlp_ln_g = P.in[9]; const float* gmlp_ln_b = P.in[10];
    const float* gmlp_w_s = P.in[11]; const float* gmlp_b_s = P.in[12]; const float* conv_w_dw = P.in[13]; const float* conv_b_dw = P.in[14]; const float* conv_ln_g = P.in[15];
    const float* conv_ln_b = P.in[16]; const float* conv_w_pw = P.in[17]; const float* conv_b_pw = P.in[18]; const float* w_out = P.in[19]; const float* ln1_g = P.in[20];
    const float* ln1_b = P.in[21]; const float* ln2_g = P.in[22]; const float* ln2_b = P.in[23]; const float* peer_w_q = P.in[24]; const float* peer_sk = P.in[25];
    const float* peer_u = P.in[26]; const float* peer_v = P.in[27];
    float* out = P.out;
    float* mod = (float*)(ws + WS_MOD); float* rope = (float*)(ws + WS_ROPE); float* bout = (float*)(ws + WS_BOUT);
    bf16_t* Win_t = (bf16_t*)(ws + WS_WIN_T); bf16_t* Wout_t = (bf16_t*)(ws + WS_WOUT_T); bf16_t* Ws_t = (bf16_t*)(ws + WS_WS_T); bf16_t* gws = (bf16_t*)(ws + WS_GWS);
    float* xc1 = (float*)(ws + WS_XC1); float* xc2 = (float*)(ws + WS_XC2);
    unsigned char* u8 = ws + WS_U8; unsigned char* v8 = ws + WS_V8;
    bf16_t* hbuf = (bf16_t*)(ws + WS_H); bf16_t* qbuf = (bf16_t*)(ws + WS_Q); bf16_t* kvbuf = (bf16_t*)(ws + WS_KV); bf16_t* zgbuf = (bf16_t*)(ws + WS_ZG); bf16_t* ycbuf = (bf16_t*)(ws + WS_YC);
    bf16_t* mix = (bf16_t*)(ws + WS_MIX); bf16_t* ybuf = (bf16_t*)(ws + WS_Y); unsigned short* sbuf = (unsigned short*)(ws + WS_S);
    bf16_t* pact = (bf16_t*)(ws + WS_PACT); bf16_t* fbuf = (bf16_t*)(ws + WS_F); unsigned short* tk_idx = (unsigned short*)(ws + WS_TKI); float* tk_gate = (float*)(ws + WS_TKG); unsigned char* w8buf = ws + WS_W; unsigned* wscbuf = (unsigned*)(ws + WS_W + 8 * MiB); unsigned char* h8buf = ws + WS_H8; bf16_t* x2b = (bf16_t*)out;

    const P0Ptrs PP{c, c_ctx, w_mod, b_mod, peer_w_q, peer_sk, conv_w_pw, conv_b_pw, w_out, w_in, peer_u, peer_v, mod, bout, Ws_t, Wout_t, Win_t, u8, v8};
    const int lo = P.ph_lo, hi = P.ph_hi;
#ifdef PROBE_MASK
    unsigned long long probe_acc = 0ull, probe_t0 = 0ull;
#define PROBE_BEGIN(k) do { if ((PROBE_MASK >> (k)) & 1) { __syncthreads(); probe_t0 = __builtin_amdgcn_s_memrealtime(); } } while (0)
#define PROBE_END(k) do { if ((PROBE_MASK >> (k)) & 1) { __syncthreads(); probe_acc += __builtin_amdgcn_s_memrealtime() - probe_t0; } } while (0)
#else
#define PROBE_BEGIN(k) do {} while (0)
#define PROBE_END(k) do {} while (0)
#endif
#define IN(k) (lo <= (k) && (k) < hi)
#define SEAM(k) do { if (IN(k) && IN((k) + 1)) xcd_barrier(bar); } while (0)
    const int gw = F.vcu * NWAVES + F.wave, NGW = F.G * NWAVES;
    const int gt = gw * 64 + F.lane, NGT = NGW * 64;

    PROBE_BEGIN(0);
    if (IN(0)) {
#ifndef NO_P0
        p0_block_items(F, PP, 0, 7, F.vcu, F.G);
        p0_wave_transposes(F, PP, 0, gw, NGW);
        for (int i = gt; i < 2048; i += NGT) { const int pos = i >> 4, f = i & 15; const double a = (double)pos * exp(-(double)f * (9.210340371976184 / 16.0)); rope[i * 2] = (float)cos(a); rope[i * 2 + 1] = (float)sin(a); }
        for (int i = gt; i < 2 * 4 * 128 * 128 / 2; i += NGT) { const f32x2 v = *(const f32x2*)(gmlp_w_s + (size_t)i * 2); ((unsigned*)gws)[i] = pk2(v[0], v[1]); }
        p0_convert_tables(PP, 0, gt, NGT);
        __syncthreads();
#endif
    }
    SEAM(0);
    PROBE_END(0);
    PROBE_BEGIN(1);
    if (IN(1)) {
#pragma unroll 1
        for (int ch = gw; ch < ML / 16; ch += NGW) {
            const int r0 = ch * 16; const float* mp = mod + (size_t)modid(r0) * 6144;
            f32x4 sh[4], sc[4]; load_par(sh, mp, F.lane); load_par(sc, mp + 1024, F.lane);
#pragma unroll 1
            for (int tr = 0; tr < 4; ++tr) {
                f32x4 xv[4][4];
#pragma unroll
                for (int k = 0; k < 4; ++k) { const float* xp = x + (size_t)(r0 + tr * 4 + k) * D;
#pragma unroll
                    for (int j = 0; j < 4; ++j) xv[k][j] = *(const f32x4*)(xp + j * 256 + F.lane * 4); }
#pragma unroll
                for (int k = 0; k < 4; ++k) { float s = 0.f;
#pragma unroll
                    for (int j = 0; j < 4; ++j) s += (xv[k][j][0] + xv[k][j][1]) + (xv[k][j][2] + xv[k][j][3]);
                    adaln_store(xv[k], s, sh, sc, hbuf + (size_t)(r0 + tr * 4 + k) * D, F.lane); }
            }
        }
#pragma unroll 1
        for (int row = ML + gw; row < MT; row += NGW) {
            const float* mp = mod + (size_t)4 * 6144; f32x4 sh[4], sc[4], xv[4]; load_par(sh, mp, F.lane); load_par(sc, mp + 1024, F.lane); load_par(xv, ctxin + (size_t)(row - ML) * D, F.lane);
            float s = 0.f;
#pragma unroll
            for (int j = 0; j < 4; ++j) s += (xv[j][0] + xv[j][1]) + (xv[j][2] + xv[j][3]);
            adaln_store(xv, s, sh, sc, hbuf + (size_t)row * D, F.lane);
        }
    }
    SEAM(1);
    PROBE_END(1);

    for (int l = 0; l < 2; ++l) {
        const int pb = 2 + 10 * l;
#define LAUNDER() do { int t_ = threadIdx.x; asm volatile("" : "+v"(t_)); F.tid = t_; F.lane = t_ & 63; } while (0)
        const float* modl = mod + (size_t)l * 5 * 6144;
        const float* xl = l == 0 ? x : out; const float* xc = l == 0 ? ctxin : xc2;
        const int nr = l == 0 ? MT : ML;
        PROBE_BEGIN(2);
        if (IN(pb)) {
            LAUNDER();
#ifndef NO_A
            pg8::Gemm g{hbuf, Win_t + (size_t)l * INW * 1024, MT, INW, 1024}; pg8::StaticOrder S; S.init(MT, INW, F.G, (int)blockIdx.x);
            pg8::EpiInProj E{qbuf, kvbuf, zgbuf, ycbuf, q_norm_g + l * 64, k_norm_g + l * 64, rope};
            pg8::gemm_phase<pg8::EpiInProj, pg8::StaticOrder, true, true>(F.lds, g, S, E);
#endif
        }
        SEAM(pb);
        PROBE_END(2);
        PROBE_BEGIN(3);
        if (IN(pb + 1)) {
            LAUNDER();
#ifndef NO_ATT
            for (int u0 = F.vcu * 4; u0 < 1024; u0 += F.G * 4)
                for (int i = 0; i < 4; ++i) { const int u = u0 + i, gi = u >> 7, qb = (u & 127) >> 2, b = gi >> 1, g = gi & 1, hq = g * 4 + (u & 3);
                    const size_t row0 = (size_t)b * SEQ + qb * 256;
                    attn_body::attn_unit<8>((const attn_body::bf16*)(qbuf + row0 * 512 + hq * 64), (const attn_body::bf16*)(kvbuf + (size_t)b * KVSEQ * 256 + g * 64),
                                            (const attn_body::bf16*)(kvbuf + (size_t)b * KVSEQ * 256 + 128 + g * 64), (attn_body::bf16*)(mix + row0 * 1024 + hq * 64), KVSEQ / 64, (char*)lds_raw); }
            if (l == 0)
                for (int u = F.vcu; u < 32; u += F.G) { const int b = u >> 3, hq = u & 7, g = hq >> 2; const size_t row0 = (size_t)ML + b * CTXL;
                    attn_body::attn_unit<8>((const attn_body::bf16*)(qbuf + row0 * 512 + hq * 64), (const attn_body::bf16*)(kvbuf + (size_t)b * KVSEQ * 256 + g * 64),
                                            (const attn_body::bf16*)(kvbuf + (size_t)b * KVSEQ * 256 + 128 + g * 64), (attn_body::bf16*)(mix + row0 * 1024 + hq * 64), CTXL / 64, (char*)lds_raw); }
#endif
            __syncthreads();
            PROBE_BEGIN(12);
#ifndef NO_GMLP
            for (int ch = F.vcu; ch < nr / 128; ch += F.G)
                gmlp_chunk(F, ch, zgbuf, gmlp_ln_g + l * 256, gmlp_ln_b + l * 256, gws + (size_t)l * 4 * 128 * 128, gmlp_b_s + l * 512, mix);
#endif
#ifndef NO_CONV
            for (int tl = (F.vcu < F.G / 2 ? F.vcu + F.G / 2 : F.vcu - F.G / 2); tl < nr / 128; tl += F.G)
                conv_tile(F, tl, ycbuf, conv_w_dw + l * 31 * 256, conv_b_dw + l * 256, conv_ln_g + l * 256, conv_ln_b + l * 256, mix);
#endif
            PROBE_END(12);
            __syncthreads();
        }
        SEAM(pb + 1);
        PROBE_END(3);
        PROBE_BEGIN(4);
        if (IN(pb + 2)) {
            LAUNDER();
            pg8::Gemm g{mix, Wout_t + (size_t)l * 1024 * 1024, nr, 1024, 1024}; pg8::StaticOrder S; S.init(nr, 1024, F.G, (int)blockIdx.x);
            pg8::EpiResid E{ybuf, bout + l * 1024, modl, x, l == 0 ? (const bf16_t*)nullptr : (const bf16_t*)x2b, xc};
#ifndef NO_GF32
            pg8::gemm_phase<pg8::EpiResid, pg8::StaticOrder, true, true>(F.lds, g, S, E);
#endif
            if (l == 0) { int nw; const int w = idle_worker((nr / 256) * 4, F.G, (int)blockIdx.x, nw); if (w >= 0) { LAUNDER(); p0_block_items(F, PP, 1, 2, w, nw); } }
        }
        SEAM(pb + 2);
        PROBE_END(4);
        PROBE_BEGIN(5);
        if (IN(pb + 3)) { LAUNDER();
            const int w0 = F.vcu * NWAVES + __builtin_amdgcn_readfirstlane(F.tid >> 6);
            f32x4 lg[4], lb[4]; load_par(lg, ln1_g + l * 1024, F.lane); load_par(lb, ln1_b + l * 1024, F.lane);
#pragma unroll 1
            for (int ch = w0; ch < ML / 16; ch += NGW) {
                const int r0 = ch * 16; const float* mp = modl + (size_t)modid(r0) * 6144;
                f32x4 sh[4], sc[4]; load_par(sh, mp + 3072, F.lane); load_par(sc, mp + 4096, F.lane);
#pragma unroll 1
                for (int tr = 0; tr < 4; ++tr) {
                    TRow in4[4];
#pragma unroll
                    for (int k = 0; k < 4; ++k) trow_load(in4[k], r0 + tr * 4 + k, F.lane, ybuf);
#pragma unroll
                    for (int k = 0; k < 4; ++k) { f32x4 v[4]; const float s = ln1_apply(v, in4[k], lg, lb); adaln_store(v, s, sh, sc, hbuf + (size_t)(r0 + tr * 4 + k) * D, F.lane, h8buf + (size_t)(r0 + tr * 4 + k) * D); }
                }
                        }
#pragma unroll 1
            for (int row = ML + w0; row < nr; row += NGW) {
                const float* mp = modl + (size_t)4 * 6144; f32x4 sh[4], sc[4]; load_par(sh, mp + 3072, F.lane); load_par(sc, mp + 4096, F.lane);
                TRow in1; trow_load(in1, row, F.lane, ybuf); f32x4 v[4]; const float s = ln1_apply(v, in1, lg, lb); adaln_store(v, s, sh, sc, hbuf + (size_t)row * D, F.lane, h8buf + (size_t)row * D);
            } }
        SEAM(pb + 3);
        PROBE_END(5);
        PROBE_BEGIN(6);
        if (IN(pb + 4)) {
            LAUNDER();
            pg8::Gemm g{hbuf, Ws_t + (size_t)l * 2048 * 1024, nr, 2048, 1024}; pg8::StaticOrder S; S.init(nr, 2048, F.G, (int)blockIdx.x);
#ifdef TK_F32
            pg8::EpiF32 E{(float*)sbuf, 2048, nullptr};
            pg8::gemm_phase<pg8::EpiF32, pg8::StaticOrder, true, true>(F.lds, g, S, E);
#else
            pg8::EpiF16 E{sbuf, 2048};
#ifndef NO_GF32
            pg8::gemm_phase<pg8::EpiF16, pg8::StaticOrder, true, true>(F.lds, g, S, E);
#endif
#ifndef TK_F32
            if (l == 0) { int nw; const int w = idle_worker((nr / 256) * 8, F.G, (int)blockIdx.x, nw);
                if (w >= 0) { LAUNDER(); p0_block_items(F, PP, 1, 5, w, nw); p0_wave_transposes(F, PP, 1, w * NWAVES + F.wave, nw * NWAVES); p0_convert_tables(PP, 1, w * NTHREADS + F.tid, nw * NTHREADS); __syncthreads(); } }
#endif
#endif
        }
        SEAM(pb + 4);
        PROBE_END(6);
        PROBE_BEGIN(7);
        if (IN(pb + 5)) {
            LAUNDER();
#ifndef NO_PEER
            peer_topk_wave(F, gw, nr / 4, NGW, sbuf, tk_idx, tk_gate);
#endif
        }
        SEAM(pb + 5);
        PROBE_END(7);
        PROBE_BEGIN(8);
        if (IN(pb + 6)) {
            LAUNDER();
#ifndef NO_PEER
            const int own = (int)(xb_xcc_id() & 7u) >> 1;
            for (int so = 0; so < 4; ++so) { const int slice = (own + so) & 3; unsigned* qw = ctl + CW_Q + ((l * 2 + 0) * 8 + slice) * 64;
                for (;;) { const int item = q_next(F, qw); const unsigned char* ut = u8 + ((size_t)l * 4 + slice) * 16384 * 128;
                    if (item < ML / 512) peer_u_item<64>(F, 0, item, slice, h8buf, tk_idx, ut, pact);
                    else if (item < ML / 512 + (nr - ML) / 16) peer_u_item<2>(F, ML, item - ML / 512, slice, h8buf, tk_idx, ut, pact);
                    else break; } }
#endif
        }
        SEAM(pb + 6);
        PROBE_END(8);
        PROBE_BEGIN(9);
        if (IN(pb + 7)) {
            LAUNDER();
#ifndef NO_PEER
            const int gt2 = F.vcu * NTHREADS + F.tid;
            for (int i = gt2; i < nr * 32; i += NGT) {
                f32x4 a = (f32x4){0.f, 0.f, 0.f, 0.f};
#pragma unroll
                for (int sl = 0; sl < 4; ++sl) { const u32x2 pw = *(const u32x2*)(pact + ((size_t)sl * MT * 128) + (size_t)i * 4); a = a + (f32x4){bflo(pw.x), bfhi(pw.x), bflo(pw.y), bfhi(pw.y)}; }
                const f32x4 g = *(const f32x4*)(tk_gate + (size_t)i * 4);
                f32x4 w;
#pragma unroll
                for (int e = 0; e < 4; ++e) w[e] = g[e] * gelu_tanh(a[e] * (1.0f / (U_SCALE * H_SCALE))) * (1.0f / V_SCALE);
                float mx = fmaxf(fmaxf(fabsf(w[0]), fabsf(w[1])), fmaxf(fabsf(w[2]), fabsf(w[3])));
                mx = fmaxf(mx, dpp_f<0xB1>(mx)); mx = fmaxf(mx, dpp_f<0x4E>(mx)); mx = fmaxf(mx, dpp_f<0x141>(mx)); mx = fmaxf(mx, dpp_f<0x140>(mx)); mx = fmaxf(mx, xchg16(mx, F.lane & 16));
                int ex = (int)((__float_as_uint(mx) >> 23) & 255u) - 127; ex = ex < -100 ? -100 : ex;
                const float sc = __uint_as_float((unsigned)(134 - ex) << 23);
                int pw8 = 0; pw8 = __builtin_amdgcn_cvt_pk_fp8_f32(w[0] * sc, w[1] * sc, pw8, false); pw8 = __builtin_amdgcn_cvt_pk_fp8_f32(w[2] * sc, w[3] * sc, pw8, true);
                *(unsigned*)(w8buf + (size_t)i * 4) = (unsigned)pw8;
                if ((i & 31) == 0) wscbuf[i >> 5] = 0x01010101u * (unsigned)(ex + 120);
            }
#endif
        }
        SEAM(pb + 7);
        PROBE_END(9);
        PROBE_BEGIN(10);
        if (IN(pb + 8)) {
            LAUNDER();
#ifndef NO_PEER
            const int own = (int)(xb_xcc_id() & 7u) >> 1;
            for (int so = 0; so < 4; ++so) { const int slice = (own + so) & 3; unsigned* qw = ctl + CW_Q + ((l * 2 + 1) * 8 + slice) * 64;
                for (;;) { const int item = q_next(F, qw); const unsigned char* vt = v8 + ((size_t)l * 4 + slice) * 16384 * 128;
                    if (item < ML / 512) peer_v_item<64>(F, 0, item, slice, tk_idx, w8buf, wscbuf, vt, fbuf);
                    else if (item < ML / 512 + (nr - ML) / 16) peer_v_item<2>(F, ML, item - ML / 512, slice, tk_idx, w8buf, wscbuf, vt, fbuf);
                    else break; } }
#endif
        }
        SEAM(pb + 8);
        PROBE_END(10);
        PROBE_BEGIN(11);
        if (IN(pb + 9)) { LAUNDER();
            const int w0 = F.vcu * NWAVES + __builtin_amdgcn_readfirstlane(F.tid >> 6);
            f32x4 l1g[4], l1b[4], lg[4], lb[4];
            load_par(l1g, ln1_g + l * 1024, F.lane); load_par(l1b, ln1_b + l * 1024, F.lane); load_par(lg, ln2_g + l * 1024, F.lane); load_par(lb, ln2_b + l * 1024, F.lane);
            const float* modn = l == 0 ? mod + (size_t)5 * 6144 : (const float*)nullptr;
#pragma unroll 1
            for (int ch = w0; ch < ML / 16; ch += NGW) {
                const int r0 = ch * 16; const int mi = modid(r0);
                f32x4 g2[4]; load_par(g2, modl + (size_t)mi * 6144 + 5120, F.lane);
#pragma unroll 1
                for (int tr = 0; tr < 8; ++tr) {
                    Ln2In in2[2];
#pragma unroll
                    for (int k = 0; k < 2; ++k) ln2_load(in2[k], r0 + tr * 2 + k, F.lane, fbuf, ybuf);
#pragma unroll
                    for (int k = 0; k < 2; ++k) { const int row = r0 + tr * 2 + k; f32x4 v[4];
                        const float s = ln2_row(v, in2[k], row, F.lane, l1g, l1b, g2, lg, lb, out, l == 0 ? x2b : (bf16_t*)nullptr, xc2);
                        if (modn) { f32x4 shn[4], scn[4]; load_par(shn, modn + (size_t)mi * 6144, F.lane); load_par(scn, modn + (size_t)mi * 6144 + 1024, F.lane); asm volatile("" ::: "memory");
                            adaln_store(v, s, shn, scn, hbuf + (size_t)row * D, F.lane); } }
                }
                        }
#pragma unroll 1
            for (int row = ML + w0; row < nr; row += NGW) {
                f32x4 g2[4]; load_par(g2, modl + (size_t)4 * 6144 + 5120, F.lane);
                Ln2In in1; ln2_load(in1, row, F.lane, fbuf, ybuf); f32x4 v[4];
                const float s = ln2_row(v, in1, row, F.lane, l1g, l1b, g2, lg, lb, out, (bf16_t*)nullptr, xc2);
                if (modn) { f32x4 shn[4], scn[4]; load_par(shn, modn + (size_t)4 * 6144, F.lane); load_par(scn, modn + (size_t)4 * 6144 + 1024, F.lane); adaln_store(v, s, shn, scn, hbuf + (size_t)row * D, F.lane); }
            } }
        SEAM(pb + 9);
        PROBE_END(11);
    }
#ifdef PROBE_MASK
    if (blockIdx.x == 0 && threadIdx.x == 0) { const unsigned long long t1 = __builtin_amdgcn_s_memrealtime(); while (__builtin_amdgcn_s_memrealtime() - t1 < (unsigned long long)PROBE_MULT * probe_acc) __builtin_amdgcn_s_sleep(32); }
#endif
#undef IN
#undef SEAM
}

extern "C" void kernel_launch(void* const* d_in, const int* in_sizes, int n_in, void* d_out, int out_size, void* d_ws, size_t ws_size, hipStream_t stream) {
    static int grid = 0;
    if (grid == 0) {
        int dev = 0, cus = 0;
        if (n_in != 28 || ws_size < WS_END) { fprintf(stderr, "kernel_launch: unexpected n_in %d / ws_size %zu (need %zu)\n", n_in, ws_size, (size_t)WS_END); grid = -1; return; }
        if (hipGetDevice(&dev) != hipSuccess || hipDeviceGetAttribute(&cus, hipDeviceAttributeMultiprocessorCount, dev) != hipSuccess) { grid = -1; return; }
        if (hipFuncSetAttribute((const void*)mk_fwd, hipFuncAttributeMaxDynamicSharedMemorySize, LDS_BYTES) != hipSuccess) { fprintf(stderr, "kernel_launch: hipFuncSetAttribute failed\n"); grid = -1; return; }
        int per_cu = 0;
        if (hipOccupancyMaxActiveBlocksPerMultiprocessor(&per_cu, (const void*)mk_fwd, NTHREADS, LDS_BYTES) != hipSuccess || per_cu < 1) { fprintf(stderr, "kernel_launch: occupancy query says %d\n", per_cu); }
        (void)hipGetLastError();
        grid = cus;
    }
    if (grid < 0) return;
    (void)hipMemsetAsync((char*)d_ws + WS_CTL, 0, CTL_ZERO_BYTES, stream);
    Params p{};
    for (int i = 0; i < 28; ++i) p.in[i] = (const float*)d_in[i];
    p.out = (float*)d_out; p.ws = (unsigned char*)d_ws;
#if MK_SINGLE
    p.ph_lo = 0; p.ph_hi = N_PHASES;
    hipLaunchKernelGGL(mk_fwd, dim3(grid), dim3(NTHREADS), LDS_BYTES, stream, p);
#else
    for (int ph = 0; ph < N_PHASES; ++ph) { p.ph_lo = ph; p.ph_hi = ph + 1; hipLaunchKernelGGL(mk_fwd, dim3(grid), dim3(NTHREADS), LDS_BYTES, stream, p); }
#endif
}
```

```cpp
#include <hip/hip_runtime.h>
#include <hip/hip_bf16.h>
#include <cstdio>
#include <cstdint>

#define GAS __attribute__((address_space(1)))
#define LAS __attribute__((address_space(3)))

namespace cfg {
constexpr int D = 1024, NB = 4, SEQ = 8192, CTXL = 256;
constexpr int ML = NB * SEQ, MC = NB * CTXL, MT = ML + MC;
constexpr int KVSEQ = CTXL + SEQ;
constexpr int INW = 1792;
constexpr float EPS = 1e-6f;
constexpr float ALPHA = 1.41421356237309515f;
constexpr float C2 = 0.125f * 1.4426950408889634f;
constexpr float U_SCALE = 64.f, V_SCALE = 4.f, H_SCALE = 8.f;
constexpr int NWAVES = 8, NTHREADS = 512;
}
using namespace cfg;

typedef unsigned short bf16_t;
typedef float f32x2 __attribute__((ext_vector_type(2)));
typedef float f32x4 __attribute__((ext_vector_type(4)));
typedef unsigned u32x2 __attribute__((ext_vector_type(2)));
typedef unsigned u32x4 __attribute__((ext_vector_type(4)));
typedef short bf16x8 __attribute__((ext_vector_type(8)));

__device__ __forceinline__ int mk_tid() { int t = threadIdx.x; asm volatile("" : "+v"(t)); return t; }
__device__ __forceinline__ unsigned f2bf(float f) { unsigned u = __builtin_bit_cast(unsigned, f); return (u + 0x7fffu + ((u >> 16) & 1u)) >> 16; }
__device__ __forceinline__ unsigned pk2(float lo, float hi) { return f2bf(lo) | (f2bf(hi) << 16); }
__device__ __forceinline__ float bflo(unsigned w) { return __uint_as_float(w << 16); }
__device__ __forceinline__ float bfhi(unsigned w) { return __uint_as_float(w & 0xffff0000u); }
__device__ __forceinline__ float fast_sigmoid(float x) { return __builtin_amdgcn_rcpf(1.0f + __builtin_amdgcn_exp2f(-1.4426950408889634f * x)); }
__device__ __forceinline__ float gelu_tanh(float x) { const float z = x * (1.0f + 0.044715f * x * x); return x * __builtin_amdgcn_rcpf(1.0f + __builtin_amdgcn_exp2f(-2.302208198f * z)); }
template <int CTRL> __device__ __forceinline__ float dpp_f(float v) { return __builtin_bit_cast(float, __builtin_amdgcn_update_dpp(0, __builtin_bit_cast(int, v), CTRL, 0xF, 0xF, true)); }
__device__ __forceinline__ float xchg16(float v, bool odd_row) { const auto rr = __builtin_amdgcn_permlane16_swap(__float_as_uint(v), __float_as_uint(v), false, false); return __uint_as_float(odd_row ? rr[0] : rr[1]); }
__device__ __forceinline__ float xchg32(float v, bool upper) { const auto rr = __builtin_amdgcn_permlane32_swap(__float_as_uint(v), __float_as_uint(v), false, false); return __uint_as_float(upper ? rr[0] : rr[1]); }
__device__ __forceinline__ float wave_sum(float v) {
    v += dpp_f<0xB1>(v);
    v += dpp_f<0x4E>(v);
    v += dpp_f<0x141>(v);
    v += dpp_f<0x140>(v);
    const int lane = (int)__builtin_amdgcn_mbcnt_hi(~0u, __builtin_amdgcn_mbcnt_lo(~0u, 0u));
    v += xchg16(v, lane & 16);
    v += xchg32(v, lane & 32);
    return v;
}
__device__ __forceinline__ float wave_reduce16(float (&v)[16], int lane) {
    const bool b5 = lane & 32, b4 = lane & 16, b3 = lane & 8, b2 = lane & 4;
#pragma unroll
    for (int i = 0; i < 8; ++i) { const float send = b5 ? v[i] : v[i + 8], keep = b5 ? v[i + 8] : v[i]; v[i] = keep + xchg32(send, b5); }
#pragma unroll
    for (int i = 0; i < 4; ++i) { const float send = b4 ? v[i] : v[i + 4], keep = b4 ? v[i + 4] : v[i]; v[i] = keep + xchg16(send, b4); }
#pragma unroll
    for (int i = 0; i < 2; ++i) { const float send = b3 ? v[i] : v[i + 2], keep = b3 ? v[i + 2] : v[i]; v[i] = keep + dpp_f<0x128>(send); }
    { const float send = b2 ? v[0] : v[1], keep = b2 ? v[1] : v[0]; v[0] = keep + dpp_f<0x141>(send); }
    v[0] += dpp_f<0xB1>(v[0]); v[0] += dpp_f<0x4E>(v[0]);
    return v[0];
}
__device__ __forceinline__ const float* rowptr(const float* xl, const float* xc, int row) { return row < ML ? xl + (size_t)row * D : xc + (size_t)(row - ML) * D; }
__device__ __forceinline__ float* rowptr_w(float* xl, float* xc, int row) { return row < ML ? xl + (size_t)row * D : xc + (size_t)(row - ML) * D; }
__device__ __forceinline__ int modid(int row) { return row < ML ? row / SEQ : 4; }
__device__ __forceinline__ int kvrow(int row) { return row < ML ? (row / SEQ) * KVSEQ + CTXL + (row % SEQ) : ((row - ML) / CTXL) * KVSEQ + ((row - ML) % CTXL); }

namespace pg8 {
#define PG8_LAS __attribute__((address_space(3)))
constexpr int BM = 256, BK = 64, HALF = 128, HTB = HALF * BK * 2  , STAGE_BYTES = 8 * HTB, NXCD = 8, WGM = 8;

__host__ __device__ __forceinline__ int lds_byte(int r, int c) { const int st = (r >> 4) * 2 + (c >> 5), rr = r & 15, cc = c & 31, ob = rr * 64 + cc * 2; return st * 1024 + (ob ^ (((ob >> 9) & 1) << 5)); }
__host__ __device__ __forceinline__ void stage_rc(int b, int& R, int& C) { const int st = b / 1024, sb = b % 1024, swz = sb ^ (((sb >> 9) & 1) << 5); R = (st >> 1) * 16 + swz / 64; C = (st & 1) * 32 + (swz % 64) / 2; }
__host__ __device__ __forceinline__ int perm32(int rho) { const int n = rho >> 4, i = rho & 15; return 8 * (i >> 2) + 4 * n + (i & 3); }

struct Unit { int pm, pn; };
struct Gemm { const bf16_t* A; const bf16_t* Bt; int M, N, K; };

struct StaticOrder {
    int nM, nN, nwg, G, c;
    __host__ __device__ void init(int M, int N, int G_, int c_) { nM = M / BM; nN = N / BM; nwg = nM * nN; G = G_; c = c_; }
    __host__ __device__ bool next(int i, Unit& u) const {
        const long L = (long)i * G + c; if (L >= nwg) return false;
        int wgid = (int)L; { const int q = nwg / NXCD, r = nwg % NXCD, xcd = wgid % NXCD, off = wgid / NXCD; wgid = (xcd < r ? xcd * (q + 1) : r * (q + 1) + (xcd - r) * q) + off; }
        const int nig = WGM * nN, gid = wgid / nig, fm = gid * WGM, gsz = (nM - fm) < WGM ? (nM - fm) : WGM;
        u.pm = fm + ((wgid % nig) % gsz); u.pn = (wgid % nig) / gsz; return true;
    }
    __device__ __forceinline__ void a_ready(const Unit&) const {}
    __device__ __forceinline__ void done(const Unit&) const {}
};


struct EpiF32 {
    static constexpr bool PERM = false, AFTER_DRAIN = false;
    float* C; int ldc; const float* bias;
    __device__ __forceinline__ void operator()(const f32x4 (&acc)[2][2][4][2], const Unit& u, int wr, int wc, int fr, int fq) const {
        const int row0 = u.pm * BM + wr * 64 + fr, col0 = u.pn * BM + wc * 32 + 4 * fq;
        f32x4 bv[2][2];
#pragma unroll
        for (int bj = 0; bj < 2; ++bj)
#pragma unroll
            for (int n = 0; n < 2; ++n) bv[bj][n] = bias ? *(const f32x4*)(bias + col0 + bj * HALF + 16 * n) : (f32x4){0.f, 0.f, 0.f, 0.f};
#pragma unroll
        for (int ai = 0; ai < 2; ++ai)
#pragma unroll
            for (int m = 0; m < 4; ++m) { float* rowp = C + (size_t)(row0 + ai * HALF + m * 16) * ldc + col0;
#pragma unroll
                for (int bj = 0; bj < 2; ++bj)
#pragma unroll
                    for (int n = 0; n < 2; ++n) *(f32x4*)(rowp + bj * HALF + 16 * n) = acc[ai][bj][m][n] + bv[bj][n]; }
    }
};

struct EpiBf16 {
    static constexpr bool PERM = true, AFTER_DRAIN = false;
    bf16_t* C; int ldc; const float* bias;
    __device__ __forceinline__ void operator()(const f32x4 (&acc)[2][2][4][2], const Unit& u, int wr, int wc, int fr, int fq) const {
        const int row0 = u.pm * BM + wr * 64 + fr, col0 = u.pn * BM + wc * 32 + 8 * fq;
        f32x4 bv[2][2];
#pragma unroll
        for (int bj = 0; bj < 2; ++bj)
#pragma unroll
            for (int n = 0; n < 2; ++n) bv[bj][n] = bias ? *(const f32x4*)(bias + col0 + bj * HALF + 4 * n) : (f32x4){0.f, 0.f, 0.f, 0.f};
#pragma unroll
        for (int ai = 0; ai < 2; ++ai)
#pragma unroll
            for (int m = 0; m < 4; ++m) { bf16_t* rowp = C + (size_t)(row0 + ai * HALF + m * 16) * ldc + col0;
#pragma unroll
                for (int bj = 0; bj < 2; ++bj) { const f32x4 v0 = acc[ai][bj][m][0] + bv[bj][0], v1 = acc[ai][bj][m][1] + bv[bj][1];
                    u32x4 w; w.x = pk2(v0[0], v0[1]); w.y = pk2(v0[2], v0[3]); w.z = pk2(v1[0], v1[1]); w.w = pk2(v1[2], v1[3]); *(u32x4*)(rowp + bj * HALF) = w; } }
    }
};

struct EpiResid {
    static constexpr bool PERM = true, AFTER_DRAIN = false;
    bf16_t* T; const float* bias; const float* modl; const float* xf; const bf16_t* xb; const float* xc;
    __device__ __forceinline__ void operator()(const f32x4 (&acc)[2][2][4][2], const Unit& u, int wr, int wc, int fr, int fq) const {
        const int row0 = u.pm * BM + wr * 64 + fr, col0 = u.pn * BM + wc * 32 + 8 * fq;
        const bool isctx = u.pm * BM >= ML;
        const float* g1p = modl + (size_t)(isctx ? 4 : (u.pm * BM) / SEQ) * 6144 + 2048;
        f32x4 bv[2][2], gv[2][2];
#pragma unroll
        for (int bj = 0; bj < 2; ++bj)
#pragma unroll
            for (int n = 0; n < 2; ++n) { bv[bj][n] = *(const f32x4*)(bias + col0 + bj * HALF + 4 * n); gv[bj][n] = *(const f32x4*)(g1p + col0 + bj * HALF + 4 * n); }
#pragma unroll
        for (int ai = 0; ai < 2; ++ai)
#pragma unroll
            for (int m = 0; m < 4; ++m) { const int row = row0 + ai * HALF + m * 16;
#pragma unroll
                for (int bj = 0; bj < 2; ++bj) { const int col = col0 + bj * HALF;
                    f32x4 x0, x1;
                    if (isctx) { const float* p = xc + (size_t)(row - ML) * D + col; x0 = *(const f32x4*)p; x1 = *(const f32x4*)(p + 4); }
                    else if (xb) { const u32x4 w = *(const u32x4*)(xb + (size_t)row * D + col); x0 = (f32x4){bflo(w.x), bfhi(w.x), bflo(w.y), bfhi(w.y)}; x1 = (f32x4){bflo(w.z), bfhi(w.z), bflo(w.w), bfhi(w.w)}; }
                    else { const float* p = xf + (size_t)row * D + col; x0 = *(const f32x4*)p; x1 = *(const f32x4*)(p + 4); }
                    const f32x4 v0 = x0 * ALPHA + gv[bj][0] * (acc[ai][bj][m][0] + bv[bj][0]), v1 = x1 * ALPHA + gv[bj][1] * (acc[ai][bj][m][1] + bv[bj][1]);
                    u32x4 w; w.x = pk2(v0[0], v0[1]); w.y = pk2(v0[2], v0[3]); w.z = pk2(v1[0], v1[1]); w.w = pk2(v1[2], v1[3]); *(u32x4*)(T + (size_t)row * D + col) = w; } }
    }
};

typedef _Float16 f16x2_t __attribute__((ext_vector_type(2)));
__device__ __forceinline__ unsigned pkh2(float lo, float hi) { const f16x2_t h = __builtin_convertvector((f32x2){lo, hi}, f16x2_t); return __builtin_bit_cast(unsigned, h); }
struct EpiF16 {
    static constexpr bool PERM = true, AFTER_DRAIN = false;
    unsigned short* C; int ldc;
    __device__ __forceinline__ void operator()(const f32x4 (&acc)[2][2][4][2], const Unit& u, int wr, int wc, int fr, int fq) const {
        const int row0 = u.pm * BM + wr * 64 + fr, col0 = u.pn * BM + wc * 32 + 8 * fq;
#pragma unroll
        for (int ai = 0; ai < 2; ++ai)
#pragma unroll
            for (int m = 0; m < 4; ++m) { unsigned short* rowp = C + (size_t)(row0 + ai * HALF + m * 16) * ldc + col0;
#pragma unroll
                for (int bj = 0; bj < 2; ++bj) { const f32x4 v0 = acc[ai][bj][m][0], v1 = acc[ai][bj][m][1];
                    u32x4 w; w.x = pkh2(v0[0], v0[1]); w.y = pkh2(v0[2], v0[3]); w.z = pkh2(v1[0], v1[1]); w.w = pkh2(v1[2], v1[3]); *(u32x4*)(rowp + bj * HALF) = w; } }
    }
};

struct EpiInProj {
    static constexpr bool PERM = false, AFTER_DRAIN = false;
    bf16_t* q; bf16_t* kv; bf16_t* zg; bf16_t* yc; const float* qg; const float* kg; const float* rope;
    __device__ __forceinline__ void operator()(const f32x4 (&acc)[2][2][4][2], const Unit& u, int wr, int wc, int fr, int fq) const {
        const int pn = u.pn, rowb = u.pm * BM + wr * 64 + fr;
        if (pn <= 2) {
            const bool isq = pn < 2, isv = (pn == 2 && wc >= 2), lat = (u.pm * BM) < ML;
            f32x4 gn[2][2];
#pragma unroll
            for (int bj = 0; bj < 2; ++bj)
#pragma unroll
                for (int n = 0; n < 2; ++n) gn[bj][n] = *(const f32x4*)((isq ? qg : kg) + 32 * bj + 16 * n + 4 * fq);
#pragma unroll
            for (int ai = 0; ai < 2; ++ai)
#pragma unroll
                for (int m = 0; m < 4; ++m) {
                    const int row = rowb + ai * HALF + m * 16;
                    f32x4 v[2][2];
#pragma unroll
                    for (int bj = 0; bj < 2; ++bj)
#pragma unroll
                        for (int n = 0; n < 2; ++n) v[bj][n] = acc[ai][bj][m][n];
                    if (!isv) {
                        float ss = 0.f;
#pragma unroll
                        for (int bj = 0; bj < 2; ++bj)
#pragma unroll
                            for (int n = 0; n < 2; ++n) ss += (v[bj][n][0] * v[bj][n][0] + v[bj][n][1] * v[bj][n][1]) + (v[bj][n][2] * v[bj][n][2] + v[bj][n][3] * v[bj][n][3]);
                        ss += xchg16(ss, fq & 1); ss += xchg32(ss, fq & 2);
                        const float rs = __builtin_amdgcn_rsqf(ss * (1.0f / 64.0f) + EPS);
#pragma unroll
                        for (int bj = 0; bj < 2; ++bj)
#pragma unroll
                            for (int n = 0; n < 2; ++n) v[bj][n] = v[bj][n] * rs * gn[bj][n];
                        if (lat) {
                            const int t = row & (SEQ - 1);
#pragma unroll
                            for (int bj = 0; bj < 2; ++bj) {
                                const int pos = bj ? (t & 63) : (t >> 6);
                                const float* rp = rope + (pos * 16 + 4 * fq) * 2;
                                const f32x4 cs01 = *(const f32x4*)rp, cs23 = *(const f32x4*)(rp + 4);
                                const float cs[4] = {cs01[0], cs01[2], cs23[0], cs23[2]}, sn[4] = {cs01[1], cs01[3], cs23[1], cs23[3]};
#pragma unroll
                                for (int e = 0; e < 4; ++e) { const float x1 = v[bj][0][e], x2 = v[bj][1][e]; v[bj][0][e] = x1 * cs[e] - x2 * sn[e]; v[bj][1][e] = x1 * sn[e] + x2 * cs[e]; }
                            }
                        }
                        if (isq) {
#pragma unroll
                            for (int bj = 0; bj < 2; ++bj)
#pragma unroll
                                for (int n = 0; n < 2; ++n) v[bj][n] = v[bj][n] * C2;
                        }
                    }
                    bf16_t* dst = isq ? q + (size_t)row * 512 + (pn * 4 + wc) * 64 : kv + (size_t)kvrow(row) * 256 + (wc >= 2 ? 128 + (wc - 2) * 64 : wc * 64);
#pragma unroll
                    for (int bj = 0; bj < 2; ++bj)
#pragma unroll
                        for (int n = 0; n < 2; ++n) { u32x2 w; w.x = pk2(v[bj][n][0], v[bj][n][1]); w.y = pk2(v[bj][n][2], v[bj][n][3]); *(u32x2*)(dst + 32 * bj + 16 * n + 4 * fq) = w; }
                }
        } else if (pn <= 4) {
#pragma unroll
            for (int ai = 0; ai < 2; ++ai)
#pragma unroll
                for (int m = 0; m < 4; ++m) { bf16_t* dst = zg + (size_t)(rowb + ai * HALF + m * 16) * 512 + (pn - 3) * 256 + wc * 32 + 4 * fq;
#pragma unroll
                    for (int bj = 0; bj < 2; ++bj)
#pragma unroll
                        for (int n = 0; n < 2; ++n) { const f32x4 a = acc[ai][bj][m][n]; u32x2 w; w.x = pk2(gelu_tanh(a[0]), gelu_tanh(a[1])); w.y = pk2(gelu_tanh(a[2]), gelu_tanh(a[3]));
                            *(u32x2*)(dst + bj * HALF + 16 * n) = w; } }
        } else {
#pragma unroll
            for (int ai = 0; ai < 2; ++ai)
#pragma unroll
                for (int m = 0; m < 4; ++m) { bf16_t* dst = yc + (size_t)(rowb + ai * HALF + m * 16) * 256 + (pn - 5) * 128 + wc * 32 + 4 * fq;
#pragma unroll
                    for (int n = 0; n < 2; ++n) { const f32x4 a = acc[ai][0][m][n], g = acc[ai][1][m][n]; u32x2 w;
                        w.x = pk2(a[0] * fast_sigmoid(g[0]), a[1] * fast_sigmoid(g[1])); w.y = pk2(a[2] * fast_sigmoid(g[2]), a[3] * fast_sigmoid(g[3]));
                        *(u32x2*)(dst + 16 * n) = w; } }
        }
    }
};
template <class Epi, class Sched, bool ALIGN_EPI = false, bool SP2 = false>
__device__ __forceinline__ void gemm_phase(PG8_LAS unsigned char* lds, const Gemm g, const Sched& S, const Epi& E) {
    const int tid = mk_tid(), wid = __builtin_amdgcn_readfirstlane(tid >> 6), lane = tid & 63, wr = wid >> 2, wc = wid & 3, fr = lane & 15, fq = lane >> 4;
    const int K = g.K, nt = K / BK;
    unsigned voffA[2], voffB[2];
#pragma unroll
    for (int i = 0; i < 2; ++i) { int R, C; stage_rc(tid * 16 + i * 8192, R, C); const int Rb = Epi::PERM ? ((R & ~31) + perm32(R & 31)) : R;
        voffA[i] = (unsigned)(R * K + C) * 2u; voffB[i] = (unsigned)(Rb * K + C) * 2u; }
    const size_t kstep = (size_t)(BK * 2);
    const size_t hstep = (size_t)HALF * K * 2;
    const size_t tstep = 2 * hstep;
    const unsigned ldsw = (unsigned)wid * 1024u;
    const int aoff = lds_byte(wr * 64 + fr, fq * 8), boff = lds_byte(wc * 32 + fr, fq * 8);
#define PG8_SA(b, h) (((b) * 2 + (h)) * HTB)
#define PG8_SB(b, h) ((4 + (b) * 2 + (h)) * HTB)
#define PG8_STAGE(bufoff, gbase, voff) do { _Pragma("unroll") for (int _i = 0; _i < 2; ++_i) \
        __builtin_amdgcn_global_load_lds((const unsigned*)((const char*)(gbase) + (voff)[_i]), (PG8_LAS unsigned*)(lds + (bufoff) + ldsw + _i * 8192), 16, 0, 0); } while (0)
#define PG8_LDA(dst, b, h) do { _Pragma("unroll") for (int m = 0; m < 4; ++m) _Pragma("unroll") for (int k = 0; k < 2; ++k) dst[m][k] = *(const PG8_LAS bf16x8*)(lds + PG8_SA(b, h) + aoff + m * 2048 + k * 1024); } while (0)
#define PG8_LDB(dst, b, h) do { _Pragma("unroll") for (int n = 0; n < 2; ++n) _Pragma("unroll") for (int k = 0; k < 2; ++k) dst[n][k] = *(const PG8_LAS bf16x8*)(lds + PG8_SB(b, h) + boff + n * 2048 + k * 1024); } while (0)
#define PG8_MMA(ai, bj, At, Bt) do { __builtin_amdgcn_s_setprio(1); _Pragma("unroll") for (int m = 0; m < 4; ++m) _Pragma("unroll") for (int n = 0; n < 2; ++n) _Pragma("unroll") for (int k = 0; k < 2; ++k) \
        acc[ai][bj][m][n] = __builtin_amdgcn_mfma_f32_16x16x32_bf16(Bt[n][k], At[m][k], acc[ai][bj][m][n], 0, 0, 0); __builtin_amdgcn_s_setprio(0); } while (0)
#define PG8_WAIT_V(n) asm volatile("s_waitcnt vmcnt(" #n ")" ::: "memory")
#define PG8_WAIT_L(n) asm volatile("s_waitcnt lgkmcnt(" #n ")" ::: "memory")
#define PG8_BAR __builtin_amdgcn_s_barrier()
#define PG8_SCHED __builtin_amdgcn_sched_barrier(0)
    Unit cur, nxt; int ui = 0;
    if (!S.next(0, cur)) return;
    f32x4 acc[2][2][4][2];
#pragma unroll
    for (int a = 0; a < 2; ++a)
#pragma unroll
        for (int b = 0; b < 2; ++b)
#pragma unroll
            for (int m = 0; m < 4; ++m)
#pragma unroll
                for (int n = 0; n < 2; ++n) acc[a][b][m][n] = (f32x4){0.f, 0.f, 0.f, 0.f};
    bf16x8 At[4][2], B0[2][2], B1[2][2];
    const char* cA = (const char*)g.A + (size_t)cur.pm * tstep; const char* cB = (const char*)g.Bt + (size_t)cur.pn * tstep;
    S.a_ready(cur);
    if constexpr (SP2) {
        PG8_STAGE(PG8_SB(0, 0), cB, voffB); PG8_STAGE(PG8_SB(0, 1), cB + hstep, voffB); PG8_STAGE(PG8_SA(0, 0), cA, voffA); PG8_STAGE(PG8_SA(0, 1), cA + hstep, voffA);
        if (wr == 1) PG8_BAR;
        PG8_WAIT_V(2); PG8_BAR;
        PG8_STAGE(PG8_SB(1, 0), cB + kstep, voffB); PG8_STAGE(PG8_SA(1, 0), cA + kstep, voffA); PG8_STAGE(PG8_SB(1, 1), cB + hstep + kstep, voffB);
        PG8_WAIT_V(6); PG8_BAR;
    } else {
        PG8_STAGE(PG8_SB(0, 0), cB, voffB); PG8_STAGE(PG8_SA(0, 0), cA, voffA); PG8_STAGE(PG8_SB(0, 1), cB + hstep, voffB); PG8_STAGE(PG8_SA(0, 1), cA + hstep, voffA);
        if (wr == 1) PG8_BAR;
        PG8_WAIT_V(4); PG8_BAR;
        PG8_STAGE(PG8_SB(1, 0), cB + kstep, voffB); PG8_STAGE(PG8_SA(1, 0), cA + kstep, voffA); PG8_STAGE(PG8_SB(1, 1), cB + hstep + kstep, voffB);
        PG8_WAIT_V(6); PG8_BAR;
    }
    for (;;) {
        const bool has_next = S.next(ui + 1, nxt);
        const char* nA = has_next ? (const char*)g.A + (size_t)nxt.pm * tstep : cA; const char* nB = has_next ? (const char*)g.Bt + (size_t)nxt.pn * tstep : cB;
        for (int t = 0; t < nt; t += 2) {
            const bool last = (t == nt - 2);
            const char* a1 = cA + (size_t)(t + 1) * kstep;
            const char* a2 = last ? nA : cA + (size_t)(t + 2) * kstep; const char* b2 = last ? nB : cB + (size_t)(t + 2) * kstep;
            const char* a3 = a2 + kstep; const char* b3 = b2 + kstep;
            if (last && has_next) S.a_ready(nxt);
            if constexpr (SP2) {
            PG8_LDB(B0, 0, 0); PG8_LDB(B1, 0, 1); PG8_SCHED; PG8_LDA(At, 0, 0); PG8_STAGE(PG8_SA(1, 1), a1 + hstep, voffA);
            PG8_WAIT_V(8); PG8_WAIT_L(0); PG8_BAR; PG8_MMA(0, 0, At, B0); PG8_MMA(0, 1, At, B1); PG8_BAR; PG8_SCHED;
            PG8_LDA(At, 0, 1); PG8_STAGE(PG8_SB(0, 0), b2, voffB); PG8_STAGE(PG8_SB(0, 1), b2 + hstep, voffB); PG8_STAGE(PG8_SA(0, 0), a2, voffA);
            PG8_WAIT_V(8); PG8_WAIT_L(0); PG8_BAR; PG8_MMA(1, 0, At, B0); PG8_MMA(1, 1, At, B1); PG8_BAR; PG8_SCHED;
            PG8_LDB(B0, 1, 0); PG8_LDB(B1, 1, 1); PG8_SCHED; PG8_LDA(At, 1, 0); PG8_STAGE(PG8_SA(0, 1), a2 + hstep, voffA);
            PG8_WAIT_V(8); PG8_WAIT_L(0); PG8_BAR; PG8_MMA(0, 0, At, B0); PG8_MMA(0, 1, At, B1); PG8_BAR; PG8_SCHED;
            PG8_LDA(At, 1, 1); PG8_STAGE(PG8_SB(1, 0), b3, voffB); PG8_STAGE(PG8_SB(1, 1), b3 + hstep, voffB); PG8_STAGE(PG8_SA(1, 0), a3, voffA);
            PG8_WAIT_V(8); PG8_WAIT_L(0); PG8_BAR; PG8_MMA(1, 0, At, B0); PG8_MMA(1, 1, At, B1); PG8_BAR; PG8_SCHED;
            } else {
            PG8_LDB(B0, 0, 0); PG8_SCHED; PG8_LDA(At, 0, 0); PG8_STAGE(PG8_SA(1, 1), a1 + hstep, voffA);
            PG8_WAIT_L(8); PG8_BAR; PG8_WAIT_L(0); PG8_MMA(0, 0, At, B0); PG8_BAR; PG8_SCHED;
            PG8_LDB(B1, 0, 1); PG8_STAGE(PG8_SB(0, 0), b2, voffB);
            PG8_BAR; PG8_WAIT_L(0); PG8_MMA(0, 1, At, B1); PG8_BAR;
            PG8_LDA(At, 0, 1); PG8_STAGE(PG8_SA(0, 0), a2, voffA);
            PG8_BAR; PG8_WAIT_L(0); PG8_MMA(1, 0, At, B0); PG8_BAR; PG8_SCHED;
            PG8_STAGE(PG8_SB(0, 1), b2 + hstep, voffB);
            PG8_WAIT_V(6); PG8_BAR; PG8_MMA(1, 1, At, B1); PG8_BAR;
            PG8_LDB(B0, 1, 0); PG8_SCHED; PG8_LDA(At, 1, 0); PG8_STAGE(PG8_SA(0, 1), a2 + hstep, voffA);
            PG8_WAIT_L(8); PG8_BAR; PG8_WAIT_L(0); PG8_MMA(0, 0, At, B0); PG8_BAR; PG8_SCHED;
            PG8_LDB(B1, 1, 1); PG8_STAGE(PG8_SB(1, 0), b3, voffB);
            PG8_BAR; PG8_WAIT_L(0); PG8_MMA(0, 1, At, B1); PG8_BAR;
            PG8_LDA(At, 1, 1); PG8_STAGE(PG8_SA(1, 0), a3, voffA);
            PG8_BAR; PG8_WAIT_L(0); PG8_MMA(1, 0, At, B0); PG8_BAR; PG8_SCHED;
            PG8_STAGE(PG8_SB(1, 1), b3 + hstep, voffB);
            PG8_WAIT_V(6); PG8_BAR; PG8_MMA(1, 1, At, B1); PG8_BAR;
            }
        }
        if constexpr (ALIGN_EPI) { if (wr == 0) PG8_BAR; }
        if constexpr (!Epi::AFTER_DRAIN) { E(acc, cur, wr, wc, fr, fq); S.done(cur); }
        if (!has_next) break;
#pragma unroll
        for (int a = 0; a < 2; ++a)
#pragma unroll
            for (int b = 0; b < 2; ++b)
#pragma unroll
                for (int m = 0; m < 4; ++m)
#pragma unroll
                    for (int n = 0; n < 2; ++n) acc[a][b][m][n] = (f32x4){0.f, 0.f, 0.f, 0.f};
        cur = nxt; cA = nA; cB = nB; ++ui;
        if constexpr (ALIGN_EPI) { if (wr == 1) PG8_BAR; }
    }
    PG8_WAIT_V(0);
    if constexpr (!ALIGN_EPI) { if (wr == 0) PG8_BAR; }
    PG8_BAR;
    if constexpr (Epi::AFTER_DRAIN) { E.fused(acc, cur, wr, wc, fr, fq, lds, wid, lane); S.done(cur); }
#undef PG8_SA
#undef PG8_SB
#undef PG8_STAGE
#undef PG8_LDA
#undef PG8_LDB
#undef PG8_MMA
#undef PG8_WAIT_V
#undef PG8_WAIT_L
#undef PG8_BAR
#undef PG8_SCHED
}
}
namespace attn_body {
using bf16=__hip_bfloat16;
using bf16x8=__attribute__((ext_vector_type(8)))short;
using s16x4=__attribute__((ext_vector_type(4)))short;
using f32x16=__attribute__((ext_vector_type(16)))float;
using u32x4=__attribute__((ext_vector_type(4)))unsigned;
constexpr int D=64;
constexpr int DMQ=512, DMKV=256, DMO=1024;
constexpr int NW=8,QBLK=32,QB=QBLK*NW,KVBLK=64;
constexpr int ATTN_UNIT_ROWS=QB;
__device__ __forceinline__ int crow(int r,int hi){return (r&3)+8*(r>>2)+4*hi;}
#define SBAR() __builtin_amdgcn_sched_barrier(0)
constexpr int NSLOT=3, SLOTB=8192;
constexpr int LDS_K=0, LDS_V=NSLOT*SLOTB, LDS_WS=2*NSLOT*SLOTB, LDS_OST=LDS_WS+NW*64*4, LDS_BYTES=LDS_OST+NW*4096;
__device__ __forceinline__ void glds16(const void*gsrc,unsigned lds_dst){unsigned keep;
  asm volatile("s_mov_b32 %0, m0\n\ts_mov_b32 m0, %2\n\ts_nop 0\n\tglobal_load_lds_dwordx4 %1, off\n\ts_mov_b32 m0, %0":"=&s"(keep):"v"(gsrc),"s"(lds_dst):"memory");}
__device__ __forceinline__ float max3f(float a,float b,float c){float r;asm("v_max3_f32 %0, %1, %2, %3":"=v"(r):"v"(a),"v"(b),"v"(c));return r;}
__device__ __forceinline__ float max2f(float a,float b){float r;asm("v_max_f32_e32 %0, %1, %2":"=v"(r):"v"(a),"v"(b));return r;}
__device__ __forceinline__ float fadd_s(float a,float b){float r;asm("v_add_f32_e32 %0, %1, %2":"=v"(r):"v"(a),"v"(b));return r;}
__device__ __forceinline__ float fsub_s(float a,float b){float r;asm("v_sub_f32_e32 %0, %1, %2":"=v"(r):"v"(a),"v"(b));return r;}
typedef float f32x2_t __attribute__((ext_vector_type(2))); typedef __bf16 bf16x2_t __attribute__((ext_vector_type(2)));
__device__ __forceinline__ unsigned cvtpk_s(float lo,float hi){f32x2_t v={lo,hi};bf16x2_t b=__builtin_convertvector(v,bf16x2_t);return __builtin_bit_cast(unsigned,b);}
#define WAIT_BAR(N) asm volatile("s_waitcnt vmcnt(" #N ") lgkmcnt(0)\n\ts_barrier":::"memory")

__device__ __forceinline__ void qkt(f32x16&p0,f32x16&p1,const char*Kslot,const bf16x8*qr,const f32x16&negm,int r32,int hi){
  const char*kb=Kslot+hi*1024+r32*16;
  #pragma unroll
  for(int d0=0;d0<4;++d0){
    const bf16x8 b0=*reinterpret_cast<const bf16x8*>(kb+d0*2048);
    const bf16x8 b1=*reinterpret_cast<const bf16x8*>(kb+d0*2048+512);
    if(d0==0){p0=__builtin_amdgcn_mfma_f32_32x32x16_bf16(b0,qr[0],negm,0,0,0);p1=__builtin_amdgcn_mfma_f32_32x32x16_bf16(b1,qr[0],negm,0,0,0);}
    else{p0=__builtin_amdgcn_mfma_f32_32x32x16_bf16(b0,qr[d0],p0,0,0,0);p1=__builtin_amdgcn_mfma_f32_32x32x16_bf16(b1,qr[d0],p1,0,0,0);}}
}
typedef __attribute__((address_space(3))) const char* lds_cptr;
typedef short v4i16_t __attribute__((ext_vector_type(4)));
__device__ __forceinline__ void kload8(bf16x8*kf,lds_cptr kp){
  kf[0]=*(const __attribute__((address_space(3))) bf16x8*)(kp);      kf[1]=*(const __attribute__((address_space(3))) bf16x8*)(kp+512);
  kf[2]=*(const __attribute__((address_space(3))) bf16x8*)(kp+2048); kf[3]=*(const __attribute__((address_space(3))) bf16x8*)(kp+2560);
  kf[4]=*(const __attribute__((address_space(3))) bf16x8*)(kp+4096); kf[5]=*(const __attribute__((address_space(3))) bf16x8*)(kp+4608);
  kf[6]=*(const __attribute__((address_space(3))) bf16x8*)(kp+6144); kf[7]=*(const __attribute__((address_space(3))) bf16x8*)(kp+6656);
}
__device__ __forceinline__ void kload2(bf16x8*kf,lds_cptr kp,int j){ kf[2*j]=*(const __attribute__((address_space(3))) bf16x8*)(kp+j*2048); kf[2*j+1]=*(const __attribute__((address_space(3))) bf16x8*)(kp+j*2048+512); }
__device__ __forceinline__ s16x4 vtr(lds_cptr p){ return __builtin_bit_cast(s16x4,__builtin_amdgcn_ds_read_tr16_b64_v4i16((__attribute__((address_space(3))) v4i16_t*)p)); }
__device__ __forceinline__ float rowmax(const f32x16&p0,const f32x16&p1){
  float a=max3f(p0[0],p0[1],p1[0]),b=max3f(p0[2],p0[3],p1[1]);a=max3f(a,p1[2],p1[3]);
  #pragma unroll
  for(int r=4;r<16;r+=4){a=max3f(a,p0[r],p0[r+1]);b=max3f(b,p0[r+2],p0[r+3]);a=max3f(a,p1[r],p1[r+1]);b=max3f(b,p1[r+2],p1[r+3]);}
  const float m=max2f(a,b);
  auto rr=__builtin_amdgcn_permlane32_swap(__float_as_uint(m),__float_as_uint(m),false,false);
  return max2f(__uint_as_float(rr[0]),__uint_as_float(rr[1]));
}
__device__ __forceinline__ void pv(f32x16*o,int vb,bf16x8 pa0,bf16x8 pa1,bf16x8 pa2,bf16x8 pa3){
  #pragma unroll
  for(int d0=0;d0<2;++d0){s16x4 lo[4],hi[4];
    #pragma unroll
    for(int ks=0;ks<4;++ks){
      asm volatile("ds_read_b64_tr_b16 %0,%1 offset:%c2":"=&v"(lo[ks]):"v"(vb),"i"(d0*4096+ks*1024):"memory");
      asm volatile("ds_read_b64_tr_b16 %0,%1 offset:%c2":"=&v"(hi[ks]):"v"(vb),"i"(d0*4096+ks*1024+512):"memory");}
    asm volatile("s_waitcnt lgkmcnt(0)":::"memory");SBAR();
    #define PK(k) (bf16x8){lo[k][0],lo[k][1],lo[k][2],lo[k][3],hi[k][0],hi[k][1],hi[k][2],hi[k][3]}
    o[d0]=__builtin_amdgcn_mfma_f32_32x32x16_bf16(pa0,PK(0),o[d0],0,0,0);
    o[d0]=__builtin_amdgcn_mfma_f32_32x32x16_bf16(pa1,PK(1),o[d0],0,0,0);
    o[d0]=__builtin_amdgcn_mfma_f32_32x32x16_bf16(pa2,PK(2),o[d0],0,0,0);
    o[d0]=__builtin_amdgcn_mfma_f32_32x32x16_bf16(pa3,PK(3),o[d0],0,0,0);
    #undef PK
  }
}

#ifndef ATTN_STORE16
#define ATTN_STORE16(p,v) (*(u32x4*)(p)=(v))
#endif
template<int THRL> __device__ __forceinline__ void attn_unit(const bf16*Q0,const bf16*__restrict__ K0,const bf16*__restrict__ V0,bf16*O0,const int NT,char*shm){
  const int tid=mk_tid(),lane=tid&63,r32=lane&31,hi=lane>>5; const int wid=__builtin_amdgcn_readfirstlane(tid>>6);
  const bf16*Qw=Q0+(long)(wid*QBLK)*DMQ;
  const bf16*Kh=K0,*Vh=V0;
  const unsigned lds0=(unsigned)(uintptr_t)shm;
  float*wsf=(float*)(shm+LDS_WS)+wid*64;
  const bf16*ksrc=Kh+(long)lane*DMKV+wid*8;
  const bf16*vsrc=Vh+(long)(16*(wid&3)+(lane>>2))*DMKV+(wid>>2)*32+(lane&3)*8;
  const unsigned kdst=lds0+LDS_K+wid*1024, vdst=lds0+LDS_V+wid*1024;
  #define DMA_K(t,slot) glds16(ksrc+(long)(t)*KVBLK*DMKV,(unsigned)__builtin_amdgcn_readfirstlane(kdst+(slot)))
  #define DMA_V(t,slot) glds16(vsrc+(long)(t)*KVBLK*DMKV,(unsigned)__builtin_amdgcn_readfirstlane(vdst+(slot)))
  const int vb0=(int)(lds0+LDS_V)+((lane>>4)&1)*32+(lane&3)*8+(4*hi+((lane&15)>>2))*64;
  const char*Kbase=shm+LDS_K; bf16x8 kf[8];
  const lds_cptr shm3=(lds_cptr)shm; const lds_cptr kp0=shm3+LDS_K+hi*1024+r32*16; const lds_cptr vp0=shm3+LDS_V+((lane>>4)&1)*32+(lane&3)*8+(4*hi+((lane&15)>>2))*64;
  DMA_K(0,0);DMA_V(0,0);DMA_K(1,SLOTB);
  bf16x8 qr[4];
  #pragma unroll
  for(int d0=0;d0<4;++d0)qr[d0]=*reinterpret_cast<const bf16x8*>(&Qw[(long)r32*DMQ+d0*16+hi*8]);
  float mhat=0.f,l_reg=0.f;f32x16 o[2];o[0]=f32x16{};o[1]=f32x16{};f32x16 negm=f32x16{};asm volatile("":"+v"(negm));
  #define CMASK(P0,P1,t) do{}while(0)
  bool resc=false;
  #define START(P0,P1) do{ const float rm=rowmax(P0,P1); resc=false; \
    { const float dl=rm; mhat=fadd_s(mhat,dl); \
      _Pragma("unroll") for(int r=0;r<16;++r){P0[r]=fsub_s(P0[r],dl);P1[r]=fsub_s(P1[r],dl);} \
      _Pragma("unroll") for(int r=0;r<16;++r)negm[r]=-mhat; asm volatile("":"+v"(negm)); } \
    _Pragma("unroll") for(int r=0;r<16;++r)P0[r]=__builtin_amdgcn_exp2f(P0[r]); }while(0)
  #define RESC() do{ if(resc){ asm volatile("s_waitcnt lgkmcnt(0)":::"memory"); \
      _Pragma("unroll") for(int d_=0;d_<2;++d_) _Pragma("unroll") for(int r=0;r<16;++r)o[d_][r]*=wsf[crow(r,hi)]; } }while(0)
  f32x16 pA0,pA1,pB0,pB1;
  int sl_prev=0,sl_cur=0,sl_next=SLOTB;
  #define ROT() do{sl_prev=sl_cur;sl_cur=sl_next;sl_next=(sl_next==(NSLOT-1)*SLOTB)?0:sl_next+SLOTB;}while(0)
  DMA_K(2,2*SLOTB);
  WAIT_BAR(3);
  qkt(pA0,pA1,Kbase,qr,negm,r32,hi);asm volatile("s_nop 15\n\ts_nop 7":"+v"(pA0),"+v"(pA1));CMASK(pA0,pA1,0);
  START(pA0,pA1);
  _Pragma("unroll") for(int r=0;r<16;++r)pA1[r]=__builtin_amdgcn_exp2f(pA1[r]);
  WAIT_BAR(0);
  DMA_K(3,0);DMA_V(1,SLOTB);
  ROT();
  kload8(kf,kp0+sl_cur);
  WAIT_BAR(2);
  s16x4 vlo[8],vhi[8]; u32x4 pw0,pw1,pw2,pw3;
  #define PKW(P,B) cvtpk_s(P[B],P[B+1])
  #define PAF(k) __builtin_bit_cast(bf16x8,pw##k)
  #define VFR(i) (bf16x8){vlo[i][0],vlo[i][1],vlo[i][2],vlo[i][3],vhi[i][0],vhi[i][1],vhi[i][2],vhi[i][3]}
  #define PIN(x) asm volatile("":"+v"(x))
  #define MX3(a,b,c) __builtin_fmaxf(__builtin_fmaxf((a),(b)),(c))
  #define GAPA(MF,A0,A1,A2,A3,W0,W1,PW) do{ MF; sacc+=A0; sacc+=A1; sacc+=A2; sacc+=A3; PIN(sacc); W0; W1; PIN(PW); SBAR(); }while(0)
  #define EX(v) __builtin_amdgcn_exp2f(v)
  #define GAPB(MF,X,B) do{ MF; X[B]=EX(X[B]); X[B+1]=EX(X[B+1]); X[B+2]=EX(X[B+2]); X[B+3]=EX(X[B+3]); PIN(X); SBAR(); }while(0)
  #define VRD(i) do{ vlo[i]=vtr(vp_+(((i)>>2)*4096+((i)&3)*1024)); vhi[i]=vtr(vp_+(((i)>>2)*4096+((i)&3)*1024+512)); }while(0)
  #define KRD(G,j) do{ if(G){ kload2(kf,kp0+sl_next,j); SBAR(); } }while(0)
  #define STEP(C0,C1,P0,P1,t,GK,GV,GL) do{ SBAR(); \
    const lds_cptr vp_=vp0+sl_prev; \
    VRD(0); SBAR(); float sacc=(P0[0]+P0[1]); \
    GAPA(C0=__builtin_amdgcn_mfma_f32_32x32x16_bf16(kf[0],qr[0],negm,0,0,0), P0[2],P0[3],P0[4],P0[5],     pw0[0]=PKW(P0,0), pw0[1]=PKW(P0,2), pw0); \
    VRD(4); SBAR(); GAPA(C1=__builtin_amdgcn_mfma_f32_32x32x16_bf16(kf[1],qr[0],negm,0,0,0), P0[6],P0[7],P0[8],P0[9],     pw0[2]=PKW(P0,4), pw0[3]=PKW(P0,6), pw0); \
    VRD(1); SBAR(); GAPA(C0=__builtin_amdgcn_mfma_f32_32x32x16_bf16(kf[2],qr[1],C0,0,0,0),   P0[10],P0[11],P0[12],P0[13], pw1[0]=PKW(P0,8), pw1[1]=PKW(P0,10), pw1); \
    VRD(5); SBAR(); GAPA(C1=__builtin_amdgcn_mfma_f32_32x32x16_bf16(kf[3],qr[1],C1,0,0,0),   P0[14],P0[15],P1[0],P1[1],   pw1[2]=PKW(P0,12),pw1[3]=PKW(P0,14), pw1); \
    VRD(2); SBAR(); GAPA(C0=__builtin_amdgcn_mfma_f32_32x32x16_bf16(kf[4],qr[2],C0,0,0,0),   P1[2],P1[3],P1[4],P1[5],     pw2[0]=PKW(P1,0), pw2[1]=PKW(P1,2), pw2); \
    VRD(6); SBAR(); GAPA(C1=__builtin_amdgcn_mfma_f32_32x32x16_bf16(kf[5],qr[2],C1,0,0,0),   P1[6],P1[7],P1[8],P1[9],     pw2[2]=PKW(P1,4), pw2[3]=PKW(P1,6), pw2); \
    VRD(3); SBAR(); GAPA(C0=__builtin_amdgcn_mfma_f32_32x32x16_bf16(kf[6],qr[3],C0,0,0,0),   P1[10],P1[11],P1[12],P1[13], pw3[0]=PKW(P1,8), pw3[1]=PKW(P1,10), pw3); \
    VRD(7); SBAR(); GAPA(C1=__builtin_amdgcn_mfma_f32_32x32x16_bf16(kf[7],qr[3],C1,0,0,0),   P1[14],P1[15],0.f,0.f,       pw3[2]=PKW(P1,12),pw3[3]=PKW(P1,14), pw3); \
    l_reg+=sacc; \
    if(GK){DMA_K((t)+3,sl_cur);} if(GV){DMA_V((t)+1,sl_next);} \
    CMASK(C0,C1,t); \
    { float a=MX3(C0[0],C0[1],C1[0]),b=MX3(C0[2],C0[3],C1[1]); a=MX3(a,C1[2],C1[3]); \
      _Pragma("unroll") for(int r=4;r<16;r+=4){a=MX3(a,C0[r],C0[r+1]);b=MX3(b,C0[r+2],C0[r+3]);a=MX3(a,C1[r],C1[r+1]);b=MX3(b,C1[r+2],C1[r+3]);} \
      float rm=__builtin_fmaxf(a,b); { auto rr=__builtin_amdgcn_permlane32_swap(__float_as_uint(rm),__float_as_uint(rm),false,false); rm=__builtin_fmaxf(__uint_as_float(rr[0]),__uint_as_float(rr[1])); } \
      resc=false; \
      if(__builtin_expect(__any(rm>(float)THRL),0)){ const float dl=__builtin_fmaxf(rm,0.f); mhat+=dl; \
        _Pragma("unroll") for(int r=0;r<16;++r){C0[r]-=dl;C1[r]-=dl;} \
        _Pragma("unroll") for(int r=0;r<16;++r)negm[r]=-mhat; asm volatile("":"+v"(negm)); \
        const float f=__builtin_amdgcn_exp2f(-dl); l_reg*=f; if(hi==0)wsf[r32]=f; resc=true; } } \
    SBAR(); \
    GAPB(o[0]=__builtin_amdgcn_mfma_f32_32x32x16_bf16(PAF(0),VFR(0),o[0],0,0,0), C0,0); \
    GAPB(o[1]=__builtin_amdgcn_mfma_f32_32x32x16_bf16(PAF(0),VFR(4),o[1],0,0,0), C0,4); \
    KRD(GL,0); GAPB(o[0]=__builtin_amdgcn_mfma_f32_32x32x16_bf16(PAF(1),VFR(1),o[0],0,0,0), C0,8); \
    KRD(GL,1); GAPB(o[1]=__builtin_amdgcn_mfma_f32_32x32x16_bf16(PAF(1),VFR(5),o[1],0,0,0), C0,12); \
    KRD(GL,2); GAPB(o[0]=__builtin_amdgcn_mfma_f32_32x32x16_bf16(PAF(2),VFR(2),o[0],0,0,0), C1,0); \
    KRD(GL,3); GAPB(o[1]=__builtin_amdgcn_mfma_f32_32x32x16_bf16(PAF(2),VFR(6),o[1],0,0,0), C1,4); \
    GAPB(o[0]=__builtin_amdgcn_mfma_f32_32x32x16_bf16(PAF(3),VFR(3),o[0],0,0,0), C1,8); \
    GAPB(o[1]=__builtin_amdgcn_mfma_f32_32x32x16_bf16(PAF(3),VFR(7),o[1],0,0,0), C1,12); \
    }while(0)
  int t=1;
  #undef CMASK
  #define CMASK(P0,P1,t) do{}while(0)
  for(;t+5<NT;t+=2){
    STEP(pB0,pB1,pA0,pA1,t,true,true,true);     WAIT_BAR(2); RESC(); ROT();
    STEP(pA0,pA1,pB0,pB1,t+1,true,true,true);   WAIT_BAR(2); RESC(); ROT();
  }
  #undef CMASK
  #define CMASK(P0,P1,t) do{}while(0)
  #define ENDW(tt) do{ if((tt)+3<NT){WAIT_BAR(2);} else if((tt)+2<NT){WAIT_BAR(1);} else {WAIT_BAR(0);} }while(0)
  for(;t+1<NT;t+=2){
    STEP(pB0,pB1,pA0,pA1,t,(t+3<NT),(t+1<NT),(t+1<NT));       ENDW(t);   RESC(); ROT();
    STEP(pA0,pA1,pB0,pB1,t+1,(t+4<NT),(t+2<NT),(t+2<NT));     ENDW(t+1); RESC(); ROT();
  }
  STEP(pB0,pB1,pA0,pA1,NT-1,false,false,false); RESC();
  { float sacc=pB0[0]+pB0[1]; _Pragma("unroll") for(int r=2;r<16;++r)sacc+=pB0[r]; _Pragma("unroll") for(int r=0;r<16;++r)sacc+=pB1[r]; l_reg+=sacc;
    pw0=(u32x4){PKW(pB0,0),PKW(pB0,2),PKW(pB0,4),PKW(pB0,6)};pw1=(u32x4){PKW(pB0,8),PKW(pB0,10),PKW(pB0,12),PKW(pB0,14)};pw2=(u32x4){PKW(pB1,0),PKW(pB1,2),PKW(pB1,4),PKW(pB1,6)};pw3=(u32x4){PKW(pB1,8),PKW(pB1,10),PKW(pB1,12),PKW(pB1,14)};
    SBAR(); pv(o,vb0+sl_cur,PAF(0),PAF(1),PAF(2),PAF(3)); }
  #undef PKW
  #undef PAF
  #undef VFR
  #undef PIN
  #undef MX3
  #undef GAPA
  #undef GAPB
  #undef EX
  #undef VRD
  #undef KRD
  #undef STEP
  #undef ENDW
  {auto rr=__builtin_amdgcn_permlane32_swap(__float_as_uint(l_reg),__float_as_uint(l_reg),false,false);l_reg=__uint_as_float(rr[0])+__uint_as_float(rr[1]);}
  if(hi==0)wsf[32+r32]=l_reg;asm volatile("s_waitcnt lgkmcnt(0)":::"memory");
  float rli[16];
  #pragma unroll
  for(int r=0;r<16;++r)rli[r]=__builtin_amdgcn_rcpf(wsf[32+crow(r,hi)]);
  bf16*Ow=O0+(long)(wid*QBLK)*DMO;
  { bf16*stg=(bf16*)(shm+LDS_OST)+wid*2048;
    #pragma unroll
    for(int r=0;r<16;++r){const int orow=crow(r,hi);
      #pragma unroll
      for(int d0=0;d0<2;++d0)stg[orow*64+d0*32+r32]=__float2bfloat16(o[d0][r]*rli[r]);}
    asm volatile("s_waitcnt lgkmcnt(0)":::"memory");
    #pragma unroll
    for(int i=0;i<4;++i){const int row=i*8+(lane>>3),ch=lane&7; const u32x4 v=*(const u32x4*)(stg+row*64+ch*8); ATTN_STORE16(Ow+(long)row*DMO+ch*8,v);} }
  asm volatile("s_waitcnt lgkmcnt(0)\n\ts_barrier":::"memory");
  #undef DMA_K
  #undef DMA_V
  #undef CMASK
  #undef START
  #undef RESC
  #undef ROT
}
constexpr int ATTN_LDS_BYTES=LDS_BYTES;
#undef SBAR
#undef WAIT_BAR
}
#define XB_TMO      128
#define XB_XCNT(j)  (256  + 64 * (j))
#define XB_XSUB(j)  (1280 + 64 * (j))
#define XB_XGEN(j)  (2304 + 64 * (j))
#define XB_TOP      3328
#define XB_TOPGEN   3392
#define XCD_BAR_WORDS 3456
#define XB_SPIN_CAP (1u << 18)
__device__ __forceinline__ unsigned xb_ld(unsigned* p)              { return __hip_atomic_load(p, __ATOMIC_RELAXED, __HIP_MEMORY_SCOPE_AGENT); }
__device__ __forceinline__ unsigned xb_add(unsigned* p, unsigned v) { return __hip_atomic_fetch_add(p, v, __ATOMIC_RELAXED, __HIP_MEMORY_SCOPE_AGENT); }
__device__ __forceinline__ unsigned xb_xcc_id() { return (unsigned)__builtin_amdgcn_s_getreg((3 << 11) | 20) & 0xFu; }
#define XB_SPIN(cond, bar) do { unsigned _sp = 0; while (cond) { __builtin_amdgcn_s_sleep(1); \
    if ((++_sp & 255u) == 0u) { if (xb_ld(&(bar)[XB_TMO])) break; if (_sp > XB_SPIN_CAP) { atomicAdd(&(bar)[XB_TMO], 1u); break; } } } } while (0)

struct XcdBarrier {
    unsigned* bar; unsigned x;
    volatile LAS unsigned* st;
};

__device__ __forceinline__ XcdBarrier xcd_barrier_post(unsigned* bar, volatile LAS unsigned* st) {
    XcdBarrier b; b.bar = bar; b.x = xb_xcc_id(); b.st = st;
    if (threadIdx.x == 0) (void)xb_add(&bar[XB_XCNT(b.x)], 1u);
    return b;
}
__device__ __forceinline__ void xcd_barrier_complete(unsigned* bar, unsigned x, unsigned& nloc, unsigned& nx) {
    const unsigned G = gridDim.x * gridDim.y * gridDim.z;
    unsigned sum, cnt, mine, sp = 0u;
    for (;;) {
        sum = 0u; cnt = 0u; mine = 0u;
#pragma unroll
        for (unsigned j = 0; j < 16; ++j) { const unsigned c = xb_ld(&bar[XB_XCNT(j)]); sum += c; cnt += (c > 0u) ? 1u : 0u; mine = (j == x) ? c : mine; }
        if (sum == G) break;
        __builtin_amdgcn_s_sleep(1);
        if ((++sp & 255u) == 0u) { if (xb_ld(&bar[XB_TMO])) break; if (sp > XB_SPIN_CAP) { atomicAdd(&bar[XB_TMO], 1u); break; } }
    }
    nloc = mine > 0u ? mine : 1u; nx = cnt > 0u ? cnt : 1u;
}

__device__ __forceinline__ void xcd_barrier(const XcdBarrier& b) {
    asm volatile("s_waitcnt vmcnt(0)" ::: "memory");
    __syncthreads();
    if (threadIdx.x == 0) {
        unsigned* bar = b.bar;
        __builtin_amdgcn_s_waitcnt(0);
        unsigned nloc = b.st[0], nx = b.st[1];
        if (nloc == 0u) { xcd_barrier_complete(bar, b.x, nloc, nx); b.st[0] = nloc; b.st[1] = nx; }
        const unsigned old = xb_add(&bar[XB_XSUB(b.x)], 1u);
        const unsigned gen = old / nloc;
        if (old + 1u == (gen + 1u) * nloc) {
            __builtin_amdgcn_fence(__ATOMIC_RELEASE, "agent");
            asm volatile("s_waitcnt vmcnt(0)" ::: "memory");
            const unsigned og = xb_add(&bar[XB_TOP], 1u);
            const unsigned tg = og / nx;
            if (og + 1u == (tg + 1u) * nx) xb_add(&bar[XB_TOPGEN], 1u);
            else XB_SPIN(xb_ld(&bar[XB_TOPGEN]) == tg, bar);
            __builtin_amdgcn_fence(__ATOMIC_ACQUIRE, "agent");
            xb_add(&bar[XB_XGEN(b.x)], 1u);
            asm volatile("s_waitcnt vmcnt(0)" ::: "memory");
        } else {
            XB_SPIN(xb_ld(&bar[XB_XGEN(b.x)]) == gen, bar);
            __builtin_amdgcn_fence(__ATOMIC_ACQUIRE, "agent");
            asm volatile("s_waitcnt vmcnt(0)" ::: "memory");
        }
    }
    __syncthreads();
}
constexpr size_t MiB = 1u << 20;
constexpr size_t WS_CTL = 0, CTL_ZERO_BYTES = 1 * MiB;
constexpr size_t WS_MOD = 1 * MiB, WS_ROPE = 1 * MiB + 256 * 1024, WS_BOUT = 1 * MiB + 512 * 1024;
constexpr size_t WS_WIN_T = 2 * MiB, WS_WOUT_T = 9 * MiB, WS_WS_T = 13 * MiB, WS_GWS = 21 * MiB, WS_XC1 = 22 * MiB, WS_XC2 = 26 * MiB;
constexpr size_t WS_U8 = 32 * MiB, WS_V8 = 64 * MiB, WS_H = 96 * MiB, WS_Q = 162 * MiB, WS_KV = 195 * MiB, WS_ZG = 212 * MiB, WS_YC = 245 * MiB, WS_MIX = 262 * MiB, WS_Y = 328 * MiB;
constexpr size_t WS_S = 162 * MiB;
constexpr size_t WS_PACT = 162 * MiB, WS_F = 394 * MiB;
constexpr size_t WS_X1B = 394 * MiB;
constexpr size_t WS_TKI = 477 * MiB, WS_TKG = 486 * MiB, WS_W = 460 * MiB;
constexpr size_t WS_H8 = 294 * MiB;
constexpr size_t WS_END = 503 * MiB;
static_assert(WS_S + (size_t)MT * 2048 * 4 <= WS_END && WS_Y + (size_t)MT * 1024 * 4 <= WS_END && WS_H + (size_t)MT * 1024 * 2 <= WS_Q && WS_MIX + (size_t)MT * 1024 * 2 <= WS_Y, "d_ws map");
constexpr int CW_BAR = 4096, CW_Q = 8192;
constexpr int RING_BYTES = 131072, MISC_OFF = 143360, LDS_BYTES = 147456;
constexpr int N_PHASES = 22;

#define XB_SPIN_CAP_OVERRIDE (1u << 22)

struct Params { const float* in[28]; float* out; unsigned char* ws; int ph_lo, ph_hi; };

struct Frame { LAS unsigned char* lds; int tid, lane, wave, vcu, G; };

__host__ __device__ __forceinline__ int inproj_phys(int L) {
    if (L < 512) { const int hq = L >> 6, d = L & 63; return (hq >> 2) * 256 + (d >> 5) * 128 + (hq & 3) * 32 + (d & 31); }
    if (L < 768) { const int hh = (L - 512) >> 6, d = L & 63; return 512 + (d >> 5) * 128 + hh * 32 + (d & 31); }
    if (L < 1280) return L;
    const int isg = (L >= 1536), ch = L - 1280 - isg * 256; return (5 + (ch >> 7)) * 256 + isg * 128 + (ch & 127);
}
__device__ __forceinline__ void p0_transpose_item(const float* W, int K, int N, bf16_t* WT, int k0, int n0, int prow0, LAS float* scr, int lane) {
    float tv_[32];
#pragma unroll
    for (int i = 0; i < 32; ++i) { const int kk = 2 * i + (lane >> 5); tv_[i] = W[(size_t)(k0 + kk) * N + n0 + (lane & 31)]; }
#pragma unroll
    for (int i = 0; i < 32; ++i) { const int kk = 2 * i + (lane >> 5); scr[kk * 33 + (lane & 31)] = tv_[i]; }
    asm volatile("s_waitcnt lgkmcnt(0)" ::: "memory");
    const int c = lane & 7;
#pragma unroll
    for (int j = 0; j < 4; ++j) { const int n = (lane >> 3) + 8 * j; const LAS float* s = scr + (8 * c) * 33 + n;
        u32x4 o; o.x = pk2(s[0 * 33], s[1 * 33]); o.y = pk2(s[2 * 33], s[3 * 33]); o.z = pk2(s[4 * 33], s[5 * 33]); o.w = pk2(s[6 * 33], s[7 * 33]);
        *(u32x4*)(WT + (size_t)(prow0 + n) * K + k0 + 8 * c) = o; }
    asm volatile("s_waitcnt lgkmcnt(0)" ::: "memory");
}

__device__ __forceinline__ void p0_mod_item(const Frame& F0, int item, const float* c, const float* cctx, const float* w_mod, const float* b_mod, float* mod) {
    Frame F = F0; { const int t_ = mk_tid(); F.tid = t_; F.lane = t_ & 63; }
    LAS float* sc = (LAS float*)F.lds;
    LAS float* red = (LAS float*)(F.lds + 20480);
    const int l = item / 96, cg = item % 96;
    __syncthreads();
    for (int i = F.tid; i < 5 * 1024; i += NTHREADS) { const int r = i >> 10, k = i & 1023; const float v = r < 4 ? c[r * 1024 + k] : cctx[k]; sc[i] = v * fast_sigmoid(v); }
    __syncthreads();
    const int c4 = (F.lane & 15) * 4, ks = F.lane >> 4;
    float acc[5][4];
#pragma unroll
    for (int r = 0; r < 5; ++r)
#pragma unroll
        for (int e = 0; e < 4; ++e) acc[r][e] = 0.f;
    const float* wp = w_mod + (size_t)l * 1024 * 6144 + cg * 64 + c4;
    f32x4 wl[32];
#pragma unroll
    for (int i = 0; i < 32; ++i) wl[i] = *(const f32x4*)(wp + (size_t)(F.wave * 128 + 4 * i + ks) * 6144);
#pragma unroll
    for (int i = 0; i < 32; ++i) {
        const int k = F.wave * 128 + 4 * i + ks;
        const f32x4 w = wl[i];
#pragma unroll
        for (int r = 0; r < 5; ++r) { const float s = sc[r * 1024 + k]; acc[r][0] += s * w[0]; acc[r][1] += s * w[1]; acc[r][2] += s * w[2]; acc[r][3] += s * w[3]; }
    }
#pragma unroll
    for (int r = 0; r < 5; ++r)
#pragma unroll
        for (int e = 0; e < 4; ++e) { float v = acc[r][e]; v += __shfl_xor(v, 16); v += __shfl_xor(v, 32); acc[r][e] = v; }
    if (ks == 0) {
#pragma unroll
        for (int r = 0; r < 5; ++r)
#pragma unroll
            for (int e = 0; e < 4; ++e) red[(F.wave * 5 + r) * 64 + c4 + e] = acc[r][e];
    }
    __syncthreads();
    if (F.tid < 320) { const int r = F.tid >> 6, cc = F.tid & 63; float v = b_mod[l * 6144 + cg * 64 + cc];
#pragma unroll
        for (int w = 0; w < 8; ++w) v += red[(w * 5 + r) * 64 + cc];
        mod[(size_t)(l * 5 + r) * 6144 + cg * 64 + cc] = v; }
}

__device__ __forceinline__ void p0_ws_item(const Frame& F0, int item, const float* w_q, const float* sk, bf16_t* Ws_t) {
    Frame F = F0; { const int t_ = mk_tid(); F.tid = t_; F.lane = t_ & 63; }
    LAS float* sks = (LAS float*)F.lds;
    LAS float* wqs = (LAS float*)(F.lds + 128 * 132 * 4);
    const int l = item >> 8, hp = (item >> 4) & 15, j0 = (item & 15) * 64;
    __syncthreads();
    const float* skp = sk + ((size_t)l * 16 + hp) * 128 * 128;
    { f32x4 t0[8], t1[4];
#pragma unroll
      for (int it = 0; it < 8; ++it) { const int i = it * NTHREADS + F.tid, k = i >> 5, d4 = (i & 31) * 4; t0[it] = *(const f32x4*)(skp + k * 128 + d4); }
#pragma unroll
      for (int it = 0; it < 4; ++it) { const int i = it * NTHREADS + F.tid, j = i >> 5, d4 = (i & 31) * 4; t1[it] = *(const f32x4*)(w_q + ((size_t)l * 1024 + j0 + j) * 2048 + hp * 128 + d4); }
#pragma unroll
      for (int it = 0; it < 8; ++it) { const int i = it * NTHREADS + F.tid, k = i >> 5, d4 = (i & 31) * 4; *(LAS f32x4*)(sks + k * 132 + d4) = t0[it]; }
#pragma unroll
      for (int it = 0; it < 4; ++it) { const int i = it * NTHREADS + F.tid, j = i >> 5, d4 = (i & 31) * 4; *(LAS f32x4*)(wqs + j * 128 + d4) = t1[it]; } }
    __syncthreads();
    const int k = F.tid & 127, jg = F.tid >> 7;
    float acc[16];
#pragma unroll
    for (int i = 0; i < 16; ++i) acc[i] = 0.f;
    for (int d4 = 0; d4 < 128; d4 += 4) {
        const f32x4 a = *(const LAS f32x4*)(sks + k * 132 + d4);
#pragma unroll
        for (int jj = 0; jj < 16; ++jj) { const f32x4 b = *(const LAS f32x4*)(wqs + (jg * 16 + jj) * 128 + d4); acc[jj] += (a[0] * b[0] + a[1] * b[1]) + (a[2] * b[2] + a[3] * b[3]); }
    }
    bf16_t* dst = Ws_t + ((size_t)l * 2048 + hp * 128 + k) * 1024 + j0 + jg * 16;
    u32x4 o0, o1;
    o0.x = pk2(acc[0], acc[1]); o0.y = pk2(acc[2], acc[3]); o0.z = pk2(acc[4], acc[5]); o0.w = pk2(acc[6], acc[7]);
    o1.x = pk2(acc[8], acc[9]); o1.y = pk2(acc[10], acc[11]); o1.z = pk2(acc[12], acc[13]); o1.w = pk2(acc[14], acc[15]);
    *(u32x4*)dst = o0; *(u32x4*)(dst + 8) = o1;
}

__device__ __forceinline__ void p0_wc_item(const Frame& F0, int item, const float* w_pw, const float* b_pw, const float* w_out, bf16_t* Wout_t, float* bout) {
    Frame F = F0; { const int t_ = mk_tid(); F.tid = t_; F.lane = t_ & 63; }
    LAS float* wos = (LAS float*)F.lds;
    LAS float* wps = (LAS float*)(F.lds + 65536);
    const int l = item >> 6, nb = (item >> 2) & 15, kb = item & 3, n0 = nb * 64, kk0 = kb * 64;
    __syncthreads();
    { f32x4 t0[8], t1[8];
#pragma unroll
      for (int it = 0; it < 8; ++it) { const int i = it * NTHREADS + F.tid, j = i >> 4, n4 = (i & 15) * 4; t0[it] = *(const f32x4*)(w_out + ((size_t)l * 1024 + 768 + j) * 1024 + n0 + n4); }
#pragma unroll
      for (int it = 0; it < 8; ++it) { const int i = it * NTHREADS + F.tid, kk = i >> 6, j4 = (i & 63) * 4; t1[it] = *(const f32x4*)(w_pw + ((size_t)l * 256 + kk0 + kk) * 256 + j4); }
#pragma unroll
      for (int it = 0; it < 8; ++it) { const int i = it * NTHREADS + F.tid, j = i >> 4, n4 = (i & 15) * 4; *(LAS f32x4*)(wos + j * 64 + n4) = t0[it]; }
#pragma unroll
      for (int it = 0; it < 8; ++it) { const int i = it * NTHREADS + F.tid, kk = i >> 6, j4 = (i & 63) * 4; *(LAS f32x4*)(wps + kk * 256 + j4) = t1[it]; } }
    __syncthreads();
    const int n = F.tid & 63, kg = F.tid >> 6;
    float acc[8];
#pragma unroll
    for (int i = 0; i < 8; ++i) acc[i] = 0.f;
    for (int j4 = 0; j4 < 256; j4 += 4) {
        const float a0 = wos[(j4 + 0) * 64 + n], a1 = wos[(j4 + 1) * 64 + n], a2 = wos[(j4 + 2) * 64 + n], a3 = wos[(j4 + 3) * 64 + n];
#pragma unroll
        for (int i = 0; i < 8; ++i) { const f32x4 b = *(const LAS f32x4*)(wps + (kg * 8 + i) * 256 + j4); acc[i] += (a0 * b[0] + a1 * b[1]) + (a2 * b[2] + a3 * b[3]); }
    }
    u32x4 o; o.x = pk2(acc[0], acc[1]); o.y = pk2(acc[2], acc[3]); o.z = pk2(acc[4], acc[5]); o.w = pk2(acc[6], acc[7]);
    *(u32x4*)(Wout_t + ((size_t)l * 1024 + n0 + n) * 1024 + 768 + kk0 + kg * 8) = o;
    if (kb == 0 && kg == 0) { float b = 0.f; for (int j = 0; j < 256; ++j) b += b_pw[l * 256 + j] * wos[j * 64 + n]; bout[l * 1024 + n0 + n] = b; }
}


struct P0Ptrs { const float *c, *c_ctx, *w_mod, *b_mod, *peer_w_q, *peer_sk, *conv_w_pw, *conv_b_pw, *w_out, *w_in, *peer_u, *peer_v; float *mod, *bout; bf16_t *Ws_t, *Wout_t, *Win_t; unsigned char *u8, *v8; };
__device__ __forceinline__ void p0_block_items(const Frame& F, const P0Ptrs& P, int l, int which, int w, int nw) {
    const int n0 = (which & 1) ? 96 : 0, n1 = (which & 2) ? 256 : 0, n2 = (which & 4) ? 64 : 0;
    for (int it = w; it < n0 + n1 + n2; it += nw) {
        if (it < n0) p0_mod_item(F, l * 96 + it, P.c, P.c_ctx, P.w_mod, P.b_mod, P.mod);
        else if (it < n0 + n1) p0_ws_item(F, l * 256 + it - n0, P.peer_w_q, P.peer_sk, P.Ws_t);
        else p0_wc_item(F, l * 64 + it - n0 - n1, P.conv_w_pw, P.conv_b_pw, P.w_out, P.Wout_t, P.bout);
    }
    __syncthreads();
}
__device__ __forceinline__ void p0_wave_transposes(const Frame& F, const P0Ptrs& P, int l, int ww, int nww) {
    LAS float* scr = (LAS float*)(F.lds + F.wave * 16384);
    for (int it = ww; it < 896 + 384; it += nww) {
        if (it < 896) { const int kb = it / 56, nb = it % 56;
            p0_transpose_item(P.w_in + (size_t)l * 1024 * INW, 1024, INW, P.Win_t + (size_t)l * INW * 1024, kb * 64, nb * 32, inproj_phys(nb * 32), scr, F.lane); }
        else { const int r = it - 896, kb = r / 32, nb = r % 32;
            p0_transpose_item(P.w_out + (size_t)l * 1024 * 1024, 1024, 1024, P.Wout_t + (size_t)l * 1024 * 1024, kb * 64, nb * 32, nb * 32, scr, F.lane); }
    }
}
__device__ __forceinline__ void p0_convert_tables(const P0Ptrs& P, int l, int t, int nt) {
    const int n8 = 16384 * 128;
    const size_t base = (size_t)l * 16384 * 1024;
#pragma unroll 1
    for (int i0 = t; i0 < n8; i0 += 4 * nt) {
        f32x4 a[4][2], b[4][2];
#pragma unroll
        for (int k = 0; k < 4; ++k) { const int i = i0 + k * nt; if (i < n8) { const float* up = P.peer_u + base + (size_t)i * 8; const float* vp = P.peer_v + base + (size_t)i * 8;
            a[k][0] = *(const f32x4*)up; a[k][1] = *(const f32x4*)(up + 4); b[k][0] = *(const f32x4*)vp; b[k][1] = *(const f32x4*)(vp + 4); } }
#pragma unroll
        for (int k = 0; k < 4; ++k) { const int i = i0 + k * nt; if (i < n8) {
            const int e = i >> 7, cg8 = i & 127;
            { const f32x4 a0 = a[k][0] * U_SCALE, a1 = a[k][1] * U_SCALE; unsigned wu = 0u;
#ifdef TEST_SWAP_NIB
              wu = __builtin_amdgcn_cvt_scalef32_pk_fp4_f32(wu, a0[1], a0[0], 1.0f, 0); wu = __builtin_amdgcn_cvt_scalef32_pk_fp4_f32(wu, a0[3], a0[2], 1.0f, 1);
              wu = __builtin_amdgcn_cvt_scalef32_pk_fp4_f32(wu, a1[1], a1[0], 1.0f, 2); wu = __builtin_amdgcn_cvt_scalef32_pk_fp4_f32(wu, a1[3], a1[2], 1.0f, 3);
#else
              wu = __builtin_amdgcn_cvt_scalef32_pk_fp4_f32(wu, a0[0], a0[1], 1.0f, 0); wu = __builtin_amdgcn_cvt_scalef32_pk_fp4_f32(wu, a0[2], a0[3], 1.0f, 1);
              wu = __builtin_amdgcn_cvt_scalef32_pk_fp4_f32(wu, a1[0], a1[1], 1.0f, 2); wu = __builtin_amdgcn_cvt_scalef32_pk_fp4_f32(wu, a1[2], a1[3], 1.0f, 3);
#endif
              ((unsigned*)P.u8)[(((size_t)l * 4 + (cg8 >> 5)) * 16384 + e) * 32 + (cg8 & 31)] = wu; }
            const f32x4 b0 = b[k][0] * V_SCALE, b1 = b[k][1] * V_SCALE; unsigned wv = 0u;
            wv = __builtin_amdgcn_cvt_scalef32_pk_fp4_f32(wv, b0[0], b0[1], 1.0f, 0); wv = __builtin_amdgcn_cvt_scalef32_pk_fp4_f32(wv, b0[2], b0[3], 1.0f, 1);
            wv = __builtin_amdgcn_cvt_scalef32_pk_fp4_f32(wv, b1[0], b1[1], 1.0f, 2); wv = __builtin_amdgcn_cvt_scalef32_pk_fp4_f32(wv, b1[2], b1[3], 1.0f, 3);
            ((unsigned*)P.v8)[(((size_t)l * 4 + (cg8 >> 5)) * 16384 + e) * 32 + (cg8 & 31)] = wv; } }
    }
}
__device__ __forceinline__ int idle_worker(int nwg, int G, int c, int& nw) {
    const int rounds = (nwg + G - 1) / G, busy = nwg - (rounds - 1) * G;
    if (busy == G) { nw = G; return c; }
    nw = G - busy; return c >= busy ? c - busy : -1;
}
__device__ __forceinline__ void gmlp_chunk(const Frame& F, int chunk, const bf16_t* zg, const float* ln_g, const float* ln_b, const bf16_t* gws, const float* b_s, bf16_t* mix) {
    constexpr int VP = 272;
    LAS unsigned char* vT = F.lds;
    const int row0 = chunk * 128;
    __syncthreads();
    {
        const f32x4 gg = *(const f32x4*)(ln_g + F.lane * 4), bb = *(const f32x4*)(ln_b + F.lane * 4);
        u32x2 wpre[16];
#pragma unroll
        for (int r = 0; r < 16; ++r) wpre[r] = *(const u32x2*)(zg + (size_t)(row0 + F.wave * 16 + r) * 512 + 256 + F.lane * 4);
#pragma unroll
        for (int r = 0; r < 16; ++r) {
            const int q = F.wave * 16 + r;
            const u32x2 w = wpre[r];
            float a = bflo(w.x), b = bfhi(w.x), c = bflo(w.y), d = bfhi(w.y);
            const float mu = wave_sum((a + b) + (c + d)) * (1.0f / 256.0f);
            a -= mu; b -= mu; c -= mu; d -= mu;
            const float rstd = 1.0f / sqrtf(wave_sum((a * a + b * b) + (c * c + d * d)) * (1.0f / 256.0f) + EPS);
            LAS unsigned short* dst = (LAS unsigned short*)(vT + (F.lane * 4) * VP + q * 2);
            dst[0] = (unsigned short)f2bf(a * rstd * gg[0] + bb[0]);
            dst[VP / 2] = (unsigned short)f2bf(b * rstd * gg[1] + bb[1]);
            dst[VP] = (unsigned short)f2bf(c * rstd * gg[2] + bb[2]);
            dst[VP / 2 * 3] = (unsigned short)f2bf(d * rstd * gg[3] + bb[3]);
        }
    }
    __syncthreads();
    const int g = F.wave >> 1, ph = F.wave & 1, fr = F.lane & 15, fq = F.lane >> 4;
    f32x4 acc[4][4];
#pragma unroll
    for (int ct = 0; ct < 4; ++ct)
#pragma unroll
        for (int pt = 0; pt < 4; ++pt) acc[ct][pt] = (f32x4){0.f, 0.f, 0.f, 0.f};
#pragma unroll
    for (int ks = 0; ks < 4; ++ks) {
        bf16x8 af[4], bfr[4];
#pragma unroll
        for (int ct = 0; ct < 4; ++ct) af[ct] = *(const LAS bf16x8*)(vT + (g * 64 + ct * 16 + fr) * VP + (ks * 32 + fq * 8) * 2);
#pragma unroll
        for (int pt = 0; pt < 4; ++pt) bfr[pt] = *(const bf16x8*)(gws + ((size_t)(g * 128 + ph * 64 + pt * 16 + fr)) * 128 + ks * 32 + fq * 8);
#pragma unroll
        for (int ct = 0; ct < 4; ++ct)
#pragma unroll
            for (int pt = 0; pt < 4; ++pt) acc[ct][pt] = __builtin_amdgcn_mfma_f32_16x16x32_bf16(af[ct], bfr[pt], acc[ct][pt], 0, 0, 0);
    }
#pragma unroll
    for (int pt = 0; pt < 4; ++pt) {
        const int p = ph * 64 + pt * 16 + fr; const float bs = b_s[g * 128 + p];
        const bf16_t* urow = zg + (size_t)(row0 + p) * 512 + g * 64 + 4 * fq;
        bf16_t* orow = mix + (size_t)(row0 + p) * 1024 + 512 + g * 64 + 4 * fq;
#pragma unroll
        for (int ct = 0; ct < 4; ++ct) { const u32x2 u = *(const u32x2*)(urow + ct * 16); const f32x4 s = acc[ct][pt] + bs;
            u32x2 o; o.x = pk2(bflo(u.x) * s[0], bfhi(u.x) * s[1]); o.y = pk2(bflo(u.y) * s[2], bfhi(u.y) * s[3]); *(u32x2*)(orow + ct * 16) = o; }
    }
}

__device__ __forceinline__ void conv_tile(const Frame& F, int tile, const bf16_t* yc, const float* w_dw, const float* b_dw, const float* ln_g, const float* ln_b, bf16_t* mix) {
    LAS unsigned short* T = (LAS unsigned short*)F.lds;
    LAS float* red = (LAS float*)(F.lds + 158 * 512);
    LAS float* stat = red + 128 * 8;
    const int row0 = tile * 128; const bool lat = row0 < ML;
    const int Ls = lat ? SEQ : CTXL, t0 = lat ? (row0 & (SEQ - 1)) : ((row0 - ML) & (CTXL - 1));
    __syncthreads();
    {
        u32x4 tv[10];
#pragma unroll
        for (int it = 0; it < 10; ++it) { const int i = it * NTHREADS + F.tid, r = i >> 5, c8 = (i & 31) * 8; const int tt = t0 + r - 15;
            tv[it] = (u32x4){0u, 0u, 0u, 0u}; if (i < 158 * 32 && tt >= 0 && tt < Ls) tv[it] = *(const u32x4*)(yc + (size_t)(row0 + r - 15) * 256 + c8); }
#pragma unroll
        for (int it = 0; it < 10; ++it) { const int i = it * NTHREADS + F.tid, r = i >> 5, c8 = (i & 31) * 8; if (i < 158 * 32) *(LAS u32x4*)(T + r * 256 + c8) = tv[it]; }
    }
    __syncthreads();
    const int ch = F.tid & 255, half = F.tid >> 8;
    float wd[31];
#pragma unroll
    for (int j = 0; j < 31; ++j) wd[j] = w_dw[j * 256 + ch];
    const float bd = b_dw[ch];
#pragma unroll 1
    for (int grp = 0; grp < 8; ++grp) {
        const int rb = half * 64 + grp * 8;
        float a[8];
#pragma unroll
        for (int k = 0; k < 8; ++k) a[k] = bd;
#pragma unroll
        for (int i = 0; i < 38; ++i) { const float x = __uint_as_float(((unsigned)T[(rb + i) * 256 + ch]) << 16);
#pragma unroll
            for (int k = 0; k < 8; ++k) { const int j = i - k; if (j >= 0 && j < 31) a[k] += x * wd[j]; } }
        float pr[16];
#pragma unroll
        for (int k = 0; k < 8; ++k) { pr[k] = a[k]; pr[8 + k] = a[k] * a[k]; }
        const float tot = wave_reduce16(pr, F.lane);
        if ((F.lane & 3) == 0) { const int idx = (F.lane >> 2) & 15; red[((rb + (idx & 7)) * 4 + (F.wave & 3)) * 2 + (idx >> 3)] = tot; }
    }
    __syncthreads();
    if (F.tid < 128) { const int r = F.tid; float s = 0.f, q = 0.f;
#pragma unroll
        for (int w = 0; w < 4; ++w) { s += red[(r * 4 + w) * 2]; q += red[(r * 4 + w) * 2 + 1]; }
        const float mu = s * (1.0f / 256.0f); const float var = fmaxf(q * (1.0f / 256.0f) - mu * mu, 0.f);
        stat[r * 2] = mu; stat[r * 2 + 1] = 1.0f / sqrtf(var + EPS); }
    __syncthreads();
    const float gg = ln_g[ch], bb = ln_b[ch];
#pragma unroll 1
    for (int grp = 0; grp < 8; ++grp) {
        const int rb = half * 64 + grp * 8;
        float a[8];
#pragma unroll
        for (int k = 0; k < 8; ++k) a[k] = bd;
#pragma unroll
        for (int i = 0; i < 38; ++i) { const float x = __uint_as_float(((unsigned)T[(rb + i) * 256 + ch]) << 16);
#pragma unroll
            for (int k = 0; k < 8; ++k) { const int j = i - k; if (j >= 0 && j < 31) a[k] += x * wd[j]; } }
#pragma unroll
        for (int k = 0; k < 8; ++k) { const int r = rb + k; float y = (a[k] - stat[r * 2]) * stat[r * 2 + 1] * gg + bb; y = y * fast_sigmoid(y);
            mix[(size_t)(row0 + r) * 1024 + 768 + ch] = (bf16_t)f2bf(y); }
    }
}

struct TRow { u32x2 t[4]; };
__device__ __forceinline__ void trow_load(TRow& I, int row, int lane, const bf16_t* tb) {
    const bf16_t* p = tb + (size_t)row * D;
#pragma unroll
    for (int j = 0; j < 4; ++j) I.t[j] = *(const u32x2*)(p + j * 256 + lane * 4);
}
__device__ __forceinline__ float ln1_apply(f32x4 (&v)[4], const TRow& I, const f32x4 (&lg)[4], const f32x4 (&lb)[4]) {
    float s = 0.f;
#pragma unroll
    for (int j = 0; j < 4; ++j) { const u32x2 w = I.t[j]; v[j] = (f32x4){bflo(w.x), bfhi(w.x), bflo(w.y), bfhi(w.y)}; s += (v[j][0] + v[j][1]) + (v[j][2] + v[j][3]); }
    const float mu = wave_sum(s) * (1.0f / 1024.0f); float q = 0.f;
#pragma unroll
    for (int j = 0; j < 4; ++j) { v[j] = v[j] - mu; q += (v[j][0] * v[j][0] + v[j][1] * v[j][1]) + (v[j][2] * v[j][2] + v[j][3] * v[j][3]); }
    const float rstd = 1.0f / sqrtf(wave_sum(q) * (1.0f / 1024.0f) + EPS);
    s = 0.f;
#pragma unroll
    for (int j = 0; j < 4; ++j) { v[j] = v[j] * rstd * lg[j] + lb[j]; s += (v[j][0] + v[j][1]) + (v[j][2] + v[j][3]); }
    return s;
}
__device__ __forceinline__ void adaln_store(f32x4 (&v)[4], float s, const f32x4 (&sh)[4], const f32x4 (&sc)[4], bf16_t* hrow, int lane, unsigned char* h8row = nullptr) {
    const float mu = wave_sum(s) * (1.0f / 1024.0f); float q = 0.f;
#pragma unroll
    for (int j = 0; j < 4; ++j) { v[j] = v[j] - mu; q += (v[j][0] * v[j][0] + v[j][1] * v[j][1]) + (v[j][2] * v[j][2] + v[j][3] * v[j][3]); }
    const float rstd = 1.0f / sqrtf(wave_sum(q) * (1.0f / 1024.0f) + EPS);
#pragma unroll
    for (int j = 0; j < 4; ++j) { const f32x4 o = v[j] * rstd * (sc[j] + 1.0f) + sh[j]; u32x2 w; w.x = pk2(o[0], o[1]); w.y = pk2(o[2], o[3]); *(u32x2*)(hrow + j * 256 + lane * 4) = w;
        if (h8row) { int w8 = 0; w8 = __builtin_amdgcn_cvt_pk_fp8_f32(o[0] * H_SCALE, o[1] * H_SCALE, w8, false); w8 = __builtin_amdgcn_cvt_pk_fp8_f32(o[2] * H_SCALE, o[3] * H_SCALE, w8, true); *(int*)(h8row + j * 256 + lane * 4) = w8; } }
}
__device__ __forceinline__ void load_par(f32x4 (&p)[4], const float* src, int lane) {
#pragma unroll
    for (int j = 0; j < 4; ++j) p[j] = *(const f32x4*)(src + j * 256 + lane * 4);
}
__device__ __forceinline__ void row_store(const f32x4 v, int row, int col, float* of, bf16_t* ob, float* oc) {
    if (row >= ML) *(f32x4*)(oc + (size_t)(row - ML) * D + col) = v;
    else if (ob) { u32x2 w; w.x = pk2(v[0], v[1]); w.y = pk2(v[2], v[3]); *(u32x2*)(ob + (size_t)row * D + col) = w; }
    else *(f32x4*)(of + (size_t)row * D + col) = v;
}
#define TK_INS(t, x) do { float xx_ = (x); _Pragma("unroll") for (int i_ = 0; i_ < 16; ++i_) { const float hi_ = fmaxf(t[i_], xx_); xx_ = fminf(t[i_], xx_); t[i_] = hi_; } } while (0)
__device__ __forceinline__ float dot16_fp8(const u32x4 r, const float (&hv)[16]) {
    f32x2 a = (f32x2){0.f, 0.f}, b = (f32x2){0.f, 0.f};
#pragma unroll
    for (int j = 0; j < 4; ++j) { const f32x2 lo = __builtin_amdgcn_cvt_pk_f32_fp8((int)r[j], false), hi = __builtin_amdgcn_cvt_pk_f32_fp8((int)r[j], true);
        a = __builtin_elementwise_fma(lo, (f32x2){hv[4 * j], hv[4 * j + 1]}, a); b = __builtin_elementwise_fma(hi, (f32x2){hv[4 * j + 2], hv[4 * j + 3]}, b); }
    a = a + b;
    return a[0] + a[1];
}
typedef _Float16 h2_t __attribute__((ext_vector_type(2)));
__device__ __forceinline__ float dot16_fp8_h(const u32x4 r, const h2_t (&hv)[8], const float scale) {
    float a = 0.f, b = 0.f;
#pragma unroll
    for (int j = 0; j < 4; ++j) { const h2_t lo = __builtin_amdgcn_cvt_scalef32_pk_f16_fp8((int)r[j], scale, false), hi = __builtin_amdgcn_cvt_scalef32_pk_f16_fp8((int)r[j], scale, true);
        a = __builtin_amdgcn_fdot2(lo, hv[2 * j], a, false); b = __builtin_amdgcn_fdot2(hi, hv[2 * j + 1], b, false); }
    return a + b;
}
__device__ __forceinline__ void axpy16_fp8(float (&acc)[16], const float w, const u32x4 r) {
    const f32x2 w2 = (f32x2){w, w};
#pragma unroll
    for (int j = 0; j < 4; ++j) { const f32x2 lo = __builtin_amdgcn_cvt_pk_f32_fp8((int)r[j], false), hi = __builtin_amdgcn_cvt_pk_f32_fp8((int)r[j], true);
        const f32x2 x = __builtin_elementwise_fma(w2, lo, (f32x2){acc[4 * j], acc[4 * j + 1]}), y = __builtin_elementwise_fma(w2, hi, (f32x2){acc[4 * j + 2], acc[4 * j + 3]});
        acc[4 * j] = x[0]; acc[4 * j + 1] = x[1]; acc[4 * j + 2] = y[0]; acc[4 * j + 3] = y[1]; }
}
#define TK_CE(a, b) do { const float hi_ = fmaxf(a, b), lo_ = fminf(a, b); a = hi_; b = lo_; } while (0)
__device__ __forceinline__ void tk_sort16(float (&v)[16]) {
#pragma unroll
    for (int k = 2; k <= 16; k <<= 1)
#pragma unroll
        for (int j = k >> 1; j > 0; j >>= 1)
#pragma unroll
            for (int i = 0; i < 16; ++i) { const int l = i ^ j; if (l > i) { if ((i & k) == 0) TK_CE(v[i], v[l]); else TK_CE(v[l], v[i]); } }
}
__device__ __forceinline__ void tk_bmerge16(float (&v)[16]) {
#pragma unroll
    for (int j = 8; j > 0; j >>= 1)
#pragma unroll
        for (int i = 0; i < 16; ++i) { const int l = i ^ j; if (l > i) TK_CE(v[i], v[l]); }
}
__device__ __forceinline__ void tk_merge_top(float (&t)[16], const float (&s)[16]) {
#pragma unroll
    for (int i = 0; i < 16; ++i) t[i] = fmaxf(t[i], s[15 - i]);
    tk_bmerge16(t);
}
__device__ __forceinline__ void peer_topk_wave(const Frame& F, int b0, int nb, int bstep, const unsigned short* s, unsigned short* tk_idx, float* tk_gate) {
    LAS float* l1 = (LAS float*)F.lds + (F.wave * 64) * 16;
    LAS unsigned char* xt = F.lds + 32768 + F.wave * 8192;
    const int lane = F.lane, oj = lane >> 3, piece = lane & 7;
    u32x4 ld[16];
#define TK_ISSUE(bb) do { const int r0_ = (bb) * 4; _Pragma("unroll") for (int q_ = 0; q_ < 16; ++q_) { const int o_ = 8 * (q_ & 7) + oj; \
        ld[q_] = *(const u32x4*)(s + (size_t)(r0_ + (o_ >> 4)) * 2048 + (o_ & 15) * 128 + (q_ >> 3) * 64 + piece * 8); } } while (0)
#ifndef TK_NOPREFETCH
    if (b0 < nb) TK_ISSUE(b0);
#endif
#pragma unroll 1
    for (int bb = b0; bb < nb; bb += bstep) {
        const int row0 = bb * 4;
#ifdef TK_NOPREFETCH
        TK_ISSUE(bb);
#endif
        float t[16];
#pragma unroll
        for (int hf = 0; hf < 2; ++hf) {
#pragma unroll
            for (int j = 0; j < 8; ++j) { const int o = 8 * j + oj; *(LAS u32x4*)(xt + o * 128 + ((piece ^ (o & 7)) * 16)) = ld[hf * 8 + j]; }
#pragma unroll
            for (int qd = 0; qd < 4; ++qd) {
                float v[16];
#ifdef TK_F32
#pragma unroll
                for (int pp = 0; pp < 4; ++pp) { const f32x4 x = *(const f32x4*)((const float*)s + (size_t)(row0 + (lane >> 4)) * 2048 + (lane & 15) * 128 + hf * 64 + qd * 16 + pp * 4);
#pragma unroll
                    for (int e = 0; e < 4; ++e) { const unsigned k = (unsigned)(hf * 64 + qd * 16 + pp * 4 + e); v[pp * 4 + e] = __uint_as_float((__float_as_uint((float)(_Float16)x[e]) & ~0x7Fu) | (127u - k)); } }
                if (false) {
#else
                {
#endif
#pragma unroll
#ifdef TK_DIRECT
                for (int pp = 0; pp < 2; ++pp) { const int p = qd * 2 + pp; const u32x4 x = *(const u32x4*)(s + (size_t)(row0 + (lane >> 4)) * 2048 + (lane & 15) * 128 + hf * 64 + p * 8);
#else
                for (int pp = 0; pp < 2; ++pp) { const int p = qd * 2 + pp; const u32x4 x = *(const LAS u32x4*)(xt + lane * 128 + ((p ^ (lane & 7)) * 16));
#endif
#pragma unroll
                    for (int e = 0; e < 4; ++e) { const unsigned wv_ = x[e];
                        const float f0 = (float)__builtin_bit_cast(_Float16, (unsigned short)(wv_ & 0xffffu)), f1 = (float)__builtin_bit_cast(_Float16, (unsigned short)(wv_ >> 16));
                        const unsigned k0 = (unsigned)(hf * 64 + p * 8 + e * 2);
                        v[pp * 8 + e * 2] = __uint_as_float((__float_as_uint(f0) & ~0x7Fu) | (127u - k0)); v[pp * 8 + e * 2 + 1] = __uint_as_float((__float_as_uint(f1) & ~0x7Fu) | (126u - k0)); } }
                }
                tk_sort16(v);
                if (hf == 0 && qd == 0) {
#pragma unroll
                    for (int i = 0; i < 16; ++i) t[i] = v[i];
                } else tk_merge_top(t, v);
            }
        }
#pragma unroll
        for (int i = 0; i < 4; ++i) *(LAS f32x4*)(l1 + lane * 16 + i * 4) = (f32x4){t[4 * i], t[4 * i + 1], t[4 * i + 2], t[4 * i + 3]};
#ifndef TK_NOPREFETCH
        if (bb + bstep < nb) TK_ISSUE(bb + bstep);
#endif
        {
            const LAS float* la = l1 + (lane & ~1) * 16; const LAS float* lb_ = l1 + (lane | 1) * 16;
            float a[16], b[16];
#pragma unroll
            for (int i = 0; i < 4; ++i) { const f32x4 x = *(const LAS f32x4*)(la + 4 * i), y = *(const LAS f32x4*)(lb_ + 4 * i);
                a[4 * i] = x[0]; a[4 * i + 1] = x[1]; a[4 * i + 2] = x[2]; a[4 * i + 3] = x[3]; b[4 * i] = y[0]; b[4 * i + 1] = y[1]; b[4 * i + 2] = y[2]; b[4 * i + 3] = y[3]; }
#define TK_CAND(i, j) __uint_as_float((__float_as_uint(a[i] + b[j]) & ~0xFFu) | (unsigned)(255 - ((i) * 16 + (j))))
            float x[16];
#pragma unroll
            for (int j = 0; j < 16; ++j) t[j] = TK_CAND(0, j);
#pragma unroll
            for (int j = 0; j < 8; ++j) { x[j] = TK_CAND(1, j); x[8 + j] = TK_CAND(15 - j, 0); }
            tk_bmerge16(x); tk_merge_top(t, x);
            x[0] = TK_CAND(2, 0); x[1] = TK_CAND(2, 1); x[2] = TK_CAND(2, 2); x[3] = TK_CAND(2, 3); x[4] = TK_CAND(2, 4);
            x[5] = TK_CAND(3, 0); x[6] = TK_CAND(3, 1); x[7] = TK_CAND(3, 2); x[8] = TK_CAND(3, 3);
            x[9] = TK_CAND(4, 0); x[10] = TK_CAND(4, 1); x[11] = TK_CAND(4, 2);
            x[12] = TK_CAND(5, 0); x[13] = TK_CAND(5, 1); x[14] = TK_CAND(6, 0); x[15] = TK_CAND(6, 1);
            tk_sort16(x); tk_merge_top(t, x);
            TK_INS(t, TK_CAND(7, 0)); TK_INS(t, TK_CAND(7, 1));
#undef TK_CAND
            float e[16], sum = 0.f;
#pragma unroll
            for (int i = 0; i < 16; ++i) { e[i] = __builtin_amdgcn_exp2f((t[i] - t[0]) * 1.4426950408889634f); sum += e[i]; }
            const float inv = 1.0f / sum;
            if ((lane & 1) == 0) {
                const size_t base = ((size_t)(row0 + (lane >> 4)) * 8 + ((lane & 15) >> 1)) * 16;
                int ex[16];
#pragma unroll
                for (int i = 0; i < 16; ++i) {
                    const int pos = 255 - (int)(__float_as_uint(t[i]) & 0xFFu);
                    const int ea = 127 - (int)(__float_as_uint(la[pos >> 4]) & 0x7Fu), eb = 127 - (int)(__float_as_uint(lb_[pos & 15]) & 0x7Fu);
                    ex[i] = ea * 128 + eb;
                }
#pragma unroll
                for (int i = 0; i < 2; ++i) *(u32x4*)(tk_idx + base + 8 * i) = (u32x4){(unsigned)ex[8 * i] | ((unsigned)ex[8 * i + 1] << 16), (unsigned)ex[8 * i + 2] | ((unsigned)ex[8 * i + 3] << 16), (unsigned)ex[8 * i + 4] | ((unsigned)ex[8 * i + 5] << 16), (unsigned)ex[8 * i + 6] | ((unsigned)ex[8 * i + 7] << 16)};
#pragma unroll
                for (int i = 0; i < 4; ++i) *(f32x4*)(tk_gate + base + 4 * i) = (f32x4){e[4 * i] * inv, e[4 * i + 1] * inv, e[4 * i + 2] * inv, e[4 * i + 3] * inv};
            }
        }
    }
#undef TK_ISSUE
}

__device__ __forceinline__ int q_next(const Frame& F, unsigned* qword) {
    volatile LAS int* bw = (volatile LAS int*)(F.lds + MISC_OFF + 64);
    __syncthreads();
    if (F.tid == 0) *bw = (int)__hip_atomic_fetch_add(qword, 1u, __ATOMIC_RELAXED, __HIP_MEMORY_SCOPE_AGENT);
    __syncthreads();
    return *bw;
}

typedef int v8i_t __attribute__((ext_vector_type(8)));
template <int NTW> __device__ __forceinline__ void peer_u_item(const Frame& F, int row0, int item, int slice, const unsigned char* h8, const unsigned short* tk_idx, const unsigned char* u4s  , bf16_t* pact) {
    const int lane = F.lane, c = lane & 7, ps = lane >> 3, i = lane & 15, g = lane >> 4;
    LAS unsigned char* buf = F.lds + F.wave * 16384;
    LAS unsigned char* sml = F.lds + RING_BYTES + F.wave * 1024;
    const int rowb = row0 + item * (8 * NTW) + F.wave * NTW;
    const int rdb = (8 * (i & 7) + (i >> 3)) * 128, rd0 = rdb + ((g ^ (i & 7)) * 16), rd1 = rdb + (((4 + g) ^ (i & 7)) * 16);
    const unsigned lds_rd0_ = (unsigned)(size_t)(buf + rd0), lds_rd1_ = (unsigned)(size_t)(buf + rd1);
    const unsigned ids_rd_ = (unsigned)(size_t)(sml + 16 * ps), hb_rd_ = (unsigned)(size_t)(sml + 512 + 16 * g);
#define PU_DMA_IDS(row, par) __builtin_amdgcn_global_load_lds((const unsigned*)(tk_idx + (size_t)(row) * 128 + lane * 2), (LAS unsigned*)(sml + (par) * 256), 4, 0, 0)
#define PU_DMA_HB(row, par) __builtin_amdgcn_global_load_lds((const unsigned*)(h8 + (size_t)(row) * D + slice * 256 + lane * 4), (LAS unsigned*)(sml + 512 + (par) * 256), 4, 0, 0)
#define PU_RD_IDS(dst, hf, par) asm volatile("ds_read_b128 %0, %1\n\ts_waitcnt lgkmcnt(0)" : "=&v"(dst) : "v"(ids_rd_ + (unsigned)((par) * 256 + (hf) * 128)) : "memory")
#define PU_ISSUE(hf, idv) do { _Pragma("unroll") for (int m = 0; m < 8; ++m) { const unsigned idw_ = idv[m >> 1]; const unsigned e_ = (m & 1) ? (idw_ >> 16) : (idw_ & 0xffffu); \
        __builtin_amdgcn_global_load_lds((const unsigned*)(u4s + (size_t)e_ * 128 + ((c ^ m) * 16)), (LAS unsigned*)(buf + (hf) * 8192 + m * 1024), 16, 0, 0); } } while (0)
#define PU_RD(dst, off) asm volatile("ds_read_b128 %0, %1 offset:%2" : "=v"(dst) : "v"(lds_rd0_), "n"(off))
#define PU_RD1(dst, off) asm volatile("ds_read_b128 %0, %1 offset:%2" : "=v"(dst) : "v"(lds_rd1_), "n"(off))
#define PU_HALF(hf) do { u32x4 a0_[4], a1_[4]; \
        PU_RD(a0_[0], (hf) * 8192 + 0); PU_RD1(a1_[0], (hf) * 8192 + 0); PU_RD(a0_[1], (hf) * 8192 + 256); PU_RD1(a1_[1], (hf) * 8192 + 256); \
        PU_RD(a0_[2], (hf) * 8192 + 512); PU_RD1(a1_[2], (hf) * 8192 + 512); PU_RD(a0_[3], (hf) * 8192 + 768); PU_RD1(a1_[3], (hf) * 8192 + 768); \
        asm volatile("s_waitcnt lgkmcnt(6)" : "+v"(a0_[0]), "+v"(a1_[0])); asm volatile("s_waitcnt lgkmcnt(4)" : "+v"(a0_[1]), "+v"(a1_[1])); \
        asm volatile("s_waitcnt lgkmcnt(2)" : "+v"(a0_[2]), "+v"(a1_[2])); asm volatile("s_waitcnt lgkmcnt(0)" : "+v"(a0_[3]), "+v"(a1_[3])); \
        _Pragma("unroll") for (int G = 0; G < 4; ++G) { f32x4 acc_ = (f32x4){0.f, 0.f, 0.f, 0.f}; \
        acc_ = __builtin_amdgcn_mfma_scale_f32_16x16x128_f8f6f4((v8i_t){(int)a0_[G][0], (int)a0_[G][1], (int)a0_[G][2], (int)a0_[G][3], 0, 0, 0, 0}, hb0, acc_, 4  , 0  , 0, 0x7F7F7F7F, 0, 0x7F7F7F7F); \
        acc_ = __builtin_amdgcn_mfma_scale_f32_16x16x128_f8f6f4((v8i_t){(int)a1_[G][0], (int)a1_[G][1], (int)a1_[G][2], (int)a1_[G][3], 0, 0, 0, 0}, hb1, acc_, 4, 0, 0, 0x7F7F7F7F, 0, 0x7F7F7F7F); \
        asm volatile("" : "+v"(acc_));       \
        accs[hf][G] = acc_; } } while (0)
    asm volatile("s_waitcnt lgkmcnt(0)" ::: "memory");
    PU_DMA_IDS(rowb, 0);
    asm volatile("s_waitcnt vmcnt(0)" ::: "memory");
    { u32x4 id0, id1; PU_RD_IDS(id0, 0, 0); PU_RD_IDS(id1, 1, 0);
      PU_ISSUE(0, id0); PU_DMA_HB(rowb, 0); PU_DMA_IDS(rowb + (NTW > 1 ? 1 : 0), 1); PU_ISSUE(1, id1); }
#pragma unroll 1
    for (int ti = 0; ti < NTW; ++ti) {
        const int row = rowb + ti, par = ti & 1; const bool last = ti + 1 >= NTW;
        f32x4 accs[2][4];
        asm volatile("s_waitcnt vmcnt(8)" ::: "memory");
        v8i_t hb0, hb1;
        { u32x4 x0, x1, x2, x3;
          asm volatile("ds_read_b128 %0, %4\n\tds_read_b128 %1, %4 offset:64\n\tds_read_b128 %2, %4 offset:128\n\tds_read_b128 %3, %4 offset:192\n\ts_waitcnt lgkmcnt(0)"
                       : "=&v"(x0), "=&v"(x1), "=&v"(x2), "=&v"(x3) : "v"(hb_rd_ + (unsigned)(par * 256)) : "memory");
          hb0 = (v8i_t){(int)x0[0], (int)x0[1], (int)x0[2], (int)x0[3], (int)x1[0], (int)x1[1], (int)x1[2], (int)x1[3]};
          hb1 = (v8i_t){(int)x2[0], (int)x2[1], (int)x2[2], (int)x2[3], (int)x3[0], (int)x3[1], (int)x3[2], (int)x3[3]}; }
        PU_HALF(0);
        if (!last) { u32x4 idn; PU_RD_IDS(idn, 0, par ^ 1); PU_ISSUE(0, idn); }
        if (last) asm volatile("s_waitcnt vmcnt(0)" ::: "memory"); else asm volatile("s_waitcnt vmcnt(8)" ::: "memory");
        PU_HALF(1);
        { u32x2 o = (u32x2){0u, 0u};
#pragma unroll
          for (int hf = 0; hf < 2; ++hf)
#pragma unroll
              for (int G = 0; G < 4; ++G) { const bool sel = (i == 4 * hf + G); const unsigned lo_ = pk2(accs[hf][G][0], accs[hf][G][1]), hi_ = pk2(accs[hf][G][2], accs[hf][G][3]); o.x = sel ? lo_ : o.x; o.y = sel ? hi_ : o.y; }
          if (i < 8) *(u32x2*)(pact + ((size_t)slice * MT + row) * 128 + 16 * i + 4 * g) = o; }
        if (!last) { u32x4 idn; PU_RD_IDS(idn, 1, par ^ 1); PU_DMA_HB(row + 1, par ^ 1); PU_DMA_IDS(row + (ti + 2 < NTW ? 2 : 1), par); PU_ISSUE(1, idn); }
    }
#undef PU_DMA_IDS
#undef PU_DMA_HB
#undef PU_RD_IDS
#undef PU_ISSUE
#undef PU_HALF
#undef PU_RD
#undef PU_RD1
}

template <int NTW> __device__ __forceinline__ void peer_v_item(const Frame& F, int row0, int item, int slice, const unsigned short* tk_idx, const unsigned char* w8, const unsigned* wscale, const unsigned char* v4s, bf16_t* fbuf) {
    const int lane = F.lane, c = lane & 7, ps = lane >> 3, idx = lane & 15, g = lane >> 4;
    LAS unsigned char* buf = F.lds + F.wave * 16384;
    LAS unsigned char* sml = F.lds + RING_BYTES + F.wave * 1024;
    const int rowb = row0 + item * (8 * NTW) + F.wave * NTW;
    const int rho = 8 * (idx & 7) + 4 * (g & 1) + 2 * (g >> 1) + (idx >> 3);
    unsigned adr[8];
#pragma unroll
    for (int j = 0; j < 8; ++j) adr[j] = (unsigned)(size_t)(buf + rho * 128 + ((j ^ (idx & 7)) * 16));
    const unsigned ids_rd_ = (unsigned)(size_t)(sml + 16 * (ps & 3) + 128 * (ps >> 2)), wb_rd_ = (unsigned)(size_t)(sml + 512 + 32 * g);
#define PV_DMA_IDS(row, par) __builtin_amdgcn_global_load_lds((const unsigned*)(tk_idx + (size_t)(row) * 128 + lane * 2), (LAS unsigned*)(sml + (par) * 256), 4, 0, 0)
#define PV_DMA_WB(row, par) __builtin_amdgcn_global_load_lds(lane < 32 ? (const unsigned*)(w8 + (size_t)(row) * 128 + lane * 4) : (wscale + (row)), (LAS unsigned*)(sml + 512 + (par) * 256), 4, 0, 0)
#define PV_RD_IDS(dst, h, par) asm volatile("ds_read_b128 %0, %1\n\ts_waitcnt lgkmcnt(0)" : "=&v"(dst) : "v"(ids_rd_ + (unsigned)((par) * 256 + (h) * 64)) : "memory")
#define PV_ISSUE(h, idv) do { _Pragma("unroll") for (int m = 0; m < 8; ++m) { const unsigned idw_ = idv[m >> 1]; const unsigned e_ = (m & 1) ? (idw_ >> 16) : (idw_ & 0xffffu); \
        __builtin_amdgcn_global_load_lds((const unsigned*)(v4s + (size_t)e_ * 128 + ((c ^ m) * 16)), (LAS unsigned*)(buf + (h) * 8192 + m * 1024), 16, 0, 0); } } while (0)
    asm volatile("s_waitcnt lgkmcnt(0)" ::: "memory");
    PV_DMA_IDS(rowb, 0);
    asm volatile("s_waitcnt vmcnt(0)" ::: "memory");
    { u32x4 id0, id1; PV_RD_IDS(id0, 0, 0); PV_RD_IDS(id1, 1, 0);
      PV_ISSUE(0, id0); PV_DMA_WB(rowb, 0); PV_DMA_IDS(rowb + (NTW > 1 ? 1 : 0), 1); PV_ISSUE(1, id1); }
#pragma unroll 1
    for (int ti = 0; ti < NTW; ++ti) {
        const int row = rowb + ti, par = ti & 1; const bool last = ti + 1 >= NTW;
        f32x4 acc[16];
        asm volatile("s_waitcnt vmcnt(8)" ::: "memory");
        v8i_t wb; int wsc;
        { u32x4 x0, x1; unsigned x2;
          asm volatile("ds_read_b128 %0, %3\n\tds_read_b128 %1, %3 offset:16\n\tds_read_b32 %2, %4\n\ts_waitcnt lgkmcnt(0)"
                       : "=&v"(x0), "=&v"(x1), "=&v"(x2) : "v"(wb_rd_ + (unsigned)(par * 256)), "v"((unsigned)(size_t)(sml + 512 + 128) + (unsigned)(par * 256)) : "memory");
          wb = (v8i_t){(int)x0[0], (int)x0[1], (int)x0[2], (int)x0[3], (int)x1[0], (int)x1[1], (int)x1[2], (int)x1[3]}; wsc = (int)x2; }
        { u32x2 t_[8];
        asm volatile("ds_read_b64_tr_b4 %0, %1 offset:%2" : "=v"(t_[0]) : "v"(adr[0]), "n"(0*8192 + 0));
        asm volatile("ds_read_b64_tr_b4 %0, %1 offset:%2" : "=v"(t_[1]) : "v"(adr[0]), "n"(0*8192 + 8));
        asm volatile("ds_read_b64_tr_b4 %0, %1 offset:%2" : "=v"(t_[2]) : "v"(adr[1]), "n"(0*8192 + 0));
        asm volatile("ds_read_b64_tr_b4 %0, %1 offset:%2" : "=v"(t_[3]) : "v"(adr[1]), "n"(0*8192 + 8));
        asm volatile("ds_read_b64_tr_b4 %0, %1 offset:%2" : "=v"(t_[4]) : "v"(adr[2]), "n"(0*8192 + 0));
        asm volatile("ds_read_b64_tr_b4 %0, %1 offset:%2" : "=v"(t_[5]) : "v"(adr[2]), "n"(0*8192 + 8));
        asm volatile("ds_read_b64_tr_b4 %0, %1 offset:%2" : "=v"(t_[6]) : "v"(adr[3]), "n"(0*8192 + 0));
        asm volatile("ds_read_b64_tr_b4 %0, %1 offset:%2" : "=v"(t_[7]) : "v"(adr[3]), "n"(0*8192 + 8));
        asm volatile("s_waitcnt lgkmcnt(6)" : "+v"(t_[0]), "+v"(t_[1])); asm volatile("s_waitcnt lgkmcnt(4)" : "+v"(t_[2]), "+v"(t_[3]));
        asm volatile("s_waitcnt lgkmcnt(2)" : "+v"(t_[4]), "+v"(t_[5])); asm volatile("s_waitcnt lgkmcnt(0)" : "+v"(t_[6]), "+v"(t_[7]));
        acc[0] = __builtin_amdgcn_mfma_scale_f32_16x16x128_f8f6f4((v8i_t){(int)t_[0].x, (int)t_[0].y, 0, 0, 0, 0, 0, 0}, wb, (f32x4){0.f, 0.f, 0.f, 0.f}, 4, 0, 0, 0x7F7F7F7F, 0, wsc);
        acc[1] = __builtin_amdgcn_mfma_scale_f32_16x16x128_f8f6f4((v8i_t){(int)t_[1].x, (int)t_[1].y, 0, 0, 0, 0, 0, 0}, wb, (f32x4){0.f, 0.f, 0.f, 0.f}, 4, 0, 0, 0x7F7F7F7F, 0, wsc);
        acc[2] = __builtin_amdgcn_mfma_scale_f32_16x16x128_f8f6f4((v8i_t){(int)t_[2].x, (int)t_[2].y, 0, 0, 0, 0, 0, 0}, wb, (f32x4){0.f, 0.f, 0.f, 0.f}, 4, 0, 0, 0x7F7F7F7F, 0, wsc);
        acc[3] = __builtin_amdgcn_mfma_scale_f32_16x16x128_f8f6f4((v8i_t){(int)t_[3].x, (int)t_[3].y, 0, 0, 0, 0, 0, 0}, wb, (f32x4){0.f, 0.f, 0.f, 0.f}, 4, 0, 0, 0x7F7F7F7F, 0, wsc);
        acc[4] = __builtin_amdgcn_mfma_scale_f32_16x16x128_f8f6f4((v8i_t){(int)t_[4].x, (int)t_[4].y, 0, 0, 0, 0, 0, 0}, wb, (f32x4){0.f, 0.f, 0.f, 0.f}, 4, 0, 0, 0x7F7F7F7F, 0, wsc);
        acc[5] = __builtin_amdgcn_mfma_scale_f32_16x16x128_f8f6f4((v8i_t){(int)t_[5].x, (int)t_[5].y, 0, 0, 0, 0, 0, 0}, wb, (f32x4){0.f, 0.f, 0.f, 0.f}, 4, 0, 0, 0x7F7F7F7F, 0, wsc);
        acc[6] = __builtin_amdgcn_mfma_scale_f32_16x16x128_f8f6f4((v8i_t){(int)t_[6].x, (int)t_[6].y, 0, 0, 0, 0, 0, 0}, wb, (f32x4){0.f, 0.f, 0.f, 0.f}, 4, 0, 0, 0x7F7F7F7F, 0, wsc);
        acc[7] = __builtin_amdgcn_mfma_scale_f32_16x16x128_f8f6f4((v8i_t){(int)t_[7].x, (int)t_[7].y, 0, 0, 0, 0, 0, 0}, wb, (f32x4){0.f, 0.f, 0.f, 0.f}, 4, 0, 0, 0x7F7F7F7F, 0, wsc);
        asm volatile("ds_read_b64_tr_b4 %0, %1 offset:%2" : "=v"(t_[0]) : "v"(adr[4]), "n"(0*8192 + 0));
        asm volatile("ds_read_b64_tr_b4 %0, %1 offset:%2" : "=v"(t_[1]) : "v"(adr[4]), "n"(0*8192 + 8));
        asm volatile("ds_read_b64_tr_b4 %0, %1 offset:%2" : "=v"(t_[2]) : "v"(adr[5]), "n"(0*8192 + 0));
        asm volatile("ds_read_b64_tr_b4 %0, %1 offset:%2" : "=v"(t_[3]) : "v"(adr[5]), "n"(0*8192 + 8));
        asm volatile("ds_read_b64_tr_b4 %0, %1 offset:%2" : "=v"(t_[4]) : "v"(adr[6]), "n"(0*8192 + 0));
        asm volatile("ds_read_b64_tr_b4 %0, %1 offset:%2" : "=v"(t_[5]) : "v"(adr[6]), "n"(0*8192 + 8));
        asm volatile("ds_read_b64_tr_b4 %0, %1 offset:%2" : "=v"(t_[6]) : "v"(adr[7]), "n"(0*8192 + 0));
        asm volatile("ds_read_b64_tr_b4 %0, %1 offset:%2" : "=v"(t_[7]) : "v"(adr[7]), "n"(0*8192 + 8));
        asm volatile("s_waitcnt lgkmcnt(6)" : "+v"(t_[0]), "+v"(t_[1])); asm volatile("s_waitcnt lgkmcnt(4)" : "+v"(t_[2]), "+v"(t_[3]));
        asm volatile("s_waitcnt lgkmcnt(2)" : "+v"(t_[4]), "+v"(t_[5])); asm volatile("s_waitcnt lgkmcnt(0)" : "+v"(t_[6]), "+v"(t_[7]));
        acc[8] = __builtin_amdgcn_mfma_scale_f32_16x16x128_f8f6f4((v8i_t){(int)t_[0].x, (int)t_[0].y, 0, 0, 0, 0, 0, 0}, wb, (f32x4){0.f, 0.f, 0.f, 0.f}, 4, 0, 0, 0x7F7F7F7F, 0, wsc);
        acc[9] = __builtin_amdgcn_mfma_scale_f32_16x16x128_f8f6f4((v8i_t){(int)t_[1].x, (int)t_[1].y, 0, 0, 0, 0, 0, 0}, wb, (f32x4){0.f, 0.f, 0.f, 0.f}, 4, 0, 0, 0x7F7F7F7F, 0, wsc);
        acc[10] = __builtin_amdgcn_mfma_scale_f32_16x16x128_f8f6f4((v8i_t){(int)t_[2].x, (int)t_[2].y, 0, 0, 0, 0, 0, 0}, wb, (f32x4){0.f, 0.f, 0.f, 0.f}, 4, 0, 0, 0x7F7F7F7F, 0, wsc);
        acc[11] = __builtin_amdgcn_mfma_scale_f32_16x16x128_f8f6f4((v8i_t){(int)t_[3].x, (int)t_[3].y, 0, 0, 0, 0, 0, 0}, wb, (f32x4){0.f, 0.f, 0.f, 0.f}, 4, 0, 0, 0x7F7F7F7F, 0, wsc);
        acc[12] = __builtin_amdgcn_mfma_scale_f32_16x16x128_f8f6f4((v8i_t){(int)t_[4].x, (int)t_[4].y, 0, 0, 0, 0, 0, 0}, wb, (f32x4){0.f, 0.f, 0.f, 0.f}, 4, 0, 0, 0x7F7F7F7F, 0, wsc);
        acc[13] = __builtin_amdgcn_mfma_scale_f32_16x16x128_f8f6f4((v8i_t){(int)t_[5].x, (int)t_[5].y, 0, 0, 0, 0, 0, 0}, wb, (f32x4){0.f, 0.f, 0.f, 0.f}, 4, 0, 0, 0x7F7F7F7F, 0, wsc);
        acc[14] = __builtin_amdgcn_mfma_scale_f32_16x16x128_f8f6f4((v8i_t){(int)t_[6].x, (int)t_[6].y, 0, 0, 0, 0, 0, 0}, wb, (f32x4){0.f, 0.f, 0.f, 0.f}, 4, 0, 0, 0x7F7F7F7F, 0, wsc);
        acc[15] = __builtin_amdgcn_mfma_scale_f32_16x16x128_f8f6f4((v8i_t){(int)t_[7].x, (int)t_[7].y, 0, 0, 0, 0, 0, 0}, wb, (f32x4){0.f, 0.f, 0.f, 0.f}, 4, 0, 0, 0x7F7F7F7F, 0, wsc);
        }
        if (!last) { u32x4 idn; PV_RD_IDS(idn, 0, par ^ 1); PV_ISSUE(0, idn); }
        if (last) asm volatile("s_waitcnt vmcnt(0)" ::: "memory"); else asm volatile("s_waitcnt vmcnt(8)" ::: "memory");
        { u32x2 t_[8];
        asm volatile("ds_read_b64_tr_b4 %0, %1 offset:%2" : "=v"(t_[0]) : "v"(adr[0]), "n"(1*8192 + 0));
        asm volatile("ds_read_b64_tr_b4 %0, %1 offset:%2" : "=v"(t_[1]) : "v"(adr[0]), "n"(1*8192 + 8));
        asm volatile("ds_read_b64_tr_b4 %0, %1 offset:%2" : "=v"(t_[2]) : "v"(adr[1]), "n"(1*8192 + 0));
        asm volatile("ds_read_b64_tr_b4 %0, %1 offset:%2" : "=v"(t_[3]) : "v"(adr[1]), "n"(1*8192 + 8));
        asm volatile("ds_read_b64_tr_b4 %0, %1 offset:%2" : "=v"(t_[4]) : "v"(adr[2]), "n"(1*8192 + 0));
        asm volatile("ds_read_b64_tr_b4 %0, %1 offset:%2" : "=v"(t_[5]) : "v"(adr[2]), "n"(1*8192 + 8));
        asm volatile("ds_read_b64_tr_b4 %0, %1 offset:%2" : "=v"(t_[6]) : "v"(adr[3]), "n"(1*8192 + 0));
        asm volatile("ds_read_b64_tr_b4 %0, %1 offset:%2" : "=v"(t_[7]) : "v"(adr[3]), "n"(1*8192 + 8));
        asm volatile("s_waitcnt lgkmcnt(6)" : "+v"(t_[0]), "+v"(t_[1])); asm volatile("s_waitcnt lgkmcnt(4)" : "+v"(t_[2]), "+v"(t_[3]));
        asm volatile("s_waitcnt lgkmcnt(2)" : "+v"(t_[4]), "+v"(t_[5])); asm volatile("s_waitcnt lgkmcnt(0)" : "+v"(t_[6]), "+v"(t_[7]));
        acc[0] = __builtin_amdgcn_mfma_scale_f32_16x16x128_f8f6f4((v8i_t){0, 0, (int)t_[0].x, (int)t_[0].y, 0, 0, 0, 0}, wb, acc[0], 4, 0, 0, 0x7F7F7F7F, 0, wsc);
        acc[1] = __builtin_amdgcn_mfma_scale_f32_16x16x128_f8f6f4((v8i_t){0, 0, (int)t_[1].x, (int)t_[1].y, 0, 0, 0, 0}, wb, acc[1], 4, 0, 0, 0x7F7F7F7F, 0, wsc);
        acc[2] = __builtin_amdgcn_mfma_scale_f32_16x16x128_f8f6f4((v8i_t){0, 0, (int)t_[2].x, (int)t_[2].y, 0, 0, 0, 0}, wb, acc[2], 4, 0, 0, 0x7F7F7F7F, 0, wsc);
        acc[3] = __builtin_amdgcn_mfma_scale_f32_16x16x128_f8f6f4((v8i_t){0, 0, (int)t_[3].x, (int)t_[3].y, 0, 0, 0, 0}, wb, acc[3], 4, 0, 0, 0x7F7F7F7F, 0, wsc);
        acc[4] = __builtin_amdgcn_mfma_scale_f32_16x16x128_f8f6f4((v8i_t){0, 0, (int)t_[4].x, (int)t_[4].y, 0, 0, 0, 0}, wb, acc[4], 4, 0, 0, 0x7F7F7F7F, 0, wsc);
        acc[5] = __builtin_amdgcn_mfma_scale_f32_16x16x128_f8f6f4((v8i_t){0, 0, (int)t_[5].x, (int)t_[5].y, 0, 0, 0, 0}, wb, acc[5], 4, 0, 0, 0x7F7F7F7F, 0, wsc);
        acc[6] = __builtin_amdgcn_mfma_scale_f32_16x16x128_f8f6f4((v8i_t){0, 0, (int)t_[6].x, (int)t_[6].y, 0, 0, 0, 0}, wb, acc[6], 4, 0, 0, 0x7F7F7F7F, 0, wsc);
        acc[7] = __builtin_amdgcn_mfma_scale_f32_16x16x128_f8f6f4((v8i_t){0, 0, (int)t_[7].x, (int)t_[7].y, 0, 0, 0, 0}, wb, acc[7], 4, 0, 0, 0x7F7F7F7F, 0, wsc);
        asm volatile("ds_read_b64_tr_b4 %0, %1 offset:%2" : "=v"(t_[0]) : "v"(adr[4]), "n"(1*8192 + 0));
        asm volatile("ds_read_b64_tr_b4 %0, %1 offset:%2" : "=v"(t_[1]) : "v"(adr[4]), "n"(1*8192 + 8));
        asm volatile("ds_read_b64_tr_b4 %0, %1 offset:%2" : "=v"(t_[2]) : "v"(adr[5]), "n"(1*8192 + 0));
        asm volatile("ds_read_b64_tr_b4 %0, %1 offset:%2" : "=v"(t_[3]) : "v"(adr[5]), "n"(1*8192 + 8));
        asm volatile("ds_read_b64_tr_b4 %0, %1 offset:%2" : "=v"(t_[4]) : "v"(adr[6]), "n"(1*8192 + 0));
        asm volatile("ds_read_b64_tr_b4 %0, %1 offset:%2" : "=v"(t_[5]) : "v"(adr[6]), "n"(1*8192 + 8));
        asm volatile("ds_read_b64_tr_b4 %0, %1 offset:%2" : "=v"(t_[6]) : "v"(adr[7]), "n"(1*8192 + 0));
        asm volatile("ds_read_b64_tr_b4 %0, %1 offset:%2" : "=v"(t_[7]) : "v"(adr[7]), "n"(1*8192 + 8));
        asm volatile("s_waitcnt lgkmcnt(6)" : "+v"(t_[0]), "+v"(t_[1])); asm volatile("s_waitcnt lgkmcnt(4)" : "+v"(t_[2]), "+v"(t_[3]));
        asm volatile("s_waitcnt lgkmcnt(2)" : "+v"(t_[4]), "+v"(t_[5])); asm volatile("s_waitcnt lgkmcnt(0)" : "+v"(t_[6]), "+v"(t_[7]));
        acc[8] = __builtin_amdgcn_mfma_scale_f32_16x16x128_f8f6f4((v8i_t){0, 0, (int)t_[0].x, (int)t_[0].y, 0, 0, 0, 0}, wb, acc[8], 4, 0, 0, 0x7F7F7F7F, 0, wsc);
        acc[9] = __builtin_amdgcn_mfma_scale_f32_16x16x128_f8f6f4((v8i_t){0, 0, (int)t_[1].x, (int)t_[1].y, 0, 0, 0, 0}, wb, acc[9], 4, 0, 0, 0x7F7F7F7F, 0, wsc);
        acc[10] = __builtin_amdgcn_mfma_scale_f32_16x16x128_f8f6f4((v8i_t){0, 0, (int)t_[2].x, (int)t_[2].y, 0, 0, 0, 0}, wb, acc[10], 4, 0, 0, 0x7F7F7F7F, 0, wsc);
        acc[11] = __builtin_amdgcn_mfma_scale_f32_16x16x128_f8f6f4((v8i_t){0, 0, (int)t_[3].x, (int)t_[3].y, 0, 0, 0, 0}, wb, acc[11], 4, 0, 0, 0x7F7F7F7F, 0, wsc);
        acc[12] = __builtin_amdgcn_mfma_scale_f32_16x16x128_f8f6f4((v8i_t){0, 0, (int)t_[4].x, (int)t_[4].y, 0, 0, 0, 0}, wb, acc[12], 4, 0, 0, 0x7F7F7F7F, 0, wsc);
        acc[13] = __builtin_amdgcn_mfma_scale_f32_16x16x128_f8f6f4((v8i_t){0, 0, (int)t_[5].x, (int)t_[5].y, 0, 0, 0, 0}, wb, acc[13], 4, 0, 0, 0x7F7F7F7F, 0, wsc);
        acc[14] = __builtin_amdgcn_mfma_scale_f32_16x16x128_f8f6f4((v8i_t){0, 0, (int)t_[6].x, (int)t_[6].y, 0, 0, 0, 0}, wb, acc[14], 4, 0, 0, 0x7F7F7F7F, 0, wsc);
        acc[15] = __builtin_amdgcn_mfma_scale_f32_16x16x128_f8f6f4((v8i_t){0, 0, (int)t_[7].x, (int)t_[7].y, 0, 0, 0, 0}, wb, acc[15], 4, 0, 0, 0x7F7F7F7F, 0, wsc);
        }
        { f32x4 o = acc[0];
#pragma unroll
          for (int cg = 1; cg < 16; ++cg) { const bool sel = (idx == cg); o[0] = sel ? acc[cg][0] : o[0]; o[1] = sel ? acc[cg][1] : o[1]; o[2] = sel ? acc[cg][2] : o[2]; o[3] = sel ? acc[cg][3] : o[3]; }
          asm volatile("" : "+v"(o));
          u32x2 ov; ov.x = pk2(o[0], o[1]); ov.y = pk2(o[2], o[3]);
          *(u32x2*)(fbuf + (size_t)row * D + slice * 256 + 16 * idx + 4 * g) = ov; }
        if (!last) { u32x4 idn; PV_RD_IDS(idn, 1, par ^ 1); PV_DMA_WB(row + 1, par ^ 1); PV_DMA_IDS(row + (ti + 2 < NTW ? 2 : 1), par); PV_ISSUE(1, idn); }
    }
#undef PV_DMA_IDS
#undef PV_DMA_WB
#undef PV_RD_IDS
#undef PV_ISSUE
}

struct Ln2In { TRow t; u32x2 f[4]; };
__device__ __forceinline__ void ln2_load(Ln2In& I, int row, int lane, const bf16_t* fbuf, const bf16_t* tb) {
    trow_load(I.t, row, lane, tb); const bf16_t* fp = fbuf + (size_t)row * D;
#pragma unroll
    for (int j = 0; j < 4; ++j) I.f[j] = *(const u32x2*)(fp + j * 256 + lane * 4);
}
__device__ __forceinline__ float ln2_row(f32x4 (&v)[4], const Ln2In& I, int row, int lane, const f32x4 (&l1g)[4], const f32x4 (&l1b)[4], const f32x4 (&g2)[4], const f32x4 (&lg)[4], const f32x4 (&lb)[4], float* x2f, bf16_t* x2b, float* x2c) {
    float sm = 0.f;
    (void)ln1_apply(v, I.t, l1g, l1b);
#pragma unroll
    for (int j = 0; j < 4; ++j) { const u32x2 fw = I.f[j]; const f32x4 f = (f32x4){bflo(fw.x), bfhi(fw.x), bflo(fw.y), bfhi(fw.y)};
        v[j] = v[j] * ALPHA + g2[j] * f; sm += (v[j][0] + v[j][1]) + (v[j][2] + v[j][3]); }
    const float mu = wave_sum(sm) * (1.0f / 1024.0f); float q = 0.f;
#pragma unroll
    for (int j = 0; j < 4; ++j) { v[j] = v[j] - mu; q += (v[j][0] * v[j][0] + v[j][1] * v[j][1]) + (v[j][2] * v[j][2] + v[j][3] * v[j][3]); }
    const float rstd = 1.0f / sqrtf(wave_sum(q) * (1.0f / 1024.0f) + EPS);
    sm = 0.f;
#pragma unroll
    for (int j = 0; j < 4; ++j) { v[j] = v[j] * rstd * lg[j] + lb[j]; row_store(v[j], row, j * 256 + lane * 4, x2f, x2b, x2c); sm += (v[j][0] + v[j][1]) + (v[j][2] + v[j][3]); }
    return sm;
}
#ifndef MK_SINGLE
#define MK_SINGLE 1
#endif
__global__ void __launch_bounds__(NTHREADS, 2) mk_fwd(Params P) {
    extern __shared__ __attribute__((aligned(16))) unsigned char lds_raw[];
    Frame F;
    F.lds = (LAS unsigned char*)lds_raw;
    F.tid = threadIdx.x; F.lane = F.tid & 63; F.wave = __builtin_amdgcn_readfirstlane(F.tid >> 6);
    F.G = gridDim.x; { const int bx = blockIdx.x; F.vcu = (F.G % 8 == 0) ? (bx % 8) * (F.G / 8) + bx / 8 : bx; }
    volatile LAS unsigned* MISC = (volatile LAS unsigned*)(F.lds + MISC_OFF);
    for (int u = F.tid; u < (LDS_BYTES - MISC_OFF) / 4; u += NTHREADS) MISC[u] = 0u;
    __syncthreads();
    unsigned char* ws = P.ws;
    unsigned* ctl = (unsigned*)(ws + WS_CTL);
    XcdBarrier bar; bar.bar = ctl + CW_BAR; bar.x = 0; bar.st = nullptr;
    if (P.ph_hi - P.ph_lo > 1) bar = xcd_barrier_post(ctl + CW_BAR, MISC + 8);

    const float* x = P.in[0]; const float* c = P.in[1]; const float* ctxin = P.in[2]; const float* c_ctx = P.in[3]; const float* w_mod = P.in[4]; const float* b_mod = P.in[5];
    const float* w_in = P.in[6]; const float* q_norm_g = P.in[7]; const float* k_norm_g = P.in[8]; const float* gmlp_ln_g = P.in[9]; const float* gmlp_ln_b = P.in[10];
    const float* gmlp_w_s = P.in[11]; const float* gmlp_b_s = P.in[12]; const float* conv_w_dw = P.in[13]; const float* conv_b_dw = P.in[14]; const float* conv_ln_g = P.in[15];
    const float* conv_ln_b = P.in[16]; const float* conv_w_pw = P.in[17]; const float* conv_b_pw = P.in[18]; const float* w_out = P.in[19]; const float* ln1_g = P.in[20];
    const float* ln1_b = P.in[21]; const float* ln2_g = P.in[22]; const float* ln2_b = P.in[23]; const float* peer_w_q = P.in[24]; const float* peer_sk = P.in[25];
    const float* peer_u = P.in[26]; const float* peer_v = P.in[27];
    float* out = P.out;
    float* mod = (float*)(ws + WS_MOD); float* rope = (float*)(ws + WS_ROPE); float* bout = (float*)(ws + WS_BOUT);
    bf16_t* Win_t = (bf16_t*)(ws + WS_WIN_T); bf16_t* Wout_t = (bf16_t*)(ws + WS_WOUT_T); bf16_t* Ws_t = (bf16_t*)(ws + WS_WS_T); bf16_t* gws = (bf16_t*)(ws + WS_GWS);
    float* xc1 = (float*)(ws + WS_XC1); float* xc2 = (float*)(ws + WS_XC2);
    unsigned char* u8 = ws + WS_U8; unsigned char* v8 = ws + WS_V8;
    bf16_t* hbuf = (bf16_t*)(ws + WS_H); bf16_t* qbuf = (bf16_t*)(ws + WS_Q); bf16_t* kvbuf = (bf16_t*)(ws + WS_KV); bf16_t* zgbuf = (bf16_t*)(ws + WS_ZG); bf16_t* ycbuf = (bf16_t*)(ws + WS_YC);
    bf16_t* mix = (bf16_t*)(ws + WS_MIX); bf16_t* ybuf = (bf16_t*)(ws + WS_Y); unsigned short* sbuf = (unsigned short*)(ws + WS_S);
    bf16_t* pact = (bf16_t*)(ws + WS_PACT); bf16_t* fbuf = (bf16_t*)(ws + WS_F); unsigned short* tk_idx = (unsigned short*)(ws + WS_TKI); float* tk_gate = (float*)(ws + WS_TKG); unsigned char* w8buf = ws + WS_W; unsigned* wscbuf = (unsigned*)(ws + WS_W + 8 * MiB); unsigned char* h8buf = ws + WS_H8; bf16_t* x2b = (bf16_t*)out;

    const P0Ptrs PP{c, c_ctx, w_mod, b_mod, peer_w_q, peer_sk, conv_w_pw, conv_b_pw, w_out, w_in, peer_u, peer_v, mod, bout, Ws_t, Wout_t, Win_t, u8, v8};
    const int lo = P.ph_lo, hi = P.ph_hi;
#ifdef PROBE_MASK
    unsigned long long probe_acc = 0ull, probe_t0 = 0ull;
#define PROBE_BEGIN(k) do { if ((PROBE_MASK >> (k)) & 1) { __syncthreads(); probe_t0 = __builtin_amdgcn_s_memrealtime(); } } while (0)
#define PROBE_END(k) do { if ((PROBE_MASK >> (k)) & 1) { __syncthreads(); probe_acc += __builtin_amdgcn_s_memrealtime() - probe_t0; } } while (0)
#else
#define PROBE_BEGIN(k) do {} while (0)
#define PROBE_END(k) do {} while (0)
#endif
#define IN(k) (lo <= (k) && (k) < hi)
#define SEAM(k) do { if (IN(k) && IN((k) + 1)) xcd_barrier(bar); } while (0)
    const int gw = F.vcu * NWAVES + F.wave, NGW = F.G * NWAVES;
    const int gt = gw * 64 + F.lane, NGT = NGW * 64;

    PROBE_BEGIN(0);
    if (IN(0)) {
#ifndef NO_P0
        p0_block_items(F, PP, 0, 7, F.vcu, F.G);
        p0_wave_transposes(F, PP, 0, gw, NGW);
        for (int i = gt; i < 2048; i += NGT) { const int pos = i >> 4, f = i & 15; const double a = (double)pos * exp(-(double)f * (9.210340371976184 / 16.0)); rope[i * 2] = (float)cos(a); rope[i * 2 + 1] = (float)sin(a); }
        for (int i = gt; i < 2 * 4 * 128 * 128 / 2; i += NGT) { const f32x2 v = *(const f32x2*)(gmlp_w_s + (size_t)i * 2); ((unsigned*)gws)[i] = pk2(v[0], v[1]); }
        p0_convert_tables(PP, 0, gt, NGT);
        __syncthreads();
#endif
    }
    SEAM(0);
    PROBE_END(0);
    PROBE_BEGIN(1);
    if (IN(1)) {
#pragma unroll 1
        for (int ch = gw; ch < ML / 16; ch += NGW) {
            const int r0 = ch * 16; const float* mp = mod + (size_t)modid(r0) * 6144;
            f32x4 sh[4], sc[4]; load_par(sh, mp, F.lane); load_par(sc, mp + 1024, F.lane);
#pragma unroll 1
            for (int tr = 0; tr < 4; ++tr) {
                f32x4 xv[4][4];
#pragma unroll
                for (int k = 0; k < 4; ++k) { const float* xp = x + (size_t)(r0 + tr * 4 + k) * D;
#pragma unroll
                    for (int j = 0; j < 4; ++j) xv[k][j] = *(const f32x4*)(xp + j * 256 + F.lane * 4); }
#pragma unroll
                for (int k = 0; k < 4; ++k) { float s = 0.f;
#pragma unroll
                    for (int j = 0; j < 4; ++j) s += (xv[k][j][0] + xv[k][j][1]) + (xv[k][j][2] + xv[k][j][3]);
                    adaln_store(xv[k], s, sh, sc, hbuf + (size_t)(r0 + tr * 4 + k) * D, F.lane); }
            }
        }
#pragma unroll 1
        for (int row = ML + gw; row < MT; row += NGW) {
            const float* mp = mod + (size_t)4 * 6144; f32x4 sh[4], sc[4], xv[4]; load_par(sh, mp, F.lane); load_par(sc, mp + 1024, F.lane); load_par(xv, ctxin + (size_t)(row - ML) * D, F.lane);
            float s = 0.f;
#pragma unroll
            for (int j = 0; j < 4; ++j) s += (xv[j][0] + xv[j][1]) + (xv[j][2] + xv[j][3]);
            adaln_store(xv, s, sh, sc, hbuf + (size_t)row * D, F.lane);
        }
    }
    SEAM(1);
    PROBE_END(1);

    for (int l = 0; l < 2; ++l) {
        const int pb = 2 + 10 * l;
#define LAUNDER() do { int t_ = threadIdx.x; asm volatile("" : "+v"(t_)); F.tid = t_; F.lane = t_ & 63; } while (0)
        const float* modl = mod + (size_t)l * 5 * 6144;
        const float* xl = l == 0 ? x : out; const float* xc = l == 0 ? ctxin : xc2;
        const int nr = l == 0 ? MT : ML;
        PROBE_BEGIN(2);
        if (IN(pb)) {
            LAUNDER();
#ifndef NO_A
            pg8::Gemm g{hbuf, Win_t + (size_t)l * INW * 1024, MT, INW, 1024}; pg8::StaticOrder S; S.init(MT, INW, F.G, (int)blockIdx.x);
            pg8::EpiInProj E{qbuf, kvbuf, zgbuf, ycbuf, q_norm_g + l * 64, k_norm_g + l * 64, rope};
            pg8::gemm_phase<pg8::EpiInProj, pg8::StaticOrder, true, true>(F.lds, g, S, E);
#endif
        }
        SEAM(pb);
        PROBE_END(2);
        PROBE_BEGIN(3);
        if (IN(pb + 1)) {
            LAUNDER();
#ifndef NO_ATT
            for (int u0 = F.vcu * 4; u0 < 1024; u0 += F.G * 4)
                for (int i = 0; i < 4; ++i) { const int u = u0 + i, gi = u >> 7, qb = (u & 127) >> 2, b = gi >> 1, g = gi & 1, hq = g * 4 + (u & 3);
                    const size_t row0 = (size_t)b * SEQ + qb * 256;
                    attn_body::attn_unit<8>((const attn_body::bf16*)(qbuf + row0 * 512 + hq * 64), (const attn_body::bf16*)(kvbuf + (size_t)b * KVSEQ * 256 + g * 64),
                                            (const attn_body::bf16*)(kvbuf + (size_t)b * KVSEQ * 256 + 128 + g * 64), (attn_body::bf16*)(mix + row0 * 1024 + hq * 64), KVSEQ / 64, (char*)lds_raw); }
            if (l == 0)
                for (int u = F.vcu; u < 32; u += F.G) { const int b = u >> 3, hq = u & 7, g = hq >> 2; const size_t row0 = (size_t)ML + b * CTXL;
                    attn_body::attn_unit<8>((const attn_body::bf16*)(qbuf + row0 * 512 + hq * 64), (const attn_body::bf16*)(kvbuf + (size_t)b * KVSEQ * 256 + g * 64),
                                            (const attn_body::bf16*)(kvbuf + (size_t)b * KVSEQ * 256 + 128 + g * 64), (attn_body::bf16*)(mix + row0 * 1024 + hq * 64), CTXL / 64, (char*)lds_raw); }
#endif
            __syncthreads();
            PROBE_BEGIN(12);
#ifndef NO_GMLP
            for (int ch = F.vcu; ch < nr / 128; ch += F.G)
                gmlp_chunk(F, ch, zgbuf, gmlp_ln_g + l * 256, gmlp_ln_b + l * 256, gws + (size_t)l * 4 * 128 * 128, gmlp_b_s + l * 512, mix);
#endif
#ifndef NO_CONV
            for (int tl = (F.vcu < F.G / 2 ? F.vcu + F.G / 2 : F.vcu - F.G / 2); tl < nr / 128; tl += F.G)
                conv_tile(F, tl, ycbuf, conv_w_dw + l * 31 * 256, conv_b_dw + l * 256, conv_ln_g + l * 256, conv_ln_b + l * 256, mix);
#endif
            PROBE_END(12);
            __syncthreads();
        }
        SEAM(pb + 1);
        PROBE_END(3);
        PROBE_BEGIN(4);
        if (IN(pb + 2)) {
            LAUNDER();
            pg8::Gemm g{mix, Wout_t + (size_t)l * 1024 * 1024, nr, 1024, 1024}; pg8::StaticOrder S; S.init(nr, 1024, F.G, (int)blockIdx.x);
            pg8::EpiResid E{ybuf, bout + l * 1024, modl, x, l == 0 ? (const bf16_t*)nullptr : (const bf16_t*)x2b, xc};
#ifndef NO_GF32
            pg8::gemm_phase<pg8::EpiResid, pg8::StaticOrder, true, true>(F.lds, g, S, E);
#endif
            if (l == 0) { int nw; const int w = idle_worker((nr / 256) * 4, F.G, (int)blockIdx.x, nw); if (w >= 0) { LAUNDER(); p0_block_items(F, PP, 1, 2, w, nw); } }
        }
        SEAM(pb + 2);
        PROBE_END(4);
        PROBE_BEGIN(5);
        if (IN(pb + 3)) { LAUNDER();
            const int w0 = F.vcu * NWAVES + __builtin_amdgcn_readfirstlane(F.tid >> 6);
            f32x4 lg[4], lb[4]; load_par(lg, ln1_g + l * 1024, F.lane); load_par(lb, ln1_b + l * 1024, F.lane);
#pragma unroll 1
            for (int ch = w0; ch < ML / 16; ch += NGW) {
                const int r0 = ch * 16; const float* mp = modl + (size_t)modid(r0) * 6144;
                f32x4 sh[4], sc[4]; load_par(sh, mp + 3072, F.lane); load_par(sc, mp + 4096, F.lane);
#pragma unroll 1
                for (int tr = 0; tr < 4; ++tr) {
                    TRow in4[4];
#pragma unroll
                    for (int k = 0; k < 4; ++k) trow_load(in4[k], r0 + tr * 4 + k, F.lane, ybuf);
#pragma unroll
                    for (int k = 0; k < 4; ++k) { f32x4 v[4]; const float s = ln1_apply(v, in4[k], lg, lb); adaln_store(v, s, sh, sc, hbuf + (size_t)(r0 + tr * 4 + k) * D, F.lane, h8buf + (size_t)(r0 + tr * 4 + k) * D); }
                }
                        }
#pragma unroll 1
            for (int row = ML + w0; row < nr; row += NGW) {
                const float* mp = modl + (size_t)4 * 6144; f32x4 sh[4], sc[4]; load_par(sh, mp + 3072, F.lane); load_par(sc, mp + 4096, F.lane);
                TRow in1; trow_load(in1, row, F.lane, ybuf); f32x4 v[4]; const float s = ln1_apply(v, in1, lg, lb); adaln_store(v, s, sh, sc, hbuf + (size_t)row * D, F.lane, h8buf + (size_t)row * D);
            } }
        SEAM(pb + 3);
        PROBE_END(5);
        PROBE_BEGIN(6);
        if (IN(pb + 4)) {
            LAUNDER();
            pg8::Gemm g{hbuf, Ws_t + (size_t)l * 2048 * 1024, nr, 2048, 1024}; pg8::StaticOrder S; S.init(nr, 2048, F.G, (int)blockIdx.x);
#ifdef TK_F32
            pg8::EpiF32 E{(float*)sbuf, 2048, nullptr};
            pg8::gemm_phase<pg8::EpiF32, pg8::StaticOrder, true, true>(F.lds, g, S, E);
#else
            pg8::EpiF16 E{sbuf, 2048};
#ifndef NO_GF32
            pg8::gemm_phase<pg8::EpiF16, pg8::StaticOrder, true, true>(F.lds, g, S, E);
#endif
#ifndef TK_F32
            if (l == 0) { int nw; const int w = idle_worker((nr / 256) * 8, F.G, (int)blockIdx.x, nw);
                if (w >= 0) { LAUNDER(); p0_block_items(F, PP, 1, 5, w, nw); p0_wave_transposes(F, PP, 1, w * NWAVES + F.wave, nw * NWAVES); p0_convert_tables(PP, 1, w * NTHREADS + F.tid, nw * NTHREADS); __syncthreads(); } }
#endif
#endif
        }
        SEAM(pb + 4);
        PROBE_END(6);
        PROBE_BEGIN(7);
        if (IN(pb + 5)) {
            LAUNDER();
#ifndef NO_PEER
            peer_topk_wave(F, gw, nr / 4, NGW, sbuf, tk_idx, tk_gate);
#endif
        }
        SEAM(pb + 5);
        PROBE_END(7);
        PROBE_BEGIN(8);
        if (IN(pb + 6)) {
            LAUNDER();
#ifndef NO_PEER
            const int own = (int)(xb_xcc_id() & 7u) >> 1;
            for (int so = 0; so < 4; ++so) { const int slice = (own + so) & 3; unsigned* qw = ctl + CW_Q + ((l * 2 + 0) * 8 + slice) * 64;
                for (;;) { const int item = q_next(F, qw); const unsigned char* ut = u8 + ((size_t)l * 4 + slice) * 16384 * 128;
                    if (item < ML / 512) peer_u_item<64>(F, 0, item, slice, h8buf, tk_idx, ut, pact);
                    else if (item < ML / 512 + (nr - ML) / 16) peer_u_item<2>(F, ML, item - ML / 512, slice, h8buf, tk_idx, ut, pact);
                    else break; } }
#endif
        }
        SEAM(pb + 6);
        PROBE_END(8);
        PROBE_BEGIN(9);
        if (IN(pb + 7)) {
            LAUNDER();
#ifndef NO_PEER
            const int gt2 = F.vcu * NTHREADS + F.tid;
            for (int i = gt2; i < nr * 32; i += NGT) {
                f32x4 a = (f32x4){0.f, 0.f, 0.f, 0.f};
#pragma unroll
                for (int sl = 0; sl < 4; ++sl) { const u32x2 pw = *(const u32x2*)(pact + ((size_t)sl * MT * 128) + (size_t)i * 4); a = a + (f32x4){bflo(pw.x), bfhi(pw.x), bflo(pw.y), bfhi(pw.y)}; }
                const f32x4 g = *(const f32x4*)(tk_gate + (size_t)i * 4);
                f32x4 w;
#pragma unroll
                for (int e = 0; e < 4; ++e) w[e] = g[e] * gelu_tanh(a[e] * (1.0f / (U_SCALE * H_SCALE))) * (1.0f / V_SCALE);
                float mx = fmaxf(fmaxf(fabsf(w[0]), fabsf(w[1])), fmaxf(fabsf(w[2]), fabsf(w[3])));
                mx = fmaxf(mx, dpp_f<0xB1>(mx)); mx = fmaxf(mx, dpp_f<0x4E>(mx)); mx = fmaxf(mx, dpp_f<0x141>(mx)); mx = fmaxf(mx, dpp_f<0x140>(mx)); mx = fmaxf(mx, xchg16(mx, F.lane & 16));
                int ex = (int)((__float_as_uint(mx) >> 23) & 255u) - 127; ex = ex < -100 ? -100 : ex;
                const float sc = __uint_as_float((unsigned)(134 - ex) << 23);
                int pw8 = 0; pw8 = __builtin_amdgcn_cvt_pk_fp8_f32(w[0] * sc, w[1] * sc, pw8, false); pw8 = __builtin_amdgcn_cvt_pk_fp8_f32(w[2] * sc, w[3] * sc, pw8, true);
                *(unsigned*)(w8buf + (size_t)i * 4) = (unsigned)pw8;
                if ((i & 31) == 0) wscbuf[i >> 5] = 0x01010101u * (unsigned)(ex + 120);
            }
#endif
        }
        SEAM(pb + 7);
        PROBE_END(9);
        PROBE_BEGIN(10);
        if (IN(pb + 8)) {
            LAUNDER();
#ifndef NO_PEER
            const int own = (int)(xb_xcc_id() & 7u) >> 1;
            for (int so = 0; so < 4; ++so) { const int slice = (own + so) & 3; unsigned* qw = ctl + CW_Q + ((l * 2 + 1) * 8 + slice) * 64;
                for (;;) { const int item = q_next(F, qw); const unsigned char* vt = v8 + ((size_t)l * 4 + slice) * 16384 * 128;
                    if (item < ML / 512) peer_v_item<64>(F, 0, item, slice, tk_idx, w8buf, wscbuf, vt, fbuf);
                    else if (item < ML / 512 + (nr - ML) / 16) peer_v_item<2>(F, ML, item - ML / 512, slice, tk_idx, w8buf, wscbuf, vt, fbuf);
                    else break; } }
#endif
        }
        SEAM(pb + 8);
        PROBE_END(10);
        PROBE_BEGIN(11);
        if (IN(pb + 9)) { LAUNDER();
            const int w0 = F.vcu * NWAVES + __builtin_amdgcn_readfirstlane(F.tid >> 6);
            f32x4 l1g[4], l1b[4], lg[4], lb[4];
            load_par(l1g, ln1_g + l * 1024, F.lane); load_par(l1b, ln1_b + l * 1024, F.lane); load_par(lg, ln2_g + l * 1024, F.lane); load_par(lb, ln2_b + l * 1024, F.lane);
            const float* modn = l == 0 ? mod + (size_t)5 * 6144 : (const float*)nullptr;
#pragma unroll 1
            for (int ch = w0; ch < ML / 16; ch += NGW) {
                const int r0 = ch * 16; const int mi = modid(r0);
                f32x4 g2[4]; load_par(g2, modl + (size_t)mi * 6144 + 5120, F.lane);
#pragma unroll 1
                for (int tr = 0; tr < 8; ++tr) {
                    Ln2In in2[2];
#pragma unroll
                    for (int k = 0; k < 2; ++k) ln2_load(in2[k], r0 + tr * 2 + k, F.lane, fbuf, ybuf);
#pragma unroll
                    for (int k = 0; k < 2; ++k) { const int row = r0 + tr * 2 + k; f32x4 v[4];
                        const float s = ln2_row(v, in2[k], row, F.lane, l1g, l1b, g2, lg, lb, out, l == 0 ? x2b : (bf16_t*)nullptr, xc2);
                        if (modn) { f32x4 shn[4], scn[4]; load_par(shn, modn + (size_t)mi * 6144, F.lane); load_par(scn, modn + (size_t)mi * 6144 + 1024, F.lane); asm volatile("" ::: "memory");
                            adaln_store(v, s, shn, scn, hbuf + (size_t)row * D, F.lane); } }
                }
                        }
#pragma unroll 1
            for (int row = ML + w0; row < nr; row += NGW) {
                f32x4 g2[4]; load_par(g2, modl + (size_t)4 * 6144 + 5120, F.lane);
                Ln2In in1; ln2_load(in1, row, F.lane, fbuf, ybuf); f32x4 v[4];
                const float s = ln2_row(v, in1, row, F.lane, l1g, l1b, g2, lg, lb, out, (bf16_t*)nullptr, xc2);
                if (modn) { f32x4 shn[4], scn[4]; load_par(shn, modn + (size_t)4 * 6144, F.lane); load_par(scn, modn + (size_t)4 * 6144 + 1024, F.lane); adaln_store(v, s, shn, scn, hbuf + (size_t)row * D, F.lane); }
            } }
        SEAM(pb + 9);
        PROBE_END(11);
    }
#ifdef PROBE_MASK
    if (blockIdx.x == 0 && threadIdx.x == 0) { const unsigned long long t1 = __builtin_amdgcn_s_memrealtime(); while (__builtin_amdgcn_s_memrealtime() - t1 < (unsigned long long)PROBE_MULT * probe_acc) __builtin_amdgcn_s_sleep(32); }
#endif
#undef IN
#undef SEAM
}

extern "C" void kernel_launch(void* const* d_in, const int* in_sizes, int n_in, void* d_out, int out_size, void* d_ws, size_t ws_size, hipStream_t stream) {
    static int grid = 0;
    if (grid == 0) {
        int dev = 0, cus = 0;
        if (n_in != 28 || ws_size < WS_END) { fprintf(stderr, "kernel_launch: unexpected n_in %d / ws_size %zu (need %zu)\n", n_in, ws_size, (size_t)WS_END); grid = -1; return; }
        if (hipGetDevice(&dev) != hipSuccess || hipDeviceGetAttribute(&cus, hipDeviceAttributeMultiprocessorCount, dev) != hipSuccess) { grid = -1; return; }
        if (hipFuncSetAttribute((const void*)mk_fwd, hipFuncAttributeMaxDynamicSharedMemorySize, LDS_BYTES) != hipSuccess) { fprintf(stderr, "kernel_launch: hipFuncSetAttribute failed\n"); grid = -1; return; }
        int per_cu = 0;
        if (hipOccupancyMaxActiveBlocksPerMultiprocessor(&per_cu, (const void*)mk_fwd, NTHREADS, LDS_BYTES) != hipSuccess || per_cu < 1) { fprintf(stderr, "kernel_launch: occupancy query says %d\n", per_cu); }
        (void)hipGetLastError();
        grid = cus;
    }
    if (grid < 0) return;
    (void)hipMemsetAsync((char*)d_ws + WS_CTL, 0, CTL_ZERO_BYTES, stream);
    Params p{};
    for (int i = 0; i < 28; ++i) p.in[i] = (const float*)d_in[i];
    p.out = (float*)d_out; p.ws = (unsigned char*)d_ws;
#if MK_SINGLE
    p.ph_lo = 0; p.ph_hi = N_PHASES;
    hipLaunchKernelGGL(mk_fwd, dim3(grid), dim3(NTHREADS), LDS_BYTES, stream, p);
#else
    for (int ph = 0; ph < N_PHASES; ++ph) { p.ph_lo = ph; p.ph_hi = ph + 1; hipLaunchKernelGGL(mk_fwd, dim3(grid), dim3(NTHREADS), LDS_BYTES, stream, p); }
#endif
}
```

```cpp
#include <hip/hip_runtime.h>
#include <hip/hip_bf16.h>
#include <cstdio>
#include <cstdint>

#define GAS __attribute__((address_space(1)))
#define LAS __attribute__((address_space(3)))

namespace cfg {
constexpr int D = 1024, NB = 4, SEQ = 8192, CTXL = 256;
constexpr int ML = NB * SEQ, MC = NB * CTXL, MT = ML + MC;
constexpr int KVSEQ = CTXL + SEQ;
constexpr int INW = 1792;
constexpr float EPS = 1e-6f;
constexpr float ALPHA = 1.41421356237309515f;
constexpr float C2 = 0.125f * 1.4426950408889634f;
constexpr float U_SCALE = 64.f, V_SCALE = 4.f, H_SCALE = 8.f;
constexpr int NWAVES = 8, NTHREADS = 512;
}
using namespace cfg;

typedef unsigned short bf16_t;
typedef float f32x2 __attribute__((ext_vector_type(2)));
typedef float f32x4 __attribute__((ext_vector_type(4)));
typedef unsigned u32x2 __attribute__((ext_vector_type(2)));
typedef unsigned u32x4 __attribute__((ext_vector_type(4)));
typedef short bf16x8 __attribute__((ext_vector_type(8)));

__device__ __forceinline__ int mk_tid() { int t = threadIdx.x; asm volatile("" : "+v"(t)); return t; }
__device__ __forceinline__ unsigned f2bf(float f) { unsigned u = __builtin_bit_cast(unsigned, f); return (u + 0x7fffu + ((u >> 16) & 1u)) >> 16; }
__device__ __forceinline__ unsigned pk2(float lo, float hi) { return f2bf(lo) | (f2bf(hi) << 16); }
__device__ __forceinline__ float bflo(unsigned w) { return __uint_as_float(w << 16); }
__device__ __forceinline__ float bfhi(unsigned w) { return __uint_as_float(w & 0xffff0000u); }
__device__ __forceinline__ float fast_sigmoid(float x) { return __builtin_amdgcn_rcpf(1.0f + __builtin_amdgcn_exp2f(-1.4426950408889634f * x)); }
__device__ __forceinline__ float gelu_tanh(float x) { const float z = x * (1.0f + 0.044715f * x * x); return x * __builtin_amdgcn_rcpf(1.0f + __builtin_amdgcn_exp2f(-2.302208198f * z)); }
template <int CTRL> __device__ __forceinline__ float dpp_f(float v) { return __builtin_bit_cast(float, __builtin_amdgcn_update_dpp(0, __builtin_bit_cast(int, v), CTRL, 0xF, 0xF, true)); }
__device__ __forceinline__ float xchg16(float v, bool odd_row) { const auto rr = __builtin_amdgcn_permlane16_swap(__float_as_uint(v), __float_as_uint(v), false, false); return __uint_as_float(odd_row ? rr[0] : rr[1]); }
__device__ __forceinline__ float xchg32(float v, bool upper) { const auto rr = __builtin_amdgcn_permlane32_swap(__float_as_uint(v), __float_as_uint(v), false, false); return __uint_as_float(upper ? rr[0] : rr[1]); }
__device__ __forceinline__ float wave_sum(float v) {
    v += dpp_f<0xB1>(v);
    v += dpp_f<0x4E>(v);
    v += dpp_f<0x141>(v);
    v += dpp_f<0x140>(v);
    const int lane = (int)__builtin_amdgcn_mbcnt_hi(~0u, __builtin_amdgcn_mbcnt_lo(~0u, 0u));
    v += xchg16(v, lane & 16);
    v += xchg32(v, lane & 32);
    return v;
}
__device__ __forceinline__ float wave_reduce16(float (&v)[16], int lane) {
    const bool b5 = lane & 32, b4 = lane & 16, b3 = lane & 8, b2 = lane & 4;
#pragma unroll
    for (int i = 0; i < 8; ++i) { const float send = b5 ? v[i] : v[i + 8], keep = b5 ? v[i + 8] : v[i]; v[i] = keep + xchg32(send, b5); }
#pragma unroll
    for (int i = 0; i < 4; ++i) { const float send = b4 ? v[i] : v[i + 4], keep = b4 ? v[i + 4] : v[i]; v[i] = keep + xchg16(send, b4); }
#pragma unroll
    for (int i = 0; i < 2; ++i) { const float send = b3 ? v[i] : v[i + 2], keep = b3 ? v[i + 2] : v[i]; v[i] = keep + dpp_f<0x128>(send); }
    { const float send = b2 ? v[0] : v[1], keep = b2 ? v[1] : v[0]; v[0] = keep + dpp_f<0x141>(send); }
    v[0] += dpp_f<0xB1>(v[0]); v[0] += dpp_f<0x4E>(v[0]);
    return v[0];
}
__device__ __forceinline__ const float* rowptr(const float* xl, const float* xc, int row) { return row < ML ? xl + (size_t)row * D : xc + (size_t)(row - ML) * D; }
__device__ __forceinline__ float* rowptr_w(float* xl, float* xc, int row) { return row < ML ? xl + (size_t)row * D : xc + (size_t)(row - ML) * D; }
__device__ __forceinline__ int modid(int row) { return row < ML ? row / SEQ : 4; }
__device__ __forceinline__ int kvrow(int row) { return row < ML ? (row / SEQ) * KVSEQ + CTXL + (row % SEQ) : ((row - ML) / CTXL) * KVSEQ + ((row - ML) % CTXL); }

namespace pg8 {
#define PG8_LAS __attribute__((address_space(3)))
constexpr int BM = 256, BK = 64, HALF = 128, HTB = HALF * BK * 2  , STAGE_BYTES = 8 * HTB, NXCD = 8, WGM = 8;

__host__ __device__ __forceinline__ int lds_byte(int r, int c) { const int st = (r >> 4) * 2 + (c >> 5), rr = r & 15, cc = c & 31, ob = rr * 64 + cc * 2; return st * 1024 + (ob ^ (((ob >> 9) & 1) << 5)); }
__host__ __device__ __forceinline__ void stage_rc(int b, int& R, int& C) { const int st = b / 1024, sb = b % 1024, swz = sb ^ (((sb >> 9) & 1) << 5); R = (st >> 1) * 16 + swz / 64; C = (st & 1) * 32 + (swz % 64) / 2; }
__host__ __device__ __forceinline__ int perm32(int rho) { const int n = rho >> 4, i = rho & 15; return 8 * (i >> 2) + 4 * n + (i & 3); }

struct Unit { int pm, pn; };
struct Gemm { const bf16_t* A; const bf16_t* Bt; int M, N, K; };

struct StaticOrder {
    int nM, nN, nwg, G, c;
    __host__ __device__ void init(int M, int N, int G_, int c_) { nM = M / BM; nN = N / BM; nwg = nM * nN; G = G_; c = c_; }
    __host__ __device__ bool next(int i, Unit& u) const {
        const long L = (long)i * G + c; if (L >= nwg) return false;
        int wgid = (int)L; { const int q = nwg / NXCD, r = nwg % NXCD, xcd = wgid % NXCD, off = wgid / NXCD; wgid = (xcd < r ? xcd * (q + 1) : r * (q + 1) + (xcd - r) * q) + off; }
        const int nig = WGM * nN, gid = wgid / nig, fm = gid * WGM, gsz = (nM - fm) < WGM ? (nM - fm) : WGM;
        u.pm = fm + ((wgid % nig) % gsz); u.pn = (wgid % nig) / gsz; return true;
    }
    __device__ __forceinline__ void a_ready(const Unit&) const {}
    __device__ __forceinline__ void done(const Unit&) const {}
};


struct EpiF32 {
    static constexpr bool PERM = false, AFTER_DRAIN = false;
    float* C; int ldc; const float* bias;
    __device__ __forceinline__ void operator()(const f32x4 (&acc)[2][2][4][2], const Unit& u, int wr, int wc, int fr, int fq) const {
        const int row0 = u.pm * BM + wr * 64 + fr, col0 = u.pn * BM + wc * 32 + 4 * fq;
        f32x4 bv[2][2];
#pragma unroll
        for (int bj = 0; bj < 2; ++bj)
#pragma unroll
            for (int n = 0; n < 2; ++n) bv[bj][n] = bias ? *(const f32x4*)(bias + col0 + bj * HALF + 16 * n) : (f32x4){0.f, 0.f, 0.f, 0.f};
#pragma unroll
        for (int ai = 0; ai < 2; ++ai)
#pragma unroll
            for (int m = 0; m < 4; ++m) { float* rowp = C + (size_t)(row0 + ai * HALF + m * 16) * ldc + col0;
#pragma unroll
                for (int bj = 0; bj < 2; ++bj)
#pragma unroll
                    for (int n = 0; n < 2; ++n) *(f32x4*)(rowp + bj * HALF + 16 * n) = acc[ai][bj][m][n] + bv[bj][n]; }
    }
};

struct EpiBf16 {
    static constexpr bool PERM = true, AFTER_DRAIN = false;
    bf16_t* C; int ldc; const float* bias;
    __device__ __forceinline__ void operator()(const f32x4 (&acc)[2][2][4][2], const Unit& u, int wr, int wc, int fr, int fq) const {
        const int row0 = u.pm * BM + wr * 64 + fr, col0 = u.pn * BM + wc * 32 + 8 * fq;
        f32x4 bv[2][2];
#pragma unroll
        for (int bj = 0; bj < 2; ++bj)
#pragma unroll
            for (int n = 0; n < 2; ++n) bv[bj][n] = bias ? *(const f32x4*)(bias + col0 + bj * HALF + 4 * n) : (f32x4){0.f, 0.f, 0.f, 0.f};
#pragma unroll
        for (int ai = 0; ai < 2; ++ai)
#pragma unroll
            for (int m = 0; m < 4; ++m) { bf16_t* rowp = C + (size_t)(row0 + ai * HALF + m * 16) * ldc + col0;
#pragma unroll
                for (int bj = 0; bj < 2; ++bj) { const f32x4 v0 = acc[ai][bj][m][0] + bv[bj][0], v1 = acc[ai][bj][m][1] + bv[bj][1];
                    u32x4 w; w.x = pk2(v0[0], v0[1]); w.y = pk2(v0[2], v0[3]); w.z = pk2(v1[0], v1[1]); w.w = pk2(v1[2], v1[3]); *(u32x4*)(rowp + bj * HALF) = w; } }
    }
};

struct EpiResid {
    static constexpr bool PERM = true, AFTER_DRAIN = false;
    bf16_t* T; const float* bias; const float* modl; const float* xf; const bf16_t* xb; const float* xc;
    __device__ __forceinline__ void operator()(const f32x4 (&acc)[2][2][4][2], const Unit& u, int wr, int wc, int fr, int fq) const {
        const int row0 = u.pm * BM + wr * 64 + fr, col0 = u.pn * BM + wc * 32 + 8 * fq;
        const bool isctx = u.pm * BM >= ML;
        const float* g1p = modl + (size_t)(isctx ? 4 : (u.pm * BM) / SEQ) * 6144 + 2048;
        f32x4 bv[2][2], gv[2][2];
#pragma unroll
        for (int bj = 0; bj < 2; ++bj)
#pragma unroll
            for (int n = 0; n < 2; ++n) { bv[bj][n] = *(const f32x4*)(bias + col0 + bj * HALF + 4 * n); gv[bj][n] = *(const f32x4*)(g1p + col0 + bj * HALF + 4 * n); }
#define RESID_OUT(ai, m, bj, x0, x1) do { const int row_ = row0 + (ai) * HALF + (m) * 16, col_ = col0 + (bj) * HALF; \
            const f32x4 v0_ = (x0) * ALPHA + gv[bj][0] * (acc[ai][bj][m][0] + bv[bj][0]), v1_ = (x1) * ALPHA + gv[bj][1] * (acc[ai][bj][m][1] + bv[bj][1]); \
            u32x4 w_; w_.x = pk2(v0_[0], v0_[1]); w_.y = pk2(v0_[2], v0_[3]); w_.z = pk2(v1_[0], v1_[1]); w_.w = pk2(v1_[2], v1_[3]); *(u32x4*)(T + (size_t)row_ * D + col_) = w_; } while (0)
        if (!isctx && xb) {
#pragma unroll
            for (int ai = 0; ai < 2; ++ai)
#pragma unroll
                for (int mh = 0; mh < 2; ++mh) {
                    u32x4 xr[2][2];
#pragma unroll
                    for (int mm = 0; mm < 2; ++mm)
#pragma unroll
                        for (int bj = 0; bj < 2; ++bj) xr[mm][bj] = *(const u32x4*)(xb + (size_t)(row0 + ai * HALF + (mh * 2 + mm) * 16) * D + col0 + bj * HALF);
#pragma unroll
                    for (int mm = 0; mm < 2; ++mm)
#pragma unroll
                        for (int bj = 0; bj < 2; ++bj) { const u32x4 w = xr[mm][bj];
                            RESID_OUT(ai, mh * 2 + mm, bj, ((f32x4){bflo(w.x), bfhi(w.x), bflo(w.y), bfhi(w.y)}), ((f32x4){bflo(w.z), bfhi(w.z), bflo(w.w), bfhi(w.w)})); }
                }
        } else {
            const float* xsrc = isctx ? xc - (size_t)ML * D : xf;
#pragma unroll
            for (int ai = 0; ai < 2; ++ai)
#pragma unroll
                for (int m = 0; m < 4; ++m) {
                    f32x4 xa[2][2];
#pragma unroll
                    for (int bj = 0; bj < 2; ++bj) { const float* p_ = xsrc + (size_t)(row0 + ai * HALF + m * 16) * D + col0 + bj * HALF; xa[bj][0] = *(const f32x4*)p_; xa[bj][1] = *(const f32x4*)(p_ + 4); }
#pragma unroll
                    for (int bj = 0; bj < 2; ++bj) RESID_OUT(ai, m, bj, xa[bj][0], xa[bj][1]);
                }
        }
#undef RESID_OUT
    }
};

typedef _Float16 f16x2_t __attribute__((ext_vector_type(2)));
__device__ __forceinline__ unsigned pkh2(float lo, float hi) { const f16x2_t h = __builtin_convertvector((f32x2){lo, hi}, f16x2_t); return __builtin_bit_cast(unsigned, h); }
struct EpiF16 {
    static constexpr bool PERM = true, AFTER_DRAIN = false;
    unsigned short* C; int ldc;
    __device__ __forceinline__ void operator()(const f32x4 (&acc)[2][2][4][2], const Unit& u, int wr, int wc, int fr, int fq) const {
        const int row0 = u.pm * BM + wr * 64 + fr, col0 = u.pn * BM + wc * 32 + 8 * fq;
#pragma unroll
        for (int ai = 0; ai < 2; ++ai)
#pragma unroll
            for (int m = 0; m < 4; ++m) { unsigned short* rowp = C + (size_t)(row0 + ai * HALF + m * 16) * ldc + col0;
#pragma unroll
                for (int bj = 0; bj < 2; ++bj) { const f32x4 v0 = acc[ai][bj][m][0], v1 = acc[ai][bj][m][1];
                    u32x4 w; w.x = pkh2(v0[0], v0[1]); w.y = pkh2(v0[2], v0[3]); w.z = pkh2(v1[0], v1[1]); w.w = pkh2(v1[2], v1[3]); *(u32x4*)(rowp + bj * HALF) = w; } }
    }
};

struct EpiInProj {
    static constexpr bool PERM = false, AFTER_DRAIN = false;
    bf16_t* q; bf16_t* kv; bf16_t* zg; bf16_t* yc; const float* qg; const float* kg; const float* rope;
    __device__ __forceinline__ void operator()(const f32x4 (&acc)[2][2][4][2], const Unit& u, int wr, int wc, int fr, int fq) const {
        const int pn = u.pn, rowb = u.pm * BM + wr * 64 + fr;
        if (pn <= 2) {
            const bool isq = pn < 2, isv = (pn == 2 && wc >= 2), lat = (u.pm * BM) < ML;
            f32x4 gn[2][2];
#pragma unroll
            for (int bj = 0; bj < 2; ++bj)
#pragma unroll
                for (int n = 0; n < 2; ++n) gn[bj][n] = *(const f32x4*)((isq ? qg : kg) + 32 * bj + 16 * n + 4 * fq);
            f32x4 r0[2][2];
            if (!isv && lat) {
#pragma unroll
                for (int ai = 0; ai < 2; ++ai) { const int pos = ((u.pm * BM + wr * 64 + ai * HALF) & (SEQ - 1)) >> 6; const float* rp = rope + (pos * 16 + 4 * fq) * 2; r0[ai][0] = *(const f32x4*)rp; r0[ai][1] = *(const f32x4*)(rp + 4); }
            }
#pragma unroll
            for (int mh = 0; mh < 2; ++mh) {
                f32x4 r1[2][2];
                if (!isv && lat) {
#pragma unroll
                    for (int mm = 0; mm < 2; ++mm) { const int pos = fr + 16 * (mh * 2 + mm); const float* rp = rope + (pos * 16 + 4 * fq) * 2; r1[mm][0] = *(const f32x4*)rp; r1[mm][1] = *(const f32x4*)(rp + 4); }
                }
#pragma unroll
                for (int ai = 0; ai < 2; ++ai)
#pragma unroll
                    for (int mm = 0; mm < 2; ++mm) {
                    const int m = mh * 2 + mm;
                    const int row = rowb + ai * HALF + m * 16;
                    f32x4 v[2][2];
#pragma unroll
                    for (int bj = 0; bj < 2; ++bj)
#pragma unroll
                        for (int n = 0; n < 2; ++n) v[bj][n] = acc[ai][bj][m][n];
                    if (!isv) {
                        float ss = 0.f;
#pragma unroll
                        for (int bj = 0; bj < 2; ++bj)
#pragma unroll
                            for (int n = 0; n < 2; ++n) ss += (v[bj][n][0] * v[bj][n][0] + v[bj][n][1] * v[bj][n][1]) + (v[bj][n][2] * v[bj][n][2] + v[bj][n][3] * v[bj][n][3]);
                        ss += xchg16(ss, fq & 1); ss += xchg32(ss, fq & 2);
                        const float rs = __builtin_amdgcn_rsqf(ss * (1.0f / 64.0f) + EPS);
#pragma unroll
                        for (int bj = 0; bj < 2; ++bj)
#pragma unroll
                            for (int n = 0; n < 2; ++n) v[bj][n] = v[bj][n] * rs * gn[bj][n];
                        if (lat) {
#pragma unroll
                            for (int bj = 0; bj < 2; ++bj) {
                                const f32x4 cs01 = bj ? r1[mm][0] : r0[ai][0], cs23 = bj ? r1[mm][1] : r0[ai][1];
                                const float cs[4] = {cs01[0], cs01[2], cs23[0], cs23[2]}, sn[4] = {cs01[1], cs01[3], cs23[1], cs23[3]};
#pragma unroll
                                for (int e = 0; e < 4; ++e) { const float x1 = v[bj][0][e], x2 = v[bj][1][e]; v[bj][0][e] = x1 * cs[e] - x2 * sn[e]; v[bj][1][e] = x1 * sn[e] + x2 * cs[e]; }
                            }
                        }
                        if (isq) {
#pragma unroll
                            for (int bj = 0; bj < 2; ++bj)
#pragma unroll
                                for (int n = 0; n < 2; ++n) v[bj][n] = v[bj][n] * C2;
                        }
                    }
                    bf16_t* dst = isq ? q + (size_t)row * 512 + (pn * 4 + wc) * 64 : kv + (size_t)kvrow(row) * 256 + (wc >= 2 ? 128 + (wc - 2) * 64 : wc * 64);
#pragma unroll
                    for (int bj = 0; bj < 2; ++bj)
#pragma unroll
                        for (int n = 0; n < 2; ++n) { u32x2 w; w.x = pk2(v[bj][n][0], v[bj][n][1]); w.y = pk2(v[bj][n][2], v[bj][n][3]); *(u32x2*)(dst + 32 * bj + 16 * n + 4 * fq) = w; }
                }
            }
        } else if (pn <= 4) {
#pragma unroll
            for (int ai = 0; ai < 2; ++ai)
#pragma unroll
                for (int m = 0; m < 4; ++m) { bf16_t* dst = zg + (size_t)(rowb + ai * HALF + m * 16) * 512 + (pn - 3) * 256 + wc * 32 + 4 * fq;
#pragma unroll
                    for (int bj = 0; bj < 2; ++bj)
#pragma unroll
                        for (int n = 0; n < 2; ++n) { const f32x4 a = acc[ai][bj][m][n]; u32x2 w; w.x = pk2(gelu_tanh(a[0]), gelu_tanh(a[1])); w.y = pk2(gelu_tanh(a[2]), gelu_tanh(a[3]));
                            *(u32x2*)(dst + bj * HALF + 16 * n) = w; } }
        } else {
#pragma unroll
            for (int ai = 0; ai < 2; ++ai)
#pragma unroll
                for (int m = 0; m < 4; ++m) { bf16_t* dst = yc + (size_t)(rowb + ai * HALF + m * 16) * 256 + (pn - 5) * 128 + wc * 32 + 4 * fq;
#pragma unroll
                    for (int n = 0; n < 2; ++n) { const f32x4 a = acc[ai][0][m][n], g = acc[ai][1][m][n]; u32x2 w;
                        w.x = pk2(a[0] * fast_sigmoid(g[0]), a[1] * fast_sigmoid(g[1])); w.y = pk2(a[2] * fast_sigmoid(g[2]), a[3] * fast_sigmoid(g[3]));
                        *(u32x2*)(dst + 16 * n) = w; } }
        }
    }
};
template <class Epi, class Sched, bool ALIGN_EPI = false, bool SP2 = false>
__device__ __forceinline__ void gemm_phase(PG8_LAS unsigned char* lds, const Gemm g, const Sched& S, const Epi& E) {
    const int tid = mk_tid(), wid = __builtin_amdgcn_readfirstlane(tid >> 6), lane = tid & 63, wr = wid >> 2, wc = wid & 3, fr = lane & 15, fq = lane >> 4;
    const int K = g.K, nt = K / BK;
    unsigned voffA[2], voffB[2];
#pragma unroll
    for (int i = 0; i < 2; ++i) { int R, C; stage_rc(tid * 16 + i * 8192, R, C); const int Rb = Epi::PERM ? ((R & ~31) + perm32(R & 31)) : R;
        voffA[i] = (unsigned)(R * K + C) * 2u; voffB[i] = (unsigned)(Rb * K + C) * 2u; }
    const size_t kstep = (size_t)(BK * 2);
    const size_t hstep = (size_t)HALF * K * 2;
    const size_t tstep = 2 * hstep;
    const unsigned ldsw = (unsigned)wid * 1024u;
    const int aoff = lds_byte(wr * 64 + fr, fq * 8), boff = lds_byte(wc * 32 + fr, fq * 8);
#define PG8_SA(b, h) (((b) * 2 + (h)) * HTB)
#define PG8_SB(b, h) ((4 + (b) * 2 + (h)) * HTB)
#define PG8_STAGE(bufoff, gbase, voff) do { _Pragma("unroll") for (int _i = 0; _i < 2; ++_i) \
        __builtin_amdgcn_global_load_lds((const unsigned*)((const char*)(gbase) + (voff)[_i]), (PG8_LAS unsigned*)(lds + (bufoff) + ldsw + _i * 8192), 16, 0, 0); } while (0)
#define PG8_LDA(dst, b, h) do { _Pragma("unroll") for (int m = 0; m < 4; ++m) _Pragma("unroll") for (int k = 0; k < 2; ++k) dst[m][k] = *(const PG8_LAS bf16x8*)(lds + PG8_SA(b, h) + aoff + m * 2048 + k * 1024); } while (0)
#define PG8_LDB(dst, b, h) do { _Pragma("unroll") for (int n = 0; n < 2; ++n) _Pragma("unroll") for (int k = 0; k < 2; ++k) dst[n][k] = *(const PG8_LAS bf16x8*)(lds + PG8_SB(b, h) + boff + n * 2048 + k * 1024); } while (0)
#define PG8_MMA(ai, bj, At, Bt) do { __builtin_amdgcn_s_setprio(1); _Pragma("unroll") for (int m = 0; m < 4; ++m) _Pragma("unroll") for (int n = 0; n < 2; ++n) _Pragma("unroll") for (int k = 0; k < 2; ++k) \
        acc[ai][bj][m][n] = __builtin_amdgcn_mfma_f32_16x16x32_bf16(Bt[n][k], At[m][k], acc[ai][bj][m][n], 0, 0, 0); __builtin_amdgcn_s_setprio(0); } while (0)
#define PG8_WAIT_V(n) asm volatile("s_waitcnt vmcnt(" #n ")" ::: "memory")
#define PG8_WAIT_L(n) asm volatile("s_waitcnt lgkmcnt(" #n ")" ::: "memory")
#define PG8_BAR __builtin_amdgcn_s_barrier()
#define PG8_SCHED __builtin_amdgcn_sched_barrier(0)
    Unit cur, nxt; int ui = 0;
    if (!S.next(0, cur)) return;
    f32x4 acc[2][2][4][2];
#pragma unroll
    for (int a = 0; a < 2; ++a)
#pragma unroll
        for (int b = 0; b < 2; ++b)
#pragma unroll
            for (int m = 0; m < 4; ++m)
#pragma unroll
                for (int n = 0; n < 2; ++n) acc[a][b][m][n] = (f32x4){0.f, 0.f, 0.f, 0.f};
    bf16x8 At[4][2], B0[2][2], B1[2][2];
    const char* cA = (const char*)g.A + (size_t)cur.pm * tstep; const char* cB = (const char*)g.Bt + (size_t)cur.pn * tstep;
    S.a_ready(cur);
    if constexpr (SP2) {
        PG8_STAGE(PG8_SB(0, 0), cB, voffB); PG8_STAGE(PG8_SB(0, 1), cB + hstep, voffB); PG8_STAGE(PG8_SA(0, 0), cA, voffA); PG8_STAGE(PG8_SA(0, 1), cA + hstep, voffA);
        if (wr == 1) PG8_BAR;
        PG8_WAIT_V(2); PG8_BAR;
        PG8_STAGE(PG8_SB(1, 0), cB + kstep, voffB); PG8_STAGE(PG8_SA(1, 0), cA + kstep, voffA); PG8_STAGE(PG8_SB(1, 1), cB + hstep + kstep, voffB);
        PG8_WAIT_V(6); PG8_BAR;
    } else {
        PG8_STAGE(PG8_SB(0, 0), cB, voffB); PG8_STAGE(PG8_SA(0, 0), cA, voffA); PG8_STAGE(PG8_SB(0, 1), cB + hstep, voffB); PG8_STAGE(PG8_SA(0, 1), cA + hstep, voffA);
        if (wr == 1) PG8_BAR;
        PG8_WAIT_V(4); PG8_BAR;
        PG8_STAGE(PG8_SB(1, 0), cB + kstep, voffB); PG8_STAGE(PG8_SA(1, 0), cA + kstep, voffA); PG8_STAGE(PG8_SB(1, 1), cB + hstep + kstep, voffB);
        PG8_WAIT_V(6); PG8_BAR;
    }
    for (;;) {
        const bool has_next = S.next(ui + 1, nxt);
        const char* nA = has_next ? (const char*)g.A + (size_t)nxt.pm * tstep : cA; const char* nB = has_next ? (const char*)g.Bt + (size_t)nxt.pn * tstep : cB;
        for (int t = 0; t < nt; t += 2) {
            const bool last = (t == nt - 2);
            const char* a1 = cA + (size_t)(t + 1) * kstep;
            const char* a2 = last ? nA : cA + (size_t)(t + 2) * kstep; const char* b2 = last ? nB : cB + (size_t)(t + 2) * kstep;
            const char* a3 = a2 + kstep; const char* b3 = b2 + kstep;
            if (last && has_next) S.a_ready(nxt);
            if constexpr (SP2) {
            PG8_LDB(B0, 0, 0); PG8_LDB(B1, 0, 1); PG8_SCHED; PG8_LDA(At, 0, 0); PG8_STAGE(PG8_SA(1, 1), a1 + hstep, voffA);
            PG8_WAIT_V(8); PG8_WAIT_L(0); PG8_BAR; PG8_MMA(0, 0, At, B0); PG8_MMA(0, 1, At, B1); PG8_BAR; PG8_SCHED;
            PG8_LDA(At, 0, 1); PG8_STAGE(PG8_SB(0, 0), b2, voffB); PG8_STAGE(PG8_SB(0, 1), b2 + hstep, voffB); PG8_STAGE(PG8_SA(0, 0), a2, voffA);
            PG8_WAIT_V(8); PG8_WAIT_L(0); PG8_BAR; PG8_MMA(1, 0, At, B0); PG8_MMA(1, 1, At, B1); PG8_BAR; PG8_SCHED;
            PG8_LDB(B0, 1, 0); PG8_LDB(B1, 1, 1); PG8_SCHED; PG8_LDA(At, 1, 0); PG8_STAGE(PG8_SA(0, 1), a2 + hstep, voffA);
            PG8_WAIT_V(8); PG8_WAIT_L(0); PG8_BAR; PG8_MMA(0, 0, At, B0); PG8_MMA(0, 1, At, B1); PG8_BAR; PG8_SCHED;
            PG8_LDA(At, 1, 1); PG8_STAGE(PG8_SB(1, 0), b3, voffB); PG8_STAGE(PG8_SB(1, 1), b3 + hstep, voffB); PG8_STAGE(PG8_SA(1, 0), a3, voffA);
            PG8_WAIT_V(8); PG8_WAIT_L(0); PG8_BAR; PG8_MMA(1, 0, At, B0); PG8_MMA(1, 1, At, B1); PG8_BAR; PG8_SCHED;
            } else {
            PG8_LDB(B0, 0, 0); PG8_SCHED; PG8_LDA(At, 0, 0); PG8_STAGE(PG8_SA(1, 1), a1 + hstep, voffA);
            PG8_WAIT_L(8); PG8_BAR; PG8_WAIT_L(0); PG8_MMA(0, 0, At, B0); PG8_BAR; PG8_SCHED;
            PG8_LDB(B1, 0, 1); PG8_STAGE(PG8_SB(0, 0), b2, voffB);
            PG8_BAR; PG8_WAIT_L(0); PG8_MMA(0, 1, At, B1); PG8_BAR;
            PG8_LDA(At, 0, 1); PG8_STAGE(PG8_SA(0, 0), a2, voffA);
            PG8_BAR; PG8_WAIT_L(0); PG8_MMA(1, 0, At, B0); PG8_BAR; PG8_SCHED;
            PG8_STAGE(PG8_SB(0, 1), b2 + hstep, voffB);
            PG8_WAIT_V(6); PG8_BAR; PG8_MMA(1, 1, At, B1); PG8_BAR;
            PG8_LDB(B0, 1, 0); PG8_SCHED; PG8_LDA(At, 1, 0); PG8_STAGE(PG8_SA(0, 1), a2 + hstep, voffA);
            PG8_WAIT_L(8); PG8_BAR; PG8_WAIT_L(0); PG8_MMA(0, 0, At, B0); PG8_BAR; PG8_SCHED;
            PG8_LDB(B1, 1, 1); PG8_STAGE(PG8_SB(1, 0), b3, voffB);
            PG8_BAR; PG8_WAIT_L(0); PG8_MMA(0, 1, At, B1); PG8_BAR;
            PG8_LDA(At, 1, 1); PG8_STAGE(PG8_SA(1, 0), a3, voffA);
            PG8_BAR; PG8_WAIT_L(0); PG8_MMA(1, 0, At, B0); PG8_BAR; PG8_SCHED;
            PG8_STAGE(PG8_SB(1, 1), b3 + hstep, voffB);
            PG8_WAIT_V(6); PG8_BAR; PG8_MMA(1, 1, At, B1); PG8_BAR;
            }
        }
        if constexpr (ALIGN_EPI) { if (wr == 0) PG8_BAR; }
        if constexpr (!Epi::AFTER_DRAIN) { E(acc, cur, wr, wc, fr, fq); S.done(cur); }
        if (!has_next) break;
#pragma unroll
        for (int a = 0; a < 2; ++a)
#pragma unroll
            for (int b = 0; b < 2; ++b)
#pragma unroll
                for (int m = 0; m < 4; ++m)
#pragma unroll
                    for (int n = 0; n < 2; ++n) acc[a][b][m][n] = (f32x4){0.f, 0.f, 0.f, 0.f};
        cur = nxt; cA = nA; cB = nB; ++ui;
        if constexpr (ALIGN_EPI) { if (wr == 1) PG8_BAR; }
    }
    PG8_WAIT_V(0);
    if constexpr (!ALIGN_EPI) { if (wr == 0) PG8_BAR; }
    PG8_BAR;
    if constexpr (Epi::AFTER_DRAIN) { E.fused(acc, cur, wr, wc, fr, fq, lds, wid, lane); S.done(cur); }
#undef PG8_SA
#undef PG8_SB
#undef PG8_STAGE
#undef PG8_LDA
#undef PG8_LDB
#undef PG8_MMA
#undef PG8_WAIT_V
#undef PG8_WAIT_L
#undef PG8_BAR
#undef PG8_SCHED
}
}
namespace attn_body {
using bf16=__hip_bfloat16;
using bf16x8=__attribute__((ext_vector_type(8)))short;
using s16x4=__attribute__((ext_vector_type(4)))short;
using f32x16=__attribute__((ext_vector_type(16)))float;
using u32x4=__attribute__((ext_vector_type(4)))unsigned;
constexpr int D=64;
constexpr int DMQ=512, DMKV=256, DMO=1024;
constexpr int NW=8,QBLK=32,QB=QBLK*NW,KVBLK=64;
constexpr int ATTN_UNIT_ROWS=QB;
__device__ __forceinline__ int crow(int r,int hi){return (r&3)+8*(r>>2)+4*hi;}
#define SBAR() __builtin_amdgcn_sched_barrier(0)
constexpr int NSLOT=3, SLOTB=8192;
constexpr int LDS_K=0, LDS_V=NSLOT*SLOTB, LDS_WS=2*NSLOT*SLOTB, LDS_OST=LDS_WS+NW*64*4, LDS_BYTES=LDS_OST+NW*4096;
__device__ __forceinline__ void glds16(const void*gsrc,unsigned lds_dst){unsigned keep;
  asm volatile("s_mov_b32 %0, m0\n\ts_mov_b32 m0, %2\n\ts_nop 0\n\tglobal_load_lds_dwordx4 %1, off\n\ts_mov_b32 m0, %0":"=&s"(keep):"v"(gsrc),"s"(lds_dst):"memory");}
__device__ __forceinline__ float max3f(float a,float b,float c){float r;asm("v_max3_f32 %0, %1, %2, %3":"=v"(r):"v"(a),"v"(b),"v"(c));return r;}
__device__ __forceinline__ float max2f(float a,float b){float r;asm("v_max_f32_e32 %0, %1, %2":"=v"(r):"v"(a),"v"(b));return r;}
__device__ __forceinline__ float fadd_s(float a,float b){float r;asm("v_add_f32_e32 %0, %1, %2":"=v"(r):"v"(a),"v"(b));return r;}
__device__ __forceinline__ float fsub_s(float a,float b){float r;asm("v_sub_f32_e32 %0, %1, %2":"=v"(r):"v"(a),"v"(b));return r;}
typedef float f32x2_t __attribute__((ext_vector_type(2))); typedef __bf16 bf16x2_t __attribute__((ext_vector_type(2)));
__device__ __forceinline__ unsigned cvtpk_s(float lo,float hi){f32x2_t v={lo,hi};bf16x2_t b=__builtin_convertvector(v,bf16x2_t);return __builtin_bit_cast(unsigned,b);}
#define WAIT_BAR(N) asm volatile("s_waitcnt vmcnt(" #N ") lgkmcnt(0)\n\ts_barrier":::"memory")

__device__ __forceinline__ void qkt(f32x16&p0,f32x16&p1,const char*Kslot,const bf16x8*qr,const f32x16&negm,int r32,int hi){
  const char*kb=Kslot+hi*1024+r32*16;
  #pragma unroll
  for(int d0=0;d0<4;++d0){
    const bf16x8 b0=*reinterpret_cast<const bf16x8*>(kb+d0*2048);
    const bf16x8 b1=*reinterpret_cast<const bf16x8*>(kb+d0*2048+512);
    if(d0==0){p0=__builtin_amdgcn_mfma_f32_32x32x16_bf16(b0,qr[0],negm,0,0,0);p1=__builtin_amdgcn_mfma_f32_32x32x16_bf16(b1,qr[0],negm,0,0,0);}
    else{p0=__builtin_amdgcn_mfma_f32_32x32x16_bf16(b0,qr[d0],p0,0,0,0);p1=__builtin_amdgcn_mfma_f32_32x32x16_bf16(b1,qr[d0],p1,0,0,0);}}
}
typedef __attribute__((address_space(3))) const char* lds_cptr;
typedef short v4i16_t __attribute__((ext_vector_type(4)));
__device__ __forceinline__ void kload8(bf16x8*kf,lds_cptr kp){
  kf[0]=*(const __attribute__((address_space(3))) bf16x8*)(kp);      kf[1]=*(const __attribute__((address_space(3))) bf16x8*)(kp+512);
  kf[2]=*(const __attribute__((address_space(3))) bf16x8*)(kp+2048); kf[3]=*(const __attribute__((address_space(3))) bf16x8*)(kp+2560);
  kf[4]=*(const __attribute__((address_space(3))) bf16x8*)(kp+4096); kf[5]=*(const __attribute__((address_space(3))) bf16x8*)(kp+4608);
  kf[6]=*(const __attribute__((address_space(3))) bf16x8*)(kp+6144); kf[7]=*(const __attribute__((address_space(3))) bf16x8*)(kp+6656);
}
__device__ __forceinline__ void kload2(bf16x8*kf,lds_cptr kp,int j){ kf[2*j]=*(const __attribute__((address_space(3))) bf16x8*)(kp+j*2048); kf[2*j+1]=*(const __attribute__((address_space(3))) bf16x8*)(kp+j*2048+512); }
__device__ __forceinline__ s16x4 vtr(lds_cptr p){ return __builtin_bit_cast(s16x4,__builtin_amdgcn_ds_read_tr16_b64_v4i16((__attribute__((address_space(3))) v4i16_t*)p)); }
__device__ __forceinline__ float rowmax(const f32x16&p0,const f32x16&p1){
  float a=max3f(p0[0],p0[1],p1[0]),b=max3f(p0[2],p0[3],p1[1]);a=max3f(a,p1[2],p1[3]);
  #pragma unroll
  for(int r=4;r<16;r+=4){a=max3f(a,p0[r],p0[r+1]);b=max3f(b,p0[r+2],p0[r+3]);a=max3f(a,p1[r],p1[r+1]);b=max3f(b,p1[r+2],p1[r+3]);}
  const float m=max2f(a,b);
  auto rr=__builtin_amdgcn_permlane32_swap(__float_as_uint(m),__float_as_uint(m),false,false);
  return max2f(__uint_as_float(rr[0]),__uint_as_float(rr[1]));
}
__device__ __forceinline__ void pv(f32x16*o,int vb,bf16x8 pa0,bf16x8 pa1,bf16x8 pa2,bf16x8 pa3){
  #pragma unroll
  for(int d0=0;d0<2;++d0){s16x4 lo[4],hi[4];
    #pragma unroll
    for(int ks=0;ks<4;++ks){
      asm volatile("ds_read_b64_tr_b16 %0,%1 offset:%c2":"=&v"(lo[ks]):"v"(vb),"i"(d0*4096+ks*1024):"memory");
      asm volatile("ds_read_b64_tr_b16 %0,%1 offset:%c2":"=&v"(hi[ks]):"v"(vb),"i"(d0*4096+ks*1024+512):"memory");}
    asm volatile("s_waitcnt lgkmcnt(0)":::"memory");SBAR();
    #define PK(k) (bf16x8){lo[k][0],lo[k][1],lo[k][2],lo[k][3],hi[k][0],hi[k][1],hi[k][2],hi[k][3]}
    o[d0]=__builtin_amdgcn_mfma_f32_32x32x16_bf16(pa0,PK(0),o[d0],0,0,0);
    o[d0]=__builtin_amdgcn_mfma_f32_32x32x16_bf16(pa1,PK(1),o[d0],0,0,0);
    o[d0]=__builtin_amdgcn_mfma_f32_32x32x16_bf16(pa2,PK(2),o[d0],0,0,0);
    o[d0]=__builtin_amdgcn_mfma_f32_32x32x16_bf16(pa3,PK(3),o[d0],0,0,0);
    #undef PK
  }
}

#ifndef ATTN_STORE16
#define ATTN_STORE16(p,v) (*(u32x4*)(p)=(v))
#endif
template<int THRL> __device__ __forceinline__ void attn_unit(const bf16*Q0,const bf16*__restrict__ K0,const bf16*__restrict__ V0,bf16*O0,const int NT,char*shm){
  const int tid=mk_tid(),lane=tid&63,r32=lane&31,hi=lane>>5; const int wid=__builtin_amdgcn_readfirstlane(tid>>6);
  const bf16*Qw=Q0+(long)(wid*QBLK)*DMQ;
  const bf16*Kh=K0,*Vh=V0;
  const unsigned lds0=(unsigned)(uintptr_t)shm;
  float*wsf=(float*)(shm+LDS_WS)+wid*64;
  const bf16*ksrc=Kh+(long)lane*DMKV+wid*8;
  const bf16*vsrc=Vh+(long)(16*(wid&3)+(lane>>2))*DMKV+(wid>>2)*32+(lane&3)*8;
  const unsigned kdst=lds0+LDS_K+wid*1024, vdst=lds0+LDS_V+wid*1024;
  #define DMA_K(t,slot) glds16(ksrc+(long)(t)*KVBLK*DMKV,(unsigned)__builtin_amdgcn_readfirstlane(kdst+(slot)))
  #define DMA_V(t,slot) glds16(vsrc+(long)(t)*KVBLK*DMKV,(unsigned)__builtin_amdgcn_readfirstlane(vdst+(slot)))
  const int vb0=(int)(lds0+LDS_V)+((lane>>4)&1)*32+(lane&3)*8+(4*hi+((lane&15)>>2))*64;
  const char*Kbase=shm+LDS_K; bf16x8 kf[8];
  const lds_cptr shm3=(lds_cptr)shm; const lds_cptr kp0=shm3+LDS_K+hi*1024+r32*16; const lds_cptr vp0=shm3+LDS_V+((lane>>4)&1)*32+(lane&3)*8+(4*hi+((lane&15)>>2))*64;
  DMA_K(0,0);DMA_V(0,0);DMA_K(1,SLOTB);
  bf16x8 qr[4];
  #pragma unroll
  for(int d0=0;d0<4;++d0)qr[d0]=*reinterpret_cast<const bf16x8*>(&Qw[(long)r32*DMQ+d0*16+hi*8]);
  float mhat=0.f,l_reg=0.f;f32x16 o[2];o[0]=f32x16{};o[1]=f32x16{};f32x16 negm=f32x16{};asm volatile("":"+v"(negm));
  #define CMASK(P0,P1,t) do{}while(0)
  bool resc=false;
  #define START(P0,P1) do{ const float rm=rowmax(P0,P1); resc=false; \
    { const float dl=rm; mhat=fadd_s(mhat,dl); \
      _Pragma("unroll") for(int r=0;r<16;++r){P0[r]=fsub_s(P0[r],dl);P1[r]=fsub_s(P1[r],dl);} \
      _Pragma("unroll") for(int r=0;r<16;++r)negm[r]=-mhat; asm volatile("":"+v"(negm)); } \
    _Pragma("unroll") for(int r=0;r<16;++r)P0[r]=__builtin_amdgcn_exp2f(P0[r]); }while(0)
  #define RESC() do{ if(resc){ asm volatile("s_waitcnt lgkmcnt(0)":::"memory"); \
      _Pragma("unroll") for(int d_=0;d_<2;++d_) _Pragma("unroll") for(int r=0;r<16;++r)o[d_][r]*=wsf[crow(r,hi)]; } }while(0)
  f32x16 pA0,pA1,pB0,pB1;
  int sl_prev=0,sl_cur=0,sl_next=SLOTB;
  #define ROT() do{sl_prev=sl_cur;sl_cur=sl_next;sl_next=(sl_next==(NSLOT-1)*SLOTB)?0:sl_next+SLOTB;}while(0)
  DMA_K(2,2*SLOTB);
  WAIT_BAR(3);
  qkt(pA0,pA1,Kbase,qr,negm,r32,hi);asm volatile("s_nop 15\n\ts_nop 7":"+v"(pA0),"+v"(pA1));CMASK(pA0,pA1,0);
  START(pA0,pA1);
  _Pragma("unroll") for(int r=0;r<16;++r)pA1[r]=__builtin_amdgcn_exp2f(pA1[r]);
  WAIT_BAR(0);
  DMA_K(3,0);DMA_V(1,SLOTB);
  ROT();
  kload8(kf,kp0+sl_cur);
  WAIT_BAR(2);
  s16x4 vlo[8],vhi[8]; u32x4 pw0,pw1,pw2,pw3;
  #define PKW(P,B) cvtpk_s(P[B],P[B+1])
  #define PAF(k) __builtin_bit_cast(bf16x8,pw##k)
  #define VFR(i) (bf16x8){vlo[i][0],vlo[i][1],vlo[i][2],vlo[i][3],vhi[i][0],vhi[i][1],vhi[i][2],vhi[i][3]}
  #define PIN(x) asm volatile("":"+v"(x))
  #define MX3(a,b,c) __builtin_fmaxf(__builtin_fmaxf((a),(b)),(c))
  #define GAPA(MF,A0,A1,A2,A3,W0,W1,PW) do{ MF; sacc+=A0; sacc+=A1; sacc+=A2; sacc+=A3; PIN(sacc); W0; W1; PIN(PW); SBAR(); }while(0)
  #define EX(v) __builtin_amdgcn_exp2f(v)
  #define GAPB(MF,X,B) do{ MF; X[B]=EX(X[B]); X[B+1]=EX(X[B+1]); X[B+2]=EX(X[B+2]); X[B+3]=EX(X[B+3]); PIN(X); SBAR(); }while(0)
  #define VRD(i) do{ vlo[i]=vtr(vp_+(((i)>>2)*4096+((i)&3)*1024)); vhi[i]=vtr(vp_+(((i)>>2)*4096+((i)&3)*1024+512)); }while(0)
  #define KRD(G,j) do{ if(G){ kload2(kf,kp0+sl_next,j); SBAR(); } }while(0)
  #define STEP(C0,C1,P0,P1,t,GK,GV,GL) do{ SBAR(); \
    const lds_cptr vp_=vp0+sl_prev; \
    VRD(0); SBAR(); float sacc=(P0[0]+P0[1]); \
    GAPA(C0=__builtin_amdgcn_mfma_f32_32x32x16_bf16(kf[0],qr[0],negm,0,0,0), P0[2],P0[3],P0[4],P0[5],     pw0[0]=PKW(P0,0), pw0[1]=PKW(P0,2), pw0); \
    VRD(4); SBAR(); GAPA(C1=__builtin_amdgcn_mfma_f32_32x32x16_bf16(kf[1],qr[0],negm,0,0,0), P0[6],P0[7],P0[8],P0[9],     pw0[2]=PKW(P0,4), pw0[3]=PKW(P0,6), pw0); \
    VRD(1); SBAR(); GAPA(C0=__builtin_amdgcn_mfma_f32_32x32x16_bf16(kf[2],qr[1],C0,0,0,0),   P0[10],P0[11],P0[12],P0[13], pw1[0]=PKW(P0,8), pw1[1]=PKW(P0,10), pw1); \
    VRD(5); SBAR(); GAPA(C1=__builtin_amdgcn_mfma_f32_32x32x16_bf16(kf[3],qr[1],C1,0,0,0),   P0[14],P0[15],P1[0],P1[1],   pw1[2]=PKW(P0,12),pw1[3]=PKW(P0,14), pw1); \
    VRD(2); SBAR(); GAPA(C0=__builtin_amdgcn_mfma_f32_32x32x16_bf16(kf[4],qr[2],C0,0,0,0),   P1[2],P1[3],P1[4],P1[5],     pw2[0]=PKW(P1,0), pw2[1]=PKW(P1,2), pw2); \
    VRD(6); SBAR(); GAPA(C1=__builtin_amdgcn_mfma_f32_32x32x16_bf16(kf[5],qr[2],C1,0,0,0),   P1[6],P1[7],P1[8],P1[9],     pw2[2]=PKW(P1,4), pw2[3]=PKW(P1,6), pw2); \
    VRD(3); SBAR(); GAPA(C0=__builtin_amdgcn_mfma_f32_32x32x16_bf16(kf[6],qr[3],C0,0,0,0),   P1[10],P1[11],P1[12],P1[13], pw3[0]=PKW(P1,8), pw3[1]=PKW(P1,10), pw3); \
    VRD(7); SBAR(); GAPA(C1=__builtin_amdgcn_mfma_f32_32x32x16_bf16(kf[7],qr[3],C1,0,0,0),   P1[14],P1[15],0.f,0.f,       pw3[2]=PKW(P1,12),pw3[3]=PKW(P1,14), pw3); \
    l_reg+=sacc; \
    if(GK){DMA_K((t)+3,sl_cur);} if(GV){DMA_V((t)+1,sl_next);} \
    CMASK(C0,C1,t); \
    { float a=MX3(C0[0],C0[1],C1[0]),b=MX3(C0[2],C0[3],C1[1]); a=MX3(a,C1[2],C1[3]); \
      _Pragma("unroll") for(int r=4;r<16;r+=4){a=MX3(a,C0[r],C0[r+1]);b=MX3(b,C0[r+2],C0[r+3]);a=MX3(a,C1[r],C1[r+1]);b=MX3(b,C1[r+2],C1[r+3]);} \
      float rm=__builtin_fmaxf(a,b); { auto rr=__builtin_amdgcn_permlane32_swap(__float_as_uint(rm),__float_as_uint(rm),false,false); rm=__builtin_fmaxf(__uint_as_float(rr[0]),__uint_as_float(rr[1])); } \
      resc=false; \
      if(__builtin_expect(__any(rm>(float)THRL),0)){ const float dl=__builtin_fmaxf(rm,0.f); mhat+=dl; \
        _Pragma("unroll") for(int r=0;r<16;++r){C0[r]-=dl;C1[r]-=dl;} \
        _Pragma("unroll") for(int r=0;r<16;++r)negm[r]=-mhat; asm volatile("":"+v"(negm)); \
        const float f=__builtin_amdgcn_exp2f(-dl); l_reg*=f; if(hi==0)wsf[r32]=f; resc=true; } } \
    SBAR(); \
    GAPB(o[0]=__builtin_amdgcn_mfma_f32_32x32x16_bf16(PAF(0),VFR(0),o[0],0,0,0), C0,0); \
    GAPB(o[1]=__builtin_amdgcn_mfma_f32_32x32x16_bf16(PAF(0),VFR(4),o[1],0,0,0), C0,4); \
    KRD(GL,0); GAPB(o[0]=__builtin_amdgcn_mfma_f32_32x32x16_bf16(PAF(1),VFR(1),o[0],0,0,0), C0,8); \
    KRD(GL,1); GAPB(o[1]=__builtin_amdgcn_mfma_f32_32x32x16_bf16(PAF(1),VFR(5),o[1],0,0,0), C0,12); \
    KRD(GL,2); GAPB(o[0]=__builtin_amdgcn_mfma_f32_32x32x16_bf16(PAF(2),VFR(2),o[0],0,0,0), C1,0); \
    KRD(GL,3); GAPB(o[1]=__builtin_amdgcn_mfma_f32_32x32x16_bf16(PAF(2),VFR(6),o[1],0,0,0), C1,4); \
    GAPB(o[0]=__builtin_amdgcn_mfma_f32_32x32x16_bf16(PAF(3),VFR(3),o[0],0,0,0), C1,8); \
    GAPB(o[1]=__builtin_amdgcn_mfma_f32_32x32x16_bf16(PAF(3),VFR(7),o[1],0,0,0), C1,12); \
    }while(0)
  int t=1;
  #undef CMASK
  #define CMASK(P0,P1,t) do{}while(0)
  for(;t+5<NT;t+=2){
    STEP(pB0,pB1,pA0,pA1,t,true,true,true);     WAIT_BAR(2); RESC(); ROT();
    STEP(pA0,pA1,pB0,pB1,t+1,true,true,true);   WAIT_BAR(2); RESC(); ROT();
  }
  #undef CMASK
  #define CMASK(P0,P1,t) do{}while(0)
  #define ENDW(tt) do{ if((tt)+3<NT){WAIT_BAR(2);} else if((tt)+2<NT){WAIT_BAR(1);} else {WAIT_BAR(0);} }while(0)
  for(;t+1<NT;t+=2){
    STEP(pB0,pB1,pA0,pA1,t,(t+3<NT),(t+1<NT),(t+1<NT));       ENDW(t);   RESC(); ROT();
    STEP(pA0,pA1,pB0,pB1,t+1,(t+4<NT),(t+2<NT),(t+2<NT));     ENDW(t+1); RESC(); ROT();
  }
  STEP(pB0,pB1,pA0,pA1,NT-1,false,false,false); RESC();
  { float sacc=pB0[0]+pB0[1]; _Pragma("unroll") for(int r=2;r<16;++r)sacc+=pB0[r]; _Pragma("unroll") for(int r=0;r<16;++r)sacc+=pB1[r]; l_reg+=sacc;
    pw0=(u32x4){PKW(pB0,0),PKW(pB0,2),PKW(pB0,4),PKW(pB0,6)};pw1=(u32x4){PKW(pB0,8),PKW(pB0,10),PKW(pB0,12),PKW(pB0,14)};pw2=(u32x4){PKW(pB1,0),PKW(pB1,2),PKW(pB1,4),PKW(pB1,6)};pw3=(u32x4){PKW(pB1,8),PKW(pB1,10),PKW(pB1,12),PKW(pB1,14)};
    SBAR(); pv(o,vb0+sl_cur,PAF(0),PAF(1),PAF(2),PAF(3)); }
  #undef PKW
  #undef PAF
  #undef VFR
  #undef PIN
  #undef MX3
  #undef GAPA
  #undef GAPB
  #undef EX
  #undef VRD
  #undef KRD
  #undef STEP
  #undef ENDW
  {auto rr=__builtin_amdgcn_permlane32_swap(__float_as_uint(l_reg),__float_as_uint(l_reg),false,false);l_reg=__uint_as_float(rr[0])+__uint_as_float(rr[1]);}
  if(hi==0)wsf[32+r32]=l_reg;asm volatile("s_waitcnt lgkmcnt(0)":::"memory");
  float rli[16];
  #pragma unroll
  for(int r=0;r<16;++r)rli[r]=__builtin_amdgcn_rcpf(wsf[32+crow(r,hi)]);
  bf16*Ow=O0+(long)(wid*QBLK)*DMO;
  { bf16*stg=(bf16*)(shm+LDS_OST)+wid*2048;
    #pragma unroll
    for(int r=0;r<16;++r){const int orow=crow(r,hi);
      #pragma unroll
      for(int d0=0;d0<2;++d0)stg[orow*64+d0*32+r32]=__float2bfloat16(o[d0][r]*rli[r]);}
    asm volatile("s_waitcnt lgkmcnt(0)":::"memory");
    #pragma unroll
    for(int i=0;i<4;++i){const int row=i*8+(lane>>3),ch=lane&7; const u32x4 v=*(const u32x4*)(stg+row*64+ch*8); ATTN_STORE16(Ow+(long)row*DMO+ch*8,v);} }
  asm volatile("s_waitcnt lgkmcnt(0)\n\ts_barrier":::"memory");
  #undef DMA_K
  #undef DMA_V
  #undef CMASK
  #undef START
  #undef RESC
  #undef ROT
}
constexpr int ATTN_LDS_BYTES=LDS_BYTES;
#undef SBAR
#undef WAIT_BAR
}
#define XB_TMO      128
#define XB_XCNT(j)  (256  + 64 * (j))
#define XB_XSUB(j)  (1280 + 64 * (j))
#define XB_XGEN(j)  (2304 + 64 * (j))
#define XB_TOP      3328
#define XB_TOPGEN   3392
#define XCD_BAR_WORDS 3456
#define XB_SPIN_CAP (1u << 18)
__device__ __forceinline__ unsigned xb_ld(unsigned* p)              { return __hip_atomic_load(p, __ATOMIC_RELAXED, __HIP_MEMORY_SCOPE_AGENT); }
__device__ __forceinline__ unsigned xb_add(unsigned* p, unsigned v) { return __hip_atomic_fetch_add(p, v, __ATOMIC_RELAXED, __HIP_MEMORY_SCOPE_AGENT); }
__device__ __forceinline__ unsigned xb_xcc_id() { return (unsigned)__builtin_amdgcn_s_getreg((3 << 11) | 20) & 0xFu; }
#define XB_SPIN(cond, bar) do { unsigned _sp = 0; while (cond) { __builtin_amdgcn_s_sleep(1); \
    if ((++_sp & 255u) == 0u) { if (xb_ld(&(bar)[XB_TMO])) break; if (_sp > XB_SPIN_CAP) { atomicAdd(&(bar)[XB_TMO], 1u); break; } } } } while (0)

struct XcdBarrier {
    unsigned* bar; unsigned x;
    volatile LAS unsigned* st;
};

__device__ __forceinline__ XcdBarrier xcd_barrier_post(unsigned* bar, volatile LAS unsigned* st) {
    XcdBarrier b; b.bar = bar; b.x = xb_xcc_id(); b.st = st;
    if (threadIdx.x == 0) (void)xb_add(&bar[XB_XCNT(b.x)], 1u);
    return b;
}
__device__ __forceinline__ void xcd_barrier_complete(unsigned* bar, unsigned x, unsigned& nloc, unsigned& nx) {
    const unsigned G = gridDim.x * gridDim.y * gridDim.z;
    unsigned sum, cnt, mine, sp = 0u;
    for (;;) {
        sum = 0u; cnt = 0u; mine = 0u;
#pragma unroll
        for (unsigned j = 0; j < 16; ++j) { const unsigned c = xb_ld(&bar[XB_XCNT(j)]); sum += c; cnt += (c > 0u) ? 1u : 0u; mine = (j == x) ? c : mine; }
        if (sum == G) break;
        __builtin_amdgcn_s_sleep(1);
        if ((++sp & 255u) == 0u) { if (xb_ld(&bar[XB_TMO])) break; if (sp > XB_SPIN_CAP) { atomicAdd(&bar[XB_TMO], 1u); break; } }
    }
    nloc = mine > 0u ? mine : 1u; nx = cnt > 0u ? cnt : 1u;
}

__device__ __forceinline__ void xcd_barrier(const XcdBarrier& b) {
    asm volatile("s_waitcnt vmcnt(0)" ::: "memory");
    __syncthreads();
    if (threadIdx.x == 0) {
        unsigned* bar = b.bar;
        __builtin_amdgcn_s_waitcnt(0);
        unsigned nloc = b.st[0], nx = b.st[1];
        if (nloc == 0u) { xcd_barrier_complete(bar, b.x, nloc, nx); b.st[0] = nloc; b.st[1] = nx; }
        const unsigned old = xb_add(&bar[XB_XSUB(b.x)], 1u);
        const unsigned gen = old / nloc;
        if (old + 1u == (gen + 1u) * nloc) {
            __builtin_amdgcn_fence(__ATOMIC_RELEASE, "agent");
            asm volatile("s_waitcnt vmcnt(0)" ::: "memory");
            const unsigned og = xb_add(&bar[XB_TOP], 1u);
            const unsigned tg = og / nx;
            if (og + 1u == (tg + 1u) * nx) xb_add(&bar[XB_TOPGEN], 1u);
            else XB_SPIN(xb_ld(&bar[XB_TOPGEN]) == tg, bar);
            __builtin_amdgcn_fence(__ATOMIC_ACQUIRE, "agent");
            xb_add(&bar[XB_XGEN(b.x)], 1u);
            asm volatile("s_waitcnt vmcnt(0)" ::: "memory");
        } else {
            XB_SPIN(xb_ld(&bar[XB_XGEN(b.x)]) == gen, bar);
            __builtin_amdgcn_fence(__ATOMIC_ACQUIRE, "agent");
            asm volatile("s_waitcnt vmcnt(0)" ::: "memory");
        }
    }
    __syncthreads();
}
constexpr size_t MiB = 1u << 20;
constexpr size_t WS_CTL = 0, CTL_ZERO_BYTES = 64 * 1024;
constexpr size_t WS_MOD = 1 * MiB, WS_ROPE = 1 * MiB + 256 * 1024, WS_BOUT = 1 * MiB + 512 * 1024;
constexpr size_t WS_WIN_T = 2 * MiB, WS_WOUT_T = 9 * MiB, WS_WS_T = 13 * MiB, WS_GWS = 21 * MiB, WS_XC1 = 22 * MiB, WS_XC2 = 26 * MiB;
constexpr size_t WS_U8 = 32 * MiB, WS_V8 = 64 * MiB, WS_H = 96 * MiB, WS_Q = 162 * MiB, WS_KV = 195 * MiB, WS_ZG = 212 * MiB, WS_YC = 245 * MiB, WS_MIX = 262 * MiB, WS_Y = 328 * MiB;
constexpr size_t WS_S = 162 * MiB;
constexpr size_t WS_PACT = 162 * MiB, WS_F = 394 * MiB;
constexpr size_t WS_X1B = 394 * MiB;
constexpr size_t WS_TKI = 477 * MiB, WS_TKG = 486 * MiB, WS_W = 460 * MiB;
constexpr size_t WS_H8 = 294 * MiB;
constexpr size_t WS_END = 503 * MiB;
static_assert(WS_S + (size_t)MT * 2048 * 4 <= WS_END && WS_Y + (size_t)MT * 1024 * 4 <= WS_END && WS_H + (size_t)MT * 1024 * 2 <= WS_Q && WS_MIX + (size_t)MT * 1024 * 2 <= WS_Y, "d_ws map");
constexpr int CW_BAR = 4096, CW_Q = 8192;
constexpr int RING_BYTES = 131072, MISC_OFF = 143360, LDS_BYTES = 147456;
constexpr int N_PHASES = 22;

#define XB_SPIN_CAP_OVERRIDE (1u << 22)

struct Params { const float* in[28]; float* out; unsigned char* ws; int ph_lo, ph_hi; };

struct Frame { LAS unsigned char* lds; int tid, lane, wave, vcu, G; };

__host__ __device__ __forceinline__ int inproj_phys(int L) {
    if (L < 512) { const int hq = L >> 6, d = L & 63; return (hq >> 2) * 256 + (d >> 5) * 128 + (hq & 3) * 32 + (d & 31); }
    if (L < 768) { const int hh = (L - 512) >> 6, d = L & 63; return 512 + (d >> 5) * 128 + hh * 32 + (d & 31); }
    if (L < 1280) return L;
    const int isg = (L >= 1536), ch = L - 1280 - isg * 256; return (5 + (ch >> 7)) * 256 + isg * 128 + (ch & 127);
}
__device__ __forceinline__ void p0_transpose_item(const float* W, int K, int N, bf16_t* WT, int k0, int n0, int prow0, LAS float* scr, int lane) {
    float tv_[32];
#pragma unroll
    for (int i = 0; i < 32; ++i) { const int kk = 2 * i + (lane >> 5); tv_[i] = W[(size_t)(k0 + kk) * N + n0 + (lane & 31)]; }
#pragma unroll
    for (int i = 0; i < 32; ++i) { const int kk = 2 * i + (lane >> 5); scr[kk * 33 + (lane & 31)] = tv_[i]; }
    asm volatile("s_waitcnt lgkmcnt(0)" ::: "memory");
    const int c = lane & 7;
#pragma unroll
    for (int j = 0; j < 4; ++j) { const int n = (lane >> 3) + 8 * j; const LAS float* s = scr + (8 * c) * 33 + n;
        u32x4 o; o.x = pk2(s[0 * 33], s[1 * 33]); o.y = pk2(s[2 * 33], s[3 * 33]); o.z = pk2(s[4 * 33], s[5 * 33]); o.w = pk2(s[6 * 33], s[7 * 33]);
        *(u32x4*)(WT + (size_t)(prow0 + n) * K + k0 + 8 * c) = o; }
    asm volatile("s_waitcnt lgkmcnt(0)" ::: "memory");
}

__device__ __forceinline__ void p0_mod_item(const Frame& F0, int item, const float* c, const float* cctx, const float* w_mod, const float* b_mod, float* mod) {
    Frame F = F0; { const int t_ = mk_tid(); F.tid = t_; F.lane = t_ & 63; }
    LAS float* sc = (LAS float*)F.lds;
    LAS float* red = (LAS float*)(F.lds + 20480);
    const int l = item / 96, cg = item % 96;
    __syncthreads();
    for (int i = F.tid; i < 5 * 1024; i += NTHREADS) { const int r = i >> 10, k = i & 1023; const float v = r < 4 ? c[r * 1024 + k] : cctx[k]; sc[i] = v * fast_sigmoid(v); }
    __syncthreads();
    const int c4 = (F.lane & 15) * 4, ks = F.lane >> 4;
    float acc[5][4];
#pragma unroll
    for (int r = 0; r < 5; ++r)
#pragma unroll
        for (int e = 0; e < 4; ++e) acc[r][e] = 0.f;
    const float* wp = w_mod + (size_t)l * 1024 * 6144 + cg * 64 + c4;
    f32x4 wl[32];
#pragma unroll
    for (int i = 0; i < 32; ++i) wl[i] = *(const f32x4*)(wp + (size_t)(F.wave * 128 + 4 * i + ks) * 6144);
#pragma unroll
    for (int i = 0; i < 32; ++i) {
        const int k = F.wave * 128 + 4 * i + ks;
        const f32x4 w = wl[i];
#pragma unroll
        for (int r = 0; r < 5; ++r) { const float s = sc[r * 1024 + k]; acc[r][0] += s * w[0]; acc[r][1] += s * w[1]; acc[r][2] += s * w[2]; acc[r][3] += s * w[3]; }
    }
#pragma unroll
    for (int r = 0; r < 5; ++r)
#pragma unroll
        for (int e = 0; e < 4; ++e) { float v = acc[r][e]; v += __shfl_xor(v, 16); v += __shfl_xor(v, 32); acc[r][e] = v; }
    if (ks == 0) {
#pragma unroll
        for (int r = 0; r < 5; ++r)
#pragma unroll
            for (int e = 0; e < 4; ++e) red[(F.wave * 5 + r) * 64 + c4 + e] = acc[r][e];
    }
    __syncthreads();
    if (F.tid < 320) { const int r = F.tid >> 6, cc = F.tid & 63; float v = b_mod[l * 6144 + cg * 64 + cc];
#pragma unroll
        for (int w = 0; w < 8; ++w) v += red[(w * 5 + r) * 64 + cc];
        mod[(size_t)(l * 5 + r) * 6144 + cg * 64 + cc] = v; }
}

__device__ __forceinline__ void p0_ws_item(const Frame& F0, int item, const float* w_q, const float* sk, bf16_t* Ws_t) {
    Frame F = F0; { const int t_ = mk_tid(); F.tid = t_; F.lane = t_ & 63; }
    LAS float* sks = (LAS float*)F.lds;
    LAS float* wqs = (LAS float*)(F.lds + 128 * 132 * 4);
    const int l = item >> 8, hp = (item >> 4) & 15, j0 = (item & 15) * 64;
    __syncthreads();
    const float* skp = sk + ((size_t)l * 16 + hp) * 128 * 128;
    { f32x4 t0[8], t1[4];
#pragma unroll
      for (int it = 0; it < 8; ++it) { const int i = it * NTHREADS + F.tid, k = i >> 5, d4 = (i & 31) * 4; t0[it] = *(const f32x4*)(skp + k * 128 + d4); }
#pragma unroll
      for (int it = 0; it < 4; ++it) { const int i = it * NTHREADS + F.tid, j = i >> 5, d4 = (i & 31) * 4; t1[it] = *(const f32x4*)(w_q + ((size_t)l * 1024 + j0 + j) * 2048 + hp * 128 + d4); }
#pragma unroll
      for (int it = 0; it < 8; ++it) { const int i = it * NTHREADS + F.tid, k = i >> 5, d4 = (i & 31) * 4; *(LAS f32x4*)(sks + k * 132 + d4) = t0[it]; }
#pragma unroll
      for (int it = 0; it < 4; ++it) { const int i = it * NTHREADS + F.tid, j = i >> 5, d4 = (i & 31) * 4; *(LAS f32x4*)(wqs + j * 128 + d4) = t1[it]; } }
    __syncthreads();
    const int k = F.tid & 127, jg = F.tid >> 7;
    float acc[16];
#pragma unroll
    for (int i = 0; i < 16; ++i) acc[i] = 0.f;
    for (int d4 = 0; d4 < 128; d4 += 4) {
        const f32x4 a = *(const LAS f32x4*)(sks + k * 132 + d4);
#pragma unroll
        for (int jj = 0; jj < 16; ++jj) { const f32x4 b = *(const LAS f32x4*)(wqs + (jg * 16 + jj) * 128 + d4); acc[jj] += (a[0] * b[0] + a[1] * b[1]) + (a[2] * b[2] + a[3] * b[3]); }
    }
    bf16_t* dst = Ws_t + ((size_t)l * 2048 + hp * 128 + k) * 1024 + j0 + jg * 16;
    u32x4 o0, o1;
    o0.x = pk2(acc[0], acc[1]); o0.y = pk2(acc[2], acc[3]); o0.z = pk2(acc[4], acc[5]); o0.w = pk2(acc[6], acc[7]);
    o1.x = pk2(acc[8], acc[9]); o1.y = pk2(acc[10], acc[11]); o1.z = pk2(acc[12], acc[13]); o1.w = pk2(acc[14], acc[15]);
    *(u32x4*)dst = o0; *(u32x4*)(dst + 8) = o1;
}

__device__ __forceinline__ void p0_wc_item(const Frame& F0, int item, const float* w_pw, const float* b_pw, const float* w_out, bf16_t* Wout_t, float* bout) {
    Frame F = F0; { const int t_ = mk_tid(); F.tid = t_; F.lane = t_ & 63; }
    LAS float* wos = (LAS float*)F.lds;
    LAS float* wps = (LAS float*)(F.lds + 65536);
    const int l = item >> 6, nb = (item >> 2) & 15, kb = item & 3, n0 = nb * 64, kk0 = kb * 64;
    __syncthreads();
    { f32x4 t0[8], t1[8];
#pragma unroll
      for (int it = 0; it < 8; ++it) { const int i = it * NTHREADS + F.tid, j = i >> 4, n4 = (i & 15) * 4; t0[it] = *(const f32x4*)(w_out + ((size_t)l * 1024 + 768 + j) * 1024 + n0 + n4); }
#pragma unroll
      for (int it = 0; it < 8; ++it) { const int i = it * NTHREADS + F.tid, kk = i >> 6, j4 = (i & 63) * 4; t1[it] = *(const f32x4*)(w_pw + ((size_t)l * 256 + kk0 + kk) * 256 + j4); }
#pragma unroll
      for (int it = 0; it < 8; ++it) { const int i = it * NTHREADS + F.tid, j = i >> 4, n4 = (i & 15) * 4; *(LAS f32x4*)(wos + j * 64 + n4) = t0[it]; }
#pragma unroll
      for (int it = 0; it < 8; ++it) { const int i = it * NTHREADS + F.tid, kk = i >> 6, j4 = (i & 63) * 4; *(LAS f32x4*)(wps + kk * 256 + j4) = t1[it]; } }
    __syncthreads();
    const int n = F.tid & 63, kg = F.tid >> 6;
    float acc[8];
#pragma unroll
    for (int i = 0; i < 8; ++i) acc[i] = 0.f;
    for (int j4 = 0; j4 < 256; j4 += 4) {
        const float a0 = wos[(j4 + 0) * 64 + n], a1 = wos[(j4 + 1) * 64 + n], a2 = wos[(j4 + 2) * 64 + n], a3 = wos[(j4 + 3) * 64 + n];
#pragma unroll
        for (int i = 0; i < 8; ++i) { const f32x4 b = *(const LAS f32x4*)(wps + (kg * 8 + i) * 256 + j4); acc[i] += (a0 * b[0] + a1 * b[1]) + (a2 * b[2] + a3 * b[3]); }
    }
    u32x4 o; o.x = pk2(acc[0], acc[1]); o.y = pk2(acc[2], acc[3]); o.z = pk2(acc[4], acc[5]); o.w = pk2(acc[6], acc[7]);
    *(u32x4*)(Wout_t + ((size_t)l * 1024 + n0 + n) * 1024 + 768 + kk0 + kg * 8) = o;
    if (kb == 0 && kg == 0) { float b = 0.f; for (int j = 0; j < 256; ++j) b += b_pw[l * 256 + j] * wos[j * 64 + n]; bout[l * 1024 + n0 + n] = b; }
}


struct P0Ptrs { const float *c, *c_ctx, *w_mod, *b_mod, *peer_w_q, *peer_sk, *conv_w_pw, *conv_b_pw, *w_out, *w_in, *peer_u, *peer_v; float *mod, *bout; bf16_t *Ws_t, *Wout_t, *Win_t; unsigned char *u8, *v8; };
__device__ __forceinline__ void p0_block_items(const Frame& F, const P0Ptrs& P, int l, int which, int w, int nw) {
    const int n0 = (which & 1) ? 96 : 0, n1 = (which & 2) ? 256 : 0, n2 = (which & 4) ? 64 : 0;
    for (int it = w; it < n0 + n1 + n2; it += nw) {
        if (it < n0) p0_mod_item(F, l * 96 + it, P.c, P.c_ctx, P.w_mod, P.b_mod, P.mod);
        else if (it < n0 + n1) p0_ws_item(F, l * 256 + it - n0, P.peer_w_q, P.peer_sk, P.Ws_t);
        else p0_wc_item(F, l * 64 + it - n0 - n1, P.conv_w_pw, P.conv_b_pw, P.w_out, P.Wout_t, P.bout);
    }
    __syncthreads();
}
__device__ __forceinline__ void p0_wave_transposes(const Frame& F, const P0Ptrs& P, int l, int ww, int nww) {
    LAS float* scr = (LAS float*)(F.lds + F.wave * 16384);
    for (int it = ww; it < 896 + 384; it += nww) {
        if (it < 896) { const int kb = it / 56, nb = it % 56;
            p0_transpose_item(P.w_in + (size_t)l * 1024 * INW, 1024, INW, P.Win_t + (size_t)l * INW * 1024, kb * 64, nb * 32, inproj_phys(nb * 32), scr, F.lane); }
        else { const int r = it - 896, kb = r / 32, nb = r % 32;
            p0_transpose_item(P.w_out + (size_t)l * 1024 * 1024, 1024, 1024, P.Wout_t + (size_t)l * 1024 * 1024, kb * 64, nb * 32, nb * 32, scr, F.lane); }
    }
}
__device__ __forceinline__ void p0_convert_tables(const P0Ptrs& P, int l, int t, int nt) {
    const int n8 = 16384 * 128;
    const size_t base = (size_t)l * 16384 * 1024;
#pragma unroll 1
    for (int i0 = t; i0 < n8; i0 += 4 * nt) {
        f32x4 a[4][2], b[4][2];
#pragma unroll
        for (int k = 0; k < 4; ++k) { const int i = i0 + k * nt; if (i < n8) { const float* up = P.peer_u + base + (size_t)i * 8; const float* vp = P.peer_v + base + (size_t)i * 8;
            a[k][0] = *(const f32x4*)up; a[k][1] = *(const f32x4*)(up + 4); b[k][0] = *(const f32x4*)vp; b[k][1] = *(const f32x4*)(vp + 4); } }
#pragma unroll
        for (int k = 0; k < 4; ++k) { const int i = i0 + k * nt; if (i < n8) {
            const int e = i >> 7, cg8 = i & 127;
            { const f32x4 a0 = a[k][0] * U_SCALE, a1 = a[k][1] * U_SCALE; unsigned wu = 0u;
#ifdef TEST_SWAP_NIB
              wu = __builtin_amdgcn_cvt_scalef32_pk_fp4_f32(wu, a0[1], a0[0], 1.0f, 0); wu = __builtin_amdgcn_cvt_scalef32_pk_fp4_f32(wu, a0[3], a0[2], 1.0f, 1);
              wu = __builtin_amdgcn_cvt_scalef32_pk_fp4_f32(wu, a1[1], a1[0], 1.0f, 2); wu = __builtin_amdgcn_cvt_scalef32_pk_fp4_f32(wu, a1[3], a1[2], 1.0f, 3);
#else
              wu = __builtin_amdgcn_cvt_scalef32_pk_fp4_f32(wu, a0[0], a0[1], 1.0f, 0); wu = __builtin_amdgcn_cvt_scalef32_pk_fp4_f32(wu, a0[2], a0[3], 1.0f, 1);
              wu = __builtin_amdgcn_cvt_scalef32_pk_fp4_f32(wu, a1[0], a1[1], 1.0f, 2); wu = __builtin_amdgcn_cvt_scalef32_pk_fp4_f32(wu, a1[2], a1[3], 1.0f, 3);
#endif
              ((unsigned*)P.u8)[(((size_t)l * 4 + (cg8 >> 5)) * 16384 + e) * 32 + (cg8 & 31)] = wu; }
            const f32x4 b0 = b[k][0] * V_SCALE, b1 = b[k][1] * V_SCALE; unsigned wv = 0u;
            wv = __builtin_amdgcn_cvt_scalef32_pk_fp4_f32(wv, b0[0], b0[1], 1.0f, 0); wv = __builtin_amdgcn_cvt_scalef32_pk_fp4_f32(wv, b0[2], b0[3], 1.0f, 1);
            wv = __builtin_amdgcn_cvt_scalef32_pk_fp4_f32(wv, b1[0], b1[1], 1.0f, 2); wv = __builtin_amdgcn_cvt_scalef32_pk_fp4_f32(wv, b1[2], b1[3], 1.0f, 3);
            ((unsigned*)P.v8)[(((size_t)l * 4 + (cg8 >> 5)) * 16384 + e) * 32 + (cg8 & 31)] = wv; } }
    }
}
__device__ __forceinline__ int idle_worker(int nwg, int G, int c, int& nw) {
    const int rounds = (nwg + G - 1) / G, busy = nwg - (rounds - 1) * G;
    if (busy == G) { nw = G; return c; }
    nw = G - busy; return c >= busy ? c - busy : -1;
}
__device__ __forceinline__ void gmlp_chunk(const Frame& F, int chunk, const bf16_t* zg, const float* ln_g, const float* ln_b, const bf16_t* gws, const float* b_s, bf16_t* mix) {
    constexpr int VP = 272;
    LAS unsigned char* vT = F.lds;
    const int row0 = chunk * 128;
    __syncthreads();
    {
        const f32x4 gg = *(const f32x4*)(ln_g + F.lane * 4), bb = *(const f32x4*)(ln_b + F.lane * 4);
        u32x2 wpre[16];
#pragma unroll
        for (int r = 0; r < 16; ++r) wpre[r] = *(const u32x2*)(zg + (size_t)(row0 + F.wave * 16 + r) * 512 + 256 + F.lane * 4);
#pragma unroll
        for (int r = 0; r < 16; ++r) {
            const int q = F.wave * 16 + r;
            const u32x2 w = wpre[r];
            float a = bflo(w.x), b = bfhi(w.x), c = bflo(w.y), d = bfhi(w.y);
            const float mu = wave_sum((a + b) + (c + d)) * (1.0f / 256.0f);
            a -= mu; b -= mu; c -= mu; d -= mu;
            const float rstd = 1.0f / sqrtf(wave_sum((a * a + b * b) + (c * c + d * d)) * (1.0f / 256.0f) + EPS);
            LAS unsigned short* dst = (LAS unsigned short*)(vT + (F.lane * 4) * VP + q * 2);
            dst[0] = (unsigned short)f2bf(a * rstd * gg[0] + bb[0]);
            dst[VP / 2] = (unsigned short)f2bf(b * rstd * gg[1] + bb[1]);
            dst[VP] = (unsigned short)f2bf(c * rstd * gg[2] + bb[2]);
            dst[VP / 2 * 3] = (unsigned short)f2bf(d * rstd * gg[3] + bb[3]);
        }
    }
    __syncthreads();
    const int g = F.wave >> 1, ph = F.wave & 1, fr = F.lane & 15, fq = F.lane >> 4;
    f32x4 acc[4][4];
#pragma unroll
    for (int ct = 0; ct < 4; ++ct)
#pragma unroll
        for (int pt = 0; pt < 4; ++pt) acc[ct][pt] = (f32x4){0.f, 0.f, 0.f, 0.f};
#pragma unroll
    for (int ks = 0; ks < 4; ++ks) {
        bf16x8 af[4], bfr[4];
#pragma unroll
        for (int ct = 0; ct < 4; ++ct) af[ct] = *(const LAS bf16x8*)(vT + (g * 64 + ct * 16 + fr) * VP + (ks * 32 + fq * 8) * 2);
#pragma unroll
        for (int pt = 0; pt < 4; ++pt) bfr[pt] = *(const bf16x8*)(gws + ((size_t)(g * 128 + ph * 64 + pt * 16 + fr)) * 128 + ks * 32 + fq * 8);
#pragma unroll
        for (int ct = 0; ct < 4; ++ct)
#pragma unroll
            for (int pt = 0; pt < 4; ++pt) acc[ct][pt] = __builtin_amdgcn_mfma_f32_16x16x32_bf16(af[ct], bfr[pt], acc[ct][pt], 0, 0, 0);
    }
#pragma unroll
    for (int pt = 0; pt < 4; ++pt) {
        const int p = ph * 64 + pt * 16 + fr; const float bs = b_s[g * 128 + p];
        const bf16_t* urow = zg + (size_t)(row0 + p) * 512 + g * 64 + 4 * fq;
        bf16_t* orow = mix + (size_t)(row0 + p) * 1024 + 512 + g * 64 + 4 * fq;
#pragma unroll
        for (int ct = 0; ct < 4; ++ct) { const u32x2 u = *(const u32x2*)(urow + ct * 16); const f32x4 s = acc[ct][pt] + bs;
            u32x2 o; o.x = pk2(bflo(u.x) * s[0], bfhi(u.x) * s[1]); o.y = pk2(bflo(u.y) * s[2], bfhi(u.y) * s[3]); *(u32x2*)(orow + ct * 16) = o; }
    }
}

__device__ __forceinline__ void conv_tile(const Frame& F, int tile, const bf16_t* yc, const float* w_dw, const float* b_dw, const float* ln_g, const float* ln_b, bf16_t* mix) {
    LAS unsigned short* T = (LAS unsigned short*)F.lds;
    LAS float* red = (LAS float*)(F.lds + 158 * 512);
    LAS float* stat = red + 128 * 8;
    const int row0 = tile * 128; const bool lat = row0 < ML;
    const int Ls = lat ? SEQ : CTXL, t0 = lat ? (row0 & (SEQ - 1)) : ((row0 - ML) & (CTXL - 1));
    __syncthreads();
    {
        u32x4 tv[10];
#pragma unroll
        for (int it = 0; it < 10; ++it) { const int i = it * NTHREADS + F.tid, r = i >> 5, c8 = (i & 31) * 8; const int tt = t0 + r - 15;
            tv[it] = (u32x4){0u, 0u, 0u, 0u}; if (i < 158 * 32 && tt >= 0 && tt < Ls) tv[it] = *(const u32x4*)(yc + (size_t)(row0 + r - 15) * 256 + c8); }
#pragma unroll
        for (int it = 0; it < 10; ++it) { const int i = it * NTHREADS + F.tid, r = i >> 5, c8 = (i & 31) * 8; if (i < 158 * 32) *(LAS u32x4*)(T + r * 256 + c8) = tv[it]; }
    }
    __syncthreads();
    const int ch = F.tid & 255, half = F.tid >> 8;
    float wd[31];
#pragma unroll
    for (int j = 0; j < 31; ++j) wd[j] = w_dw[j * 256 + ch];
    const float bd = b_dw[ch];
    const float gg = ln_g[ch], bb = ln_b[ch];
#pragma unroll 1
    for (int bt = 0; bt < 2; ++bt) {
        float av[4][8];
#pragma unroll
        for (int g4 = 0; g4 < 4; ++g4) {
            const int rb = half * 64 + bt * 32 + g4 * 8;
#pragma unroll
            for (int k = 0; k < 8; ++k) av[g4][k] = bd;
#pragma unroll
            for (int i = 0; i < 38; ++i) { const float x = __uint_as_float(((unsigned)T[(rb + i) * 256 + ch]) << 16);
#pragma unroll
                for (int k = 0; k < 8; ++k) { const int j = i - k; if (j >= 0 && j < 31) av[g4][k] += x * wd[j]; } }
            float pr[16];
#pragma unroll
            for (int k = 0; k < 8; ++k) { pr[k] = av[g4][k]; pr[8 + k] = av[g4][k] * av[g4][k]; }
            const float tot = wave_reduce16(pr, F.lane);
            if ((F.lane & 3) == 0) { const int idx = (F.lane >> 2) & 15; red[((rb + (idx & 7)) * 4 + (F.wave & 3)) * 2 + (idx >> 3)] = tot; }
        }
        __syncthreads();
        if (F.tid < 64) { const int r = (F.tid >> 5) * 64 + bt * 32 + (F.tid & 31); float s_ = 0.f, q_ = 0.f;
#pragma unroll
            for (int w = 0; w < 4; ++w) { s_ += red[(r * 4 + w) * 2]; q_ += red[(r * 4 + w) * 2 + 1]; }
            const float mu = s_ * (1.0f / 256.0f); const float var = fmaxf(q_ * (1.0f / 256.0f) - mu * mu, 0.f);
            stat[r * 2] = mu; stat[r * 2 + 1] = 1.0f / sqrtf(var + EPS); }
        __syncthreads();
#pragma unroll
        for (int g4 = 0; g4 < 4; ++g4) {
            const int rb = half * 64 + bt * 32 + g4 * 8;
#pragma unroll
            for (int k = 0; k < 8; ++k) { const int r = rb + k; float y = (av[g4][k] - stat[r * 2]) * stat[r * 2 + 1] * gg + bb; y = y * fast_sigmoid(y);
                mix[(size_t)(row0 + r) * 1024 + 768 + ch] = (bf16_t)f2bf(y); }
        }
    }
}

struct TRow { u32x2 t[4]; };
__device__ __forceinline__ void trow_load(TRow& I, int row, int lane, const bf16_t* tb) {
    const bf16_t* p = tb + (size_t)row * D;
#pragma unroll
    for (int j = 0; j < 4; ++j) I.t[j] = *(const u32x2*)(p + j * 256 + lane * 4);
}
__device__ __forceinline__ float ln1_apply(f32x4 (&v)[4], const TRow& I, const f32x4 (&lg)[4], const f32x4 (&lb)[4]) {
    float s = 0.f;
#pragma unroll
    for (int j = 0; j < 4; ++j) { const u32x2 w = I.t[j]; v[j] = (f32x4){bflo(w.x), bfhi(w.x), bflo(w.y), bfhi(w.y)}; s += (v[j][0] + v[j][1]) + (v[j][2] + v[j][3]); }
    const float mu = wave_sum(s) * (1.0f / 1024.0f); float q = 0.f;
#pragma unroll
    for (int j = 0; j < 4; ++j) { v[j] = v[j] - mu; q += (v[j][0] * v[j][0] + v[j][1] * v[j][1]) + (v[j][2] * v[j][2] + v[j][3] * v[j][3]); }
    const float rstd = 1.0f / sqrtf(wave_sum(q) * (1.0f / 1024.0f) + EPS);
    s = 0.f;
#pragma unroll
    for (int j = 0; j < 4; ++j) { v[j] = v[j] * rstd * lg[j] + lb[j]; s += (v[j][0] + v[j][1]) + (v[j][2] + v[j][3]); }
    return s;
}
__device__ __forceinline__ void adaln_store(f32x4 (&v)[4], float s, const f32x4 (&sh)[4], const f32x4 (&sc)[4], bf16_t* hrow, int lane, unsigned char* h8row = nullptr) {
    const float mu = wave_sum(s) * (1.0f / 1024.0f); float q = 0.f;
#pragma unroll
    for (int j = 0; j < 4; ++j) { v[j] = v[j] - mu; q += (v[j][0] * v[j][0] + v[j][1] * v[j][1]) + (v[j][2] * v[j][2] + v[j][3] * v[j][3]); }
    const float rstd = 1.0f / sqrtf(wave_sum(q) * (1.0f / 1024.0f) + EPS);
#pragma unroll
    for (int j = 0; j < 4; ++j) { const f32x4 o = v[j] * rstd * (sc[j] + 1.0f) + sh[j]; u32x2 w; w.x = pk2(o[0], o[1]); w.y = pk2(o[2], o[3]); *(u32x2*)(hrow + j * 256 + lane * 4) = w;
        if (h8row) { int w8 = 0; w8 = __builtin_amdgcn_cvt_pk_fp8_f32(o[0] * H_SCALE, o[1] * H_SCALE, w8, false); w8 = __builtin_amdgcn_cvt_pk_fp8_f32(o[2] * H_SCALE, o[3] * H_SCALE, w8, true); *(int*)(h8row + j * 256 + lane * 4) = w8; } }
}
__device__ __forceinline__ void load_par(f32x4 (&p)[4], const float* src, int lane) {
#pragma unroll
    for (int j = 0; j < 4; ++j) p[j] = *(const f32x4*)(src + j * 256 + lane * 4);
}
__device__ __forceinline__ void row_store(const f32x4 v, int row, int col, float* of, bf16_t* ob, float* oc) {
    if (row >= ML) *(f32x4*)(oc + (size_t)(row - ML) * D + col) = v;
    else if (ob) { u32x2 w; w.x = pk2(v[0], v[1]); w.y = pk2(v[2], v[3]); *(u32x2*)(ob + (size_t)row * D + col) = w; }
    else *(f32x4*)(of + (size_t)row * D + col) = v;
}
#define TK_INS(t, x) do { float xx_ = (x); _Pragma("unroll") for (int i_ = 0; i_ < 16; ++i_) { const float hi_ = fmaxf(t[i_], xx_); xx_ = fminf(t[i_], xx_); t[i_] = hi_; } } while (0)
__device__ __forceinline__ float dot16_fp8(const u32x4 r, const float (&hv)[16]) {
    f32x2 a = (f32x2){0.f, 0.f}, b = (f32x2){0.f, 0.f};
#pragma unroll
    for (int j = 0; j < 4; ++j) { const f32x2 lo = __builtin_amdgcn_cvt_pk_f32_fp8((int)r[j], false), hi = __builtin_amdgcn_cvt_pk_f32_fp8((int)r[j], true);
        a = __builtin_elementwise_fma(lo, (f32x2){hv[4 * j], hv[4 * j + 1]}, a); b = __builtin_elementwise_fma(hi, (f32x2){hv[4 * j + 2], hv[4 * j + 3]}, b); }
    a = a + b;
    return a[0] + a[1];
}
typedef _Float16 h2_t __attribute__((ext_vector_type(2)));
__device__ __forceinline__ float dot16_fp8_h(const u32x4 r, const h2_t (&hv)[8], const float scale) {
    float a = 0.f, b = 0.f;
#pragma unroll
    for (int j = 0; j < 4; ++j) { const h2_t lo = __builtin_amdgcn_cvt_scalef32_pk_f16_fp8((int)r[j], scale, false), hi = __builtin_amdgcn_cvt_scalef32_pk_f16_fp8((int)r[j], scale, true);
        a = __builtin_amdgcn_fdot2(lo, hv[2 * j], a, false); b = __builtin_amdgcn_fdot2(hi, hv[2 * j + 1], b, false); }
    return a + b;
}
__device__ __forceinline__ void axpy16_fp8(float (&acc)[16], const float w, const u32x4 r) {
    const f32x2 w2 = (f32x2){w, w};
#pragma unroll
    for (int j = 0; j < 4; ++j) { const f32x2 lo = __builtin_amdgcn_cvt_pk_f32_fp8((int)r[j], false), hi = __builtin_amdgcn_cvt_pk_f32_fp8((int)r[j], true);
        const f32x2 x = __builtin_elementwise_fma(w2, lo, (f32x2){acc[4 * j], acc[4 * j + 1]}), y = __builtin_elementwise_fma(w2, hi, (f32x2){acc[4 * j + 2], acc[4 * j + 3]});
        acc[4 * j] = x[0]; acc[4 * j + 1] = x[1]; acc[4 * j + 2] = y[0]; acc[4 * j + 3] = y[1]; }
}
#define TK_CE(a, b) do { const float hi_ = fmaxf(a, b), lo_ = fminf(a, b); a = hi_; b = lo_; } while (0)
__device__ __forceinline__ void tk_sort16(float (&v)[16]) {
    TK_CE(v[0], v[1]); TK_CE(v[2], v[3]); TK_CE(v[0], v[2]); TK_CE(v[1], v[3]); TK_CE(v[1], v[2]); TK_CE(v[4], v[5]); TK_CE(v[6], v[7]); TK_CE(v[4], v[6]);
    TK_CE(v[5], v[7]); TK_CE(v[5], v[6]); TK_CE(v[0], v[4]); TK_CE(v[2], v[6]); TK_CE(v[2], v[4]); TK_CE(v[1], v[5]); TK_CE(v[3], v[7]); TK_CE(v[3], v[5]);
    TK_CE(v[1], v[2]); TK_CE(v[3], v[4]); TK_CE(v[5], v[6]); TK_CE(v[8], v[9]); TK_CE(v[10], v[11]); TK_CE(v[8], v[10]); TK_CE(v[9], v[11]); TK_CE(v[9], v[10]);
    TK_CE(v[12], v[13]); TK_CE(v[14], v[15]); TK_CE(v[12], v[14]); TK_CE(v[13], v[15]); TK_CE(v[13], v[14]); TK_CE(v[8], v[12]); TK_CE(v[10], v[14]); TK_CE(v[10], v[12]);
    TK_CE(v[9], v[13]); TK_CE(v[11], v[15]); TK_CE(v[11], v[13]); TK_CE(v[9], v[10]); TK_CE(v[11], v[12]); TK_CE(v[13], v[14]); TK_CE(v[0], v[8]); TK_CE(v[4], v[12]);
    TK_CE(v[4], v[8]); TK_CE(v[2], v[10]); TK_CE(v[6], v[14]); TK_CE(v[6], v[10]); TK_CE(v[2], v[4]); TK_CE(v[6], v[8]); TK_CE(v[10], v[12]); TK_CE(v[1], v[9]);
    TK_CE(v[5], v[13]); TK_CE(v[5], v[9]); TK_CE(v[3], v[11]); TK_CE(v[7], v[15]); TK_CE(v[7], v[11]); TK_CE(v[3], v[5]); TK_CE(v[7], v[9]); TK_CE(v[11], v[13]);
    TK_CE(v[1], v[2]); TK_CE(v[3], v[4]); TK_CE(v[5], v[6]); TK_CE(v[7], v[8]); TK_CE(v[9], v[10]); TK_CE(v[11], v[12]); TK_CE(v[13], v[14]);
}
__device__ __forceinline__ void tk_bmerge16(float (&v)[16]) {
#pragma unroll
    for (int j = 8; j > 0; j >>= 1)
#pragma unroll
        for (int i = 0; i < 16; ++i) { const int l = i ^ j; if (l > i) TK_CE(v[i], v[l]); }
}
__device__ __forceinline__ void tk_merge_top(float (&t)[16], const float (&s)[16]) {
#pragma unroll
    for (int i = 0; i < 16; ++i) t[i] = fmaxf(t[i], s[15 - i]);
    tk_bmerge16(t);
}
__device__ __forceinline__ void peer_topk_wave(const Frame& F, int b0, int nb, int bstep, const unsigned short* s, unsigned short* tk_idx, float* tk_gate) {
    LAS float* l1 = (LAS float*)F.lds + (F.wave * 64) * 16;
    LAS unsigned char* xt = F.lds + 32768 + F.wave * 8192;
    const int lane = F.lane, oj = lane >> 3, piece = lane & 7;
    u32x4 ld[16];
#define TK_ISSUE(bb) do { const int r0_ = (bb) * 4; _Pragma("unroll") for (int q_ = 0; q_ < 16; ++q_) { const int o_ = 8 * (q_ & 7) + oj; \
        ld[q_] = *(const u32x4*)(s + (size_t)(r0_ + (o_ >> 4)) * 2048 + (o_ & 15) * 128 + (q_ >> 3) * 64 + piece * 8); } } while (0)
#ifndef TK_NOPREFETCH
    if (b0 < nb) TK_ISSUE(b0);
#endif
#pragma unroll 1
    for (int bb = b0; bb < nb; bb += bstep) {
        const int row0 = bb * 4;
#ifdef TK_NOPREFETCH
        TK_ISSUE(bb);
#endif
        float t[16];
#pragma unroll
        for (int hf = 0; hf < 2; ++hf) {
#pragma unroll
            for (int j = 0; j < 8; ++j) { const int o = 8 * j + oj; *(LAS u32x4*)(xt + o * 128 + ((piece ^ (o & 7)) * 16)) = ld[hf * 8 + j]; }
#pragma unroll
            for (int qd = 0; qd < 4; ++qd) {
                float v[16];
#ifdef TK_F32
#pragma unroll
                for (int pp = 0; pp < 4; ++pp) { const f32x4 x = *(const f32x4*)((const float*)s + (size_t)(row0 + (lane >> 4)) * 2048 + (lane & 15) * 128 + hf * 64 + qd * 16 + pp * 4);
#pragma unroll
                    for (int e = 0; e < 4; ++e) { const unsigned k = (unsigned)(hf * 64 + qd * 16 + pp * 4 + e); v[pp * 4 + e] = __uint_as_float((__float_as_uint((float)(_Float16)x[e]) & ~0x7Fu) | (127u - k)); } }
                if (false) {
#else
                {
#endif
#pragma unroll
#ifdef TK_DIRECT
                for (int pp = 0; pp < 2; ++pp) { const int p = qd * 2 + pp; const u32x4 x = *(const u32x4*)(s + (size_t)(row0 + (lane >> 4)) * 2048 + (lane & 15) * 128 + hf * 64 + p * 8);
#else
                for (int pp = 0; pp < 2; ++pp) { const int p = qd * 2 + pp; const u32x4 x = *(const LAS u32x4*)(xt + lane * 128 + ((p ^ (lane & 7)) * 16));
#endif
#pragma unroll
                    for (int e = 0; e < 4; ++e) { const unsigned wv_ = x[e];
                        const float f0 = (float)__builtin_bit_cast(_Float16, (unsigned short)(wv_ & 0xffffu)), f1 = (float)__builtin_bit_cast(_Float16, (unsigned short)(wv_ >> 16));
                        const unsigned k0 = (unsigned)(hf * 64 + p * 8 + e * 2);
                        v[pp * 8 + e * 2] = __uint_as_float((__float_as_uint(f0) & ~0x7Fu) | (127u - k0)); v[pp * 8 + e * 2 + 1] = __uint_as_float((__float_as_uint(f1) & ~0x7Fu) | (126u - k0)); } }
                }
                tk_sort16(v);
                if (hf == 0 && qd == 0) {
#pragma unroll
                    for (int i = 0; i < 16; ++i) t[i] = v[i];
                } else tk_merge_top(t, v);
            }
        }
#pragma unroll
        for (int i = 0; i < 4; ++i) *(LAS f32x4*)(l1 + lane * 16 + i * 4) = (f32x4){t[4 * i], t[4 * i + 1], t[4 * i + 2], t[4 * i + 3]};
#ifndef TK_NOPREFETCH
        if (bb + bstep < nb) TK_ISSUE(bb + bstep);
#endif
        {
            const LAS float* la = l1 + (lane & ~1) * 16; const LAS float* lb_ = l1 + (lane | 1) * 16;
            float a[16], b[16];
#pragma unroll
            for (int i = 0; i < 4; ++i) { const f32x4 x = *(const LAS f32x4*)(la + 4 * i), y = *(const LAS f32x4*)(lb_ + 4 * i);
                a[4 * i] = x[0]; a[4 * i + 1] = x[1]; a[4 * i + 2] = x[2]; a[4 * i + 3] = x[3]; b[4 * i] = y[0]; b[4 * i + 1] = y[1]; b[4 * i + 2] = y[2]; b[4 * i + 3] = y[3]; }
#define TK_CAND(i, j) __uint_as_float((__float_as_uint(a[i] + b[j]) & ~0xFFu) | (unsigned)(255 - ((i) * 16 + (j))))
            float x[16];
#pragma unroll
            for (int j = 0; j < 16; ++j) t[j] = TK_CAND(0, j);
#pragma unroll
            for (int j = 0; j < 8; ++j) { x[j] = TK_CAND(1, j); x[8 + j] = TK_CAND(15 - j, 0); }
            tk_bmerge16(x); tk_merge_top(t, x);
            x[0] = TK_CAND(2, 0); x[1] = TK_CAND(2, 1); x[2] = TK_CAND(2, 2); x[3] = TK_CAND(2, 3); x[4] = TK_CAND(2, 4);
            x[5] = TK_CAND(3, 0); x[6] = TK_CAND(3, 1); x[7] = TK_CAND(3, 2); x[8] = TK_CAND(3, 3);
            x[9] = TK_CAND(4, 0); x[10] = TK_CAND(4, 1); x[11] = TK_CAND(4, 2);
            x[12] = TK_CAND(5, 0); x[13] = TK_CAND(5, 1); x[14] = TK_CAND(6, 0); x[15] = TK_CAND(6, 1);
            tk_sort16(x); tk_merge_top(t, x);
            TK_INS(t, TK_CAND(7, 0)); TK_INS(t, TK_CAND(7, 1));
#undef TK_CAND
            float e[16], sum = 0.f;
#pragma unroll
            for (int i = 0; i < 16; ++i) { e[i] = __builtin_amdgcn_exp2f((t[i] - t[0]) * 1.4426950408889634f); sum += e[i]; }
            const float inv = 1.0f / sum;
            if ((lane & 1) == 0) {
                const size_t base = ((size_t)(row0 + (lane >> 4)) * 8 + ((lane & 15) >> 1)) * 16;
                int ex[16];
#pragma unroll
                for (int i = 0; i < 16; ++i) {
                    const int pos = 255 - (int)(__float_as_uint(t[i]) & 0xFFu);
                    const int ea = 127 - (int)(__float_as_uint(la[pos >> 4]) & 0x7Fu), eb = 127 - (int)(__float_as_uint(lb_[pos & 15]) & 0x7Fu);
                    ex[i] = ea * 128 + eb;
                }
#pragma unroll
                for (int i = 0; i < 2; ++i) *(u32x4*)(tk_idx + base + 8 * i) = (u32x4){(unsigned)ex[8 * i] | ((unsigned)ex[8 * i + 1] << 16), (unsigned)ex[8 * i + 2] | ((unsigned)ex[8 * i + 3] << 16), (unsigned)ex[8 * i + 4] | ((unsigned)ex[8 * i + 5] << 16), (unsigned)ex[8 * i + 6] | ((unsigned)ex[8 * i + 7] << 16)};
#pragma unroll
                for (int i = 0; i < 4; ++i) *(f32x4*)(tk_gate + base + 4 * i) = (f32x4){e[4 * i] * inv, e[4 * i + 1] * inv, e[4 * i + 2] * inv, e[4 * i + 3] * inv};
            }
        }
    }
#undef TK_ISSUE
}

__device__ __forceinline__ int q_next(const Frame& F, unsigned* qword) {
    volatile LAS int* bw = (volatile LAS int*)(F.lds + MISC_OFF + 64);
    __syncthreads();
    if (F.tid == 0) *bw = (int)__hip_atomic_fetch_add(qword, 1u, __ATOMIC_RELAXED, __HIP_MEMORY_SCOPE_AGENT);
    __syncthreads();
    return *bw;
}

typedef int v8i_t __attribute__((ext_vector_type(8)));
__device__ __forceinline__ void peer_u_item(const Frame& F, int rowb, int NTW, int slice, const unsigned char* h8, const unsigned short* tk_idx, const unsigned char* u4s  , bf16_t* pact) {
    const int lane = F.lane, c = lane & 7, ps = lane >> 3, i = lane & 15, g = lane >> 4;
    LAS unsigned char* buf = F.lds + F.wave * 16384;
    LAS unsigned char* sml = F.lds + RING_BYTES + F.wave * 1024;
    const int rdb = (8 * (i & 7) + (i >> 3)) * 128, rd0 = rdb + ((g ^ (i & 7)) * 16), rd1 = rdb + (((4 + g) ^ (i & 7)) * 16);
    const unsigned lds_rd0_ = (unsigned)(size_t)(buf + rd0), lds_rd1_ = (unsigned)(size_t)(buf + rd1);
    const unsigned ids_rd_ = (unsigned)(size_t)(sml + 16 * ps), hb_rd_ = (unsigned)(size_t)(sml + 512 + 16 * g);
#define PU_DMA_IDS(row, par) __builtin_amdgcn_global_load_lds((const unsigned*)(tk_idx + (size_t)(row) * 128 + lane * 2), (LAS unsigned*)(sml + (par) * 256), 4, 0, 0)
#define PU_DMA_HB(row, par) __builtin_amdgcn_global_load_lds((const unsigned*)(h8 + (size_t)(row) * D + slice * 256 + lane * 4), (LAS unsigned*)(sml + 512 + (par) * 256), 4, 0, 0)
#define PU_RD_IDS(dst, hf, par) asm volatile("ds_read_b128 %0, %1\n\ts_waitcnt lgkmcnt(0)" : "=&v"(dst) : "v"(ids_rd_ + (unsigned)((par) * 256 + (hf) * 128)) : "memory")
#define PU_ISSUE(hf, idv) do { _Pragma("unroll") for (int m = 0; m < 8; ++m) { const unsigned idw_ = idv[m >> 1]; const unsigned e_ = (m & 1) ? (idw_ >> 16) : (idw_ & 0xffffu); \
        __builtin_amdgcn_global_load_lds((const unsigned*)(u4s + (size_t)e_ * 128 + ((c ^ m) * 16)), (LAS unsigned*)(buf + (hf) * 8192 + m * 1024), 16, 0, 0); } } while (0)
#define PU_RD(dst, off) asm volatile("ds_read_b128 %0, %1 offset:%2" : "=v"(dst) : "v"(lds_rd0_), "n"(off))
#define PU_RD1(dst, off) asm volatile("ds_read_b128 %0, %1 offset:%2" : "=v"(dst) : "v"(lds_rd1_), "n"(off))
#define PU_HALF(hf) do { u32x4 a0_[4], a1_[4]; \
        PU_RD(a0_[0], (hf) * 8192 + 0); PU_RD1(a1_[0], (hf) * 8192 + 0); PU_RD(a0_[1], (hf) * 8192 + 256); PU_RD1(a1_[1], (hf) * 8192 + 256); \
        PU_RD(a0_[2], (hf) * 8192 + 512); PU_RD1(a1_[2], (hf) * 8192 + 512); PU_RD(a0_[3], (hf) * 8192 + 768); PU_RD1(a1_[3], (hf) * 8192 + 768); \
        asm volatile("s_waitcnt lgkmcnt(6)" : "+v"(a0_[0]), "+v"(a1_[0])); asm volatile("s_waitcnt lgkmcnt(4)" : "+v"(a0_[1]), "+v"(a1_[1])); \
        asm volatile("s_waitcnt lgkmcnt(2)" : "+v"(a0_[2]), "+v"(a1_[2])); asm volatile("s_waitcnt lgkmcnt(0)" : "+v"(a0_[3]), "+v"(a1_[3])); \
        _Pragma("unroll") for (int G = 0; G < 4; ++G) { f32x4 acc_ = (f32x4){0.f, 0.f, 0.f, 0.f}; \
        acc_ = __builtin_amdgcn_mfma_scale_f32_16x16x128_f8f6f4((v8i_t){(int)a0_[G][0], (int)a0_[G][1], (int)a0_[G][2], (int)a0_[G][3], 0, 0, 0, 0}, hb0, acc_, 4  , 0  , 0, 0x7F7F7F7F, 0, 0x7F7F7F7F); \
        acc_ = __builtin_amdgcn_mfma_scale_f32_16x16x128_f8f6f4((v8i_t){(int)a1_[G][0], (int)a1_[G][1], (int)a1_[G][2], (int)a1_[G][3], 0, 0, 0, 0}, hb1, acc_, 4, 0, 0, 0x7F7F7F7F, 0, 0x7F7F7F7F); \
        asm volatile("" : "+v"(acc_));       \
        accs[hf][G] = acc_; } } while (0)
    asm volatile("s_waitcnt lgkmcnt(0)" ::: "memory");
    PU_DMA_IDS(rowb, 0);
    asm volatile("s_waitcnt vmcnt(0)" ::: "memory");
    { u32x4 id0, id1; PU_RD_IDS(id0, 0, 0); PU_RD_IDS(id1, 1, 0);
      PU_ISSUE(0, id0); PU_DMA_HB(rowb, 0); PU_DMA_IDS(rowb + (NTW > 1 ? 1 : 0), 1); PU_ISSUE(1, id1); }
#pragma unroll 1
    for (int ti = 0; ti < NTW; ++ti) {
        const int row = rowb + ti, par = ti & 1; const bool last = ti + 1 >= NTW;
        f32x4 accs[2][4];
        asm volatile("s_waitcnt vmcnt(8)" ::: "memory");
        v8i_t hb0, hb1;
        { u32x4 x0, x1, x2, x3;
          asm volatile("ds_read_b128 %0, %4\n\tds_read_b128 %1, %4 offset:64\n\tds_read_b128 %2, %4 offset:128\n\tds_read_b128 %3, %4 offset:192\n\ts_waitcnt lgkmcnt(0)"
                       : "=&v"(x0), "=&v"(x1), "=&v"(x2), "=&v"(x3) : "v"(hb_rd_ + (unsigned)(par * 256)) : "memory");
          hb0 = (v8i_t){(int)x0[0], (int)x0[1], (int)x0[2], (int)x0[3], (int)x1[0], (int)x1[1], (int)x1[2], (int)x1[3]};
          hb1 = (v8i_t){(int)x2[0], (int)x2[1], (int)x2[2], (int)x2[3], (int)x3[0], (int)x3[1], (int)x3[2], (int)x3[3]}; }
        PU_HALF(0);
        if (!last) { u32x4 idn; PU_RD_IDS(idn, 0, par ^ 1); PU_ISSUE(0, idn); }
        if (last) asm volatile("s_waitcnt vmcnt(0)" ::: "memory"); else asm volatile("s_waitcnt vmcnt(8)" ::: "memory");
        PU_HALF(1);
        { u32x2 o = (u32x2){0u, 0u};
#pragma unroll
          for (int hf = 0; hf < 2; ++hf)
#pragma unroll
              for (int G = 0; G < 4; ++G) { const bool sel = (i == 4 * hf + G); const unsigned lo_ = pk2(accs[hf][G][0], accs[hf][G][1]), hi_ = pk2(accs[hf][G][2], accs[hf][G][3]); o.x = sel ? lo_ : o.x; o.y = sel ? hi_ : o.y; }
          if (i < 8) *(u32x2*)(pact + ((size_t)slice * MT + row) * 128 + 16 * i + 4 * g) = o; }
        if (!last) { u32x4 idn; PU_RD_IDS(idn, 1, par ^ 1); PU_DMA_HB(row + 1, par ^ 1); PU_DMA_IDS(row + (ti + 2 < NTW ? 2 : 1), par); PU_ISSUE(1, idn); }
    }
#undef PU_DMA_IDS
#undef PU_DMA_HB
#undef PU_RD_IDS
#undef PU_ISSUE
#undef PU_HALF
#undef PU_RD
#undef PU_RD1
}

__device__ __forceinline__ void peer_v_item(const Frame& F, int rowb, int NTW, int slice, const unsigned short* tk_idx, const unsigned char* w8, const unsigned* wscale, const unsigned char* v4s, bf16_t* fbuf) {
    const int lane = F.lane, c = lane & 7, ps = lane >> 3, idx = lane & 15, g = lane >> 4;
    LAS unsigned char* buf = F.lds + F.wave * 16384;
    LAS unsigned char* sml = F.lds + RING_BYTES + F.wave * 1024;
    const int rho = 8 * (idx & 7) + 4 * (g & 1) + 2 * (g >> 1) + (idx >> 3);
    unsigned adr[8];
#pragma unroll
    for (int j = 0; j < 8; ++j) adr[j] = (unsigned)(size_t)(buf + rho * 128 + ((j ^ (idx & 7)) * 16));
    const unsigned ids_rd_ = (unsigned)(size_t)(sml + 16 * (ps & 3) + 128 * (ps >> 2)), wb_rd_ = (unsigned)(size_t)(sml + 512 + 32 * g);
#define PV_DMA_IDS(row, par) __builtin_amdgcn_global_load_lds((const unsigned*)(tk_idx + (size_t)(row) * 128 + lane * 2), (LAS unsigned*)(sml + (par) * 256), 4, 0, 0)
#define PV_DMA_WB(row, par) __builtin_amdgcn_global_load_lds(lane < 32 ? (const unsigned*)(w8 + (size_t)(row) * 128 + lane * 4) : (wscale + (row)), (LAS unsigned*)(sml + 512 + (par) * 256), 4, 0, 0)
#define PV_RD_IDS(dst, h, par) asm volatile("ds_read_b128 %0, %1\n\ts_waitcnt lgkmcnt(0)" : "=&v"(dst) : "v"(ids_rd_ + (unsigned)((par) * 256 + (h) * 64)) : "memory")
#define PV_ISSUE(h, idv) do { _Pragma("unroll") for (int m = 0; m < 8; ++m) { const unsigned idw_ = idv[m >> 1]; const unsigned e_ = (m & 1) ? (idw_ >> 16) : (idw_ & 0xffffu); \
        __builtin_amdgcn_global_load_lds((const unsigned*)(v4s + (size_t)e_ * 128 + ((c ^ m) * 16)), (LAS unsigned*)(buf + (h) * 8192 + m * 1024), 16, 0, 0); } } while (0)
    asm volatile("s_waitcnt lgkmcnt(0)" ::: "memory");
    PV_DMA_IDS(rowb, 0);
    asm volatile("s_waitcnt vmcnt(0)" ::: "memory");
    { u32x4 id0, id1; PV_RD_IDS(id0, 0, 0); PV_RD_IDS(id1, 1, 0);
      PV_ISSUE(0, id0); PV_DMA_WB(rowb, 0); PV_DMA_IDS(rowb + (NTW > 1 ? 1 : 0), 1); PV_ISSUE(1, id1); }
#pragma unroll 1
    for (int ti = 0; ti < NTW; ++ti) {
        const int row = rowb + ti, par = ti & 1; const bool last = ti + 1 >= NTW;
        f32x4 acc[16];
        asm volatile("s_waitcnt vmcnt(8)" ::: "memory");
        v8i_t wb; int wsc;
        { u32x4 x0, x1; unsigned x2;
          asm volatile("ds_read_b128 %0, %3\n\tds_read_b128 %1, %3 offset:16\n\tds_read_b32 %2, %4\n\ts_waitcnt lgkmcnt(0)"
                       : "=&v"(x0), "=&v"(x1), "=&v"(x2) : "v"(wb_rd_ + (unsigned)(par * 256)), "v"((unsigned)(size_t)(sml + 512 + 128) + (unsigned)(par * 256)) : "memory");
          wb = (v8i_t){(int)x0[0], (int)x0[1], (int)x0[2], (int)x0[3], (int)x1[0], (int)x1[1], (int)x1[2], (int)x1[3]}; wsc = (int)x2; }
        { u32x2 t_[8];
        asm volatile("ds_read_b64_tr_b4 %0, %1 offset:%2" : "=v"(t_[0]) : "v"(adr[0]), "n"(0*8192 + 0));
        asm volatile("ds_read_b64_tr_b4 %0, %1 offset:%2" : "=v"(t_[1]) : "v"(adr[0]), "n"(0*8192 + 8));
        asm volatile("ds_read_b64_tr_b4 %0, %1 offset:%2" : "=v"(t_[2]) : "v"(adr[1]), "n"(0*8192 + 0));
        asm volatile("ds_read_b64_tr_b4 %0, %1 offset:%2" : "=v"(t_[3]) : "v"(adr[1]), "n"(0*8192 + 8));
        asm volatile("ds_read_b64_tr_b4 %0, %1 offset:%2" : "=v"(t_[4]) : "v"(adr[2]), "n"(0*8192 + 0));
        asm volatile("ds_read_b64_tr_b4 %0, %1 offset:%2" : "=v"(t_[5]) : "v"(adr[2]), "n"(0*8192 + 8));
        asm volatile("ds_read_b64_tr_b4 %0, %1 offset:%2" : "=v"(t_[6]) : "v"(adr[3]), "n"(0*8192 + 0));
        asm volatile("ds_read_b64_tr_b4 %0, %1 offset:%2" : "=v"(t_[7]) : "v"(adr[3]), "n"(0*8192 + 8));
        asm volatile("s_waitcnt lgkmcnt(6)" : "+v"(t_[0]), "+v"(t_[1])); asm volatile("s_waitcnt lgkmcnt(4)" : "+v"(t_[2]), "+v"(t_[3]));
        asm volatile("s_waitcnt lgkmcnt(2)" : "+v"(t_[4]), "+v"(t_[5])); asm volatile("s_waitcnt lgkmcnt(0)" : "+v"(t_[6]), "+v"(t_[7]));
        acc[0] = __builtin_amdgcn_mfma_scale_f32_16x16x128_f8f6f4((v8i_t){(int)t_[0].x, (int)t_[0].y, 0, 0, 0, 0, 0, 0}, wb, (f32x4){0.f, 0.f, 0.f, 0.f}, 4, 0, 0, 0x7F7F7F7F, 0, wsc);
        acc[1] = __builtin_amdgcn_mfma_scale_f32_16x16x128_f8f6f4((v8i_t){(int)t_[1].x, (int)t_[1].y, 0, 0, 0, 0, 0, 0}, wb, (f32x4){0.f, 0.f, 0.f, 0.f}, 4, 0, 0, 0x7F7F7F7F, 0, wsc);
        acc[2] = __builtin_amdgcn_mfma_scale_f32_16x16x128_f8f6f4((v8i_t){(int)t_[2].x, (int)t_[2].y, 0, 0, 0, 0, 0, 0}, wb, (f32x4){0.f, 0.f, 0.f, 0.f}, 4, 0, 0, 0x7F7F7F7F, 0, wsc);
        acc[3] = __builtin_amdgcn_mfma_scale_f32_16x16x128_f8f6f4((v8i_t){(int)t_[3].x, (int)t_[3].y, 0, 0, 0, 0, 0, 0}, wb, (f32x4){0.f, 0.f, 0.f, 0.f}, 4, 0, 0, 0x7F7F7F7F, 0, wsc);
        acc[4] = __builtin_amdgcn_mfma_scale_f32_16x16x128_f8f6f4((v8i_t){(int)t_[4].x, (int)t_[4].y, 0, 0, 0, 0, 0, 0}, wb, (f32x4){0.f, 0.f, 0.f, 0.f}, 4, 0, 0, 0x7F7F7F7F, 0, wsc);
        acc[5] = __builtin_amdgcn_mfma_scale_f32_16x16x128_f8f6f4((v8i_t){(int)t_[5].x, (int)t_[5].y, 0, 0, 0, 0, 0, 0}, wb, (f32x4){0.f, 0.f, 0.f, 0.f}, 4, 0, 0, 0x7F7F7F7F, 0, wsc);
        acc[6] = __builtin_amdgcn_mfma_scale_f32_16x16x128_f8f6f4((v8i_t){(int)t_[6].x, (int)t_[6].y, 0, 0, 0, 0, 0, 0}, wb, (f32x4){0.f, 0.f, 0.f, 0.f}, 4, 0, 0, 0x7F7F7F7F, 0, wsc);
        acc[7] = __builtin_amdgcn_mfma_scale_f32_16x16x128_f8f6f4((v8i_t){(int)t_[7].x, (int)t_[7].y, 0, 0, 0, 0, 0, 0}, wb, (f32x4){0.f, 0.f, 0.f, 0.f}, 4, 0, 0, 0x7F7F7F7F, 0, wsc);
        asm volatile("ds_read_b64_tr_b4 %0, %1 offset:%2" : "=v"(t_[0]) : "v"(adr[4]), "n"(0*8192 + 0));
        asm volatile("ds_read_b64_tr_b4 %0, %1 offset:%2" : "=v"(t_[1]) : "v"(adr[4]), "n"(0*8192 + 8));
        asm volatile("ds_read_b64_tr_b4 %0, %1 offset:%2" : "=v"(t_[2]) : "v"(adr[5]), "n"(0*8192 + 0));
        asm volatile("ds_read_b64_tr_b4 %0, %1 offset:%2" : "=v"(t_[3]) : "v"(adr[5]), "n"(0*8192 + 8));
        asm volatile("ds_read_b64_tr_b4 %0, %1 offset:%2" : "=v"(t_[4]) : "v"(adr[6]), "n"(0*8192 + 0));
        asm volatile("ds_read_b64_tr_b4 %0, %1 offset:%2" : "=v"(t_[5]) : "v"(adr[6]), "n"(0*8192 + 8));
        asm volatile("ds_read_b64_tr_b4 %0, %1 offset:%2" : "=v"(t_[6]) : "v"(adr[7]), "n"(0*8192 + 0));
        asm volatile("ds_read_b64_tr_b4 %0, %1 offset:%2" : "=v"(t_[7]) : "v"(adr[7]), "n"(0*8192 + 8));
        asm volatile("s_waitcnt lgkmcnt(6)" : "+v"(t_[0]), "+v"(t_[1])); asm volatile("s_waitcnt lgkmcnt(4)" : "+v"(t_[2]), "+v"(t_[3]));
        asm volatile("s_waitcnt lgkmcnt(2)" : "+v"(t_[4]), "+v"(t_[5])); asm volatile("s_waitcnt lgkmcnt(0)" : "+v"(t_[6]), "+v"(t_[7]));
        acc[8] = __builtin_amdgcn_mfma_scale_f32_16x16x128_f8f6f4((v8i_t){(int)t_[0].x, (int)t_[0].y, 0, 0, 0, 0, 0, 0}, wb, (f32x4){0.f, 0.f, 0.f, 0.f}, 4, 0, 0, 0x7F7F7F7F, 0, wsc);
        acc[9] = __builtin_amdgcn_mfma_scale_f32_16x16x128_f8f6f4((v8i_t){(int)t_[1].x, (int)t_[1].y, 0, 0, 0, 0, 0, 0}, wb, (f32x4){0.f, 0.f, 0.f, 0.f}, 4, 0, 0, 0x7F7F7F7F, 0, wsc);
        acc[10] = __builtin_amdgcn_mfma_scale_f32_16x16x128_f8f6f4((v8i_t){(int)t_[2].x, (int)t_[2].y, 0, 0, 0, 0, 0, 0}, wb, (f32x4){0.f, 0.f, 0.f, 0.f}, 4, 0, 0, 0x7F7F7F7F, 0, wsc);
        acc[11] = __builtin_amdgcn_mfma_scale_f32_16x16x128_f8f6f4((v8i_t){(int)t_[3].x, (int)t_[3].y, 0, 0, 0, 0, 0, 0}, wb, (f32x4){0.f, 0.f, 0.f, 0.f}, 4, 0, 0, 0x7F7F7F7F, 0, wsc);
        acc[12] = __builtin_amdgcn_mfma_scale_f32_16x16x128_f8f6f4((v8i_t){(int)t_[4].x, (int)t_[4].y, 0, 0, 0, 0, 0, 0}, wb, (f32x4){0.f, 0.f, 0.f, 0.f}, 4, 0, 0, 0x7F7F7F7F, 0, wsc);
        acc[13] = __builtin_amdgcn_mfma_scale_f32_16x16x128_f8f6f4((v8i_t){(int)t_[5].x, (int)t_[5].y, 0, 0, 0, 0, 0, 0}, wb, (f32x4){0.f, 0.f, 0.f, 0.f}, 4, 0, 0, 0x7F7F7F7F, 0, wsc);
        acc[14] = __builtin_amdgcn_mfma_scale_f32_16x16x128_f8f6f4((v8i_t){(int)t_[6].x, (int)t_[6].y, 0, 0, 0, 0, 0, 0}, wb, (f32x4){0.f, 0.f, 0.f, 0.f}, 4, 0, 0, 0x7F7F7F7F, 0, wsc);
        acc[15] = __builtin_amdgcn_mfma_scale_f32_16x16x128_f8f6f4((v8i_t){(int)t_[7].x, (int)t_[7].y, 0, 0, 0, 0, 0, 0}, wb, (f32x4){0.f, 0.f, 0.f, 0.f}, 4, 0, 0, 0x7F7F7F7F, 0, wsc);
        }
        if (!last) { u32x4 idn; PV_RD_IDS(idn, 0, par ^ 1); PV_ISSUE(0, idn); }
        if (last) asm volatile("s_waitcnt vmcnt(0)" ::: "memory"); else asm volatile("s_waitcnt vmcnt(8)" ::: "memory");
        { u32x2 t_[8];
        asm volatile("ds_read_b64_tr_b4 %0, %1 offset:%2" : "=v"(t_[0]) : "v"(adr[0]), "n"(1*8192 + 0));
        asm volatile("ds_read_b64_tr_b4 %0, %1 offset:%2" : "=v"(t_[1]) : "v"(adr[0]), "n"(1*8192 + 8));
        asm volatile("ds_read_b64_tr_b4 %0, %1 offset:%2" : "=v"(t_[2]) : "v"(adr[1]), "n"(1*8192 + 0));
        asm volatile("ds_read_b64_tr_b4 %0, %1 offset:%2" : "=v"(t_[3]) : "v"(adr[1]), "n"(1*8192 + 8));
        asm volatile("ds_read_b64_tr_b4 %0, %1 offset:%2" : "=v"(t_[4]) : "v"(adr[2]), "n"(1*8192 + 0));
        asm volatile("ds_read_b64_tr_b4 %0, %1 offset:%2" : "=v"(t_[5]) : "v"(adr[2]), "n"(1*8192 + 8));
        asm volatile("ds_read_b64_tr_b4 %0, %1 offset:%2" : "=v"(t_[6]) : "v"(adr[3]), "n"(1*8192 + 0));
        asm volatile("ds_read_b64_tr_b4 %0, %1 offset:%2" : "=v"(t_[7]) : "v"(adr[3]), "n"(1*8192 + 8));
        asm volatile("s_waitcnt lgkmcnt(6)" : "+v"(t_[0]), "+v"(t_[1])); asm volatile("s_waitcnt lgkmcnt(4)" : "+v"(t_[2]), "+v"(t_[3]));
        asm volatile("s_waitcnt lgkmcnt(2)" : "+v"(t_[4]), "+v"(t_[5])); asm volatile("s_waitcnt lgkmcnt(0)" : "+v"(t_[6]), "+v"(t_[7]));
        acc[0] = __builtin_amdgcn_mfma_scale_f32_16x16x128_f8f6f4((v8i_t){0, 0, (int)t_[0].x, (int)t_[0].y, 0, 0, 0, 0}, wb, acc[0], 4, 0, 0, 0x7F7F7F7F, 0, wsc);
        acc[1] = __builtin_amdgcn_mfma_scale_f32_16x16x128_f8f6f4((v8i_t){0, 0, (int)t_[1].x, (int)t_[1].y, 0, 0, 0, 0}, wb, acc[1], 4, 0, 0, 0x7F7F7F7F, 0, wsc);
        acc[2] = __builtin_amdgcn_mfma_scale_f32_16x16x128_f8f6f4((v8i_t){0, 0, (int)t_[2].x, (int)t_[2].y, 0, 0, 0, 0}, wb, acc[2], 4, 0, 0, 0x7F7F7F7F, 0, wsc);
        acc[3] = __builtin_amdgcn_mfma_scale_f32_16x16x128_f8f6f4((v8i_t){0, 0, (int)t_[3].x, (int)t_[3].y, 0, 0, 0, 0}, wb, acc[3], 4, 0, 0, 0x7F7F7F7F, 0, wsc);
        acc[4] = __builtin_amdgcn_mfma_scale_f32_16x16x128_f8f6f4((v8i_t){0, 0, (int)t_[4].x, (int)t_[4].y, 0, 0, 0, 0}, wb, acc[4], 4, 0, 0, 0x7F7F7F7F, 0, wsc);
        acc[5] = __builtin_amdgcn_mfma_scale_f32_16x16x128_f8f6f4((v8i_t){0, 0, (int)t_[5].x, (int)t_[5].y, 0, 0, 0, 0}, wb, acc[5], 4, 0, 0, 0x7F7F7F7F, 0, wsc);
        acc[6] = __builtin_amdgcn_mfma_scale_f32_16x16x128_f8f6f4((v8i_t){0, 0, (int)t_[6].x, (int)t_[6].y, 0, 0, 0, 0}, wb, acc[6], 4, 0, 0, 0x7F7F7F7F, 0, wsc);
        acc[7] = __builtin_amdgcn_mfma_scale_f32_16x16x128_f8f6f4((v8i_t){0, 0, (int)t_[7].x, (int)t_[7].y, 0, 0, 0, 0}, wb, acc[7], 4, 0, 0, 0x7F7F7F7F, 0, wsc);
        asm volatile("ds_read_b64_tr_b4 %0, %1 offset:%2" : "=v"(t_[0]) : "v"(adr[4]), "n"(1*8192 + 0));
        asm volatile("ds_read_b64_tr_b4 %0, %1 offset:%2" : "=v"(t_[1]) : "v"(adr[4]), "n"(1*8192 + 8));
        asm volatile("ds_read_b64_tr_b4 %0, %1 offset:%2" : "=v"(t_[2]) : "v"(adr[5]), "n"(1*8192 + 0));
        asm volatile("ds_read_b64_tr_b4 %0, %1 offset:%2" : "=v"(t_[3]) : "v"(adr[5]), "n"(1*8192 + 8));
        asm volatile("ds_read_b64_tr_b4 %0, %1 offset:%2" : "=v"(t_[4]) : "v"(adr[6]), "n"(1*8192 + 0));
        asm volatile("ds_read_b64_tr_b4 %0, %1 offset:%2" : "=v"(t_[5]) : "v"(adr[6]), "n"(1*8192 + 8));
        asm volatile("ds_read_b64_tr_b4 %0, %1 offset:%2" : "=v"(t_[6]) : "v"(adr[7]), "n"(1*8192 + 0));
        asm volatile("ds_read_b64_tr_b4 %0, %1 offset:%2" : "=v"(t_[7]) : "v"(adr[7]), "n"(1*8192 + 8));
        asm volatile("s_waitcnt lgkmcnt(6)" : "+v"(t_[0]), "+v"(t_[1])); asm volatile("s_waitcnt lgkmcnt(4)" : "+v"(t_[2]), "+v"(t_[3]));
        asm volatile("s_waitcnt lgkmcnt(2)" : "+v"(t_[4]), "+v"(t_[5])); asm volatile("s_waitcnt lgkmcnt(0)" : "+v"(t_[6]), "+v"(t_[7]));
        acc[8] = __builtin_amdgcn_mfma_scale_f32_16x16x128_f8f6f4((v8i_t){0, 0, (int)t_[0].x, (int)t_[0].y, 0, 0, 0, 0}, wb, acc[8], 4, 0, 0, 0x7F7F7F7F, 0, wsc);
        acc[9] = __builtin_amdgcn_mfma_scale_f32_16x16x128_f8f6f4((v8i_t){0, 0, (int)t_[1].x, (int)t_[1].y, 0, 0, 0, 0}, wb, acc[9], 4, 0, 0, 0x7F7F7F7F, 0, wsc);
        acc[10] = __builtin_amdgcn_mfma_scale_f32_16x16x128_f8f6f4((v8i_t){0, 0, (int)t_[2].x, (int)t_[2].y, 0, 0, 0, 0}, wb, acc[10], 4, 0, 0, 0x7F7F7F7F, 0, wsc);
        acc[11] = __builtin_amdgcn_mfma_scale_f32_16x16x128_f8f6f4((v8i_t){0, 0, (int)t_[3].x, (int)t_[3].y, 0, 0, 0, 0}, wb, acc[11], 4, 0, 0, 0x7F7F7F7F, 0, wsc);
        acc[12] = __builtin_amdgcn_mfma_scale_f32_16x16x128_f8f6f4((v8i_t){0, 0, (int)t_[4].x, (int)t_[4].y, 0, 0, 0, 0}, wb, acc[12], 4, 0, 0, 0x7F7F7F7F, 0, wsc);
        acc[13] = __builtin_amdgcn_mfma_scale_f32_16x16x128_f8f6f4((v8i_t){0, 0, (int)t_[5].x, (int)t_[5].y, 0, 0, 0, 0}, wb, acc[13], 4, 0, 0, 0x7F7F7F7F, 0, wsc);
        acc[14] = __builtin_amdgcn_mfma_scale_f32_16x16x128_f8f6f4((v8i_t){0, 0, (int)t_[6].x, (int)t_[6].y, 0, 0, 0, 0}, wb, acc[14], 4, 0, 0, 0x7F7F7F7F, 0, wsc);
        acc[15] = __builtin_amdgcn_mfma_scale_f32_16x16x128_f8f6f4((v8i_t){0, 0, (int)t_[7].x, (int)t_[7].y, 0, 0, 0, 0}, wb, acc[15], 4, 0, 0, 0x7F7F7F7F, 0, wsc);
        }
        { f32x4 o = acc[0];
#pragma unroll
          for (int cg = 1; cg < 16; ++cg) { const bool sel = (idx == cg); o[0] = sel ? acc[cg][0] : o[0]; o[1] = sel ? acc[cg][1] : o[1]; o[2] = sel ? acc[cg][2] : o[2]; o[3] = sel ? acc[cg][3] : o[3]; }
          asm volatile("" : "+v"(o));
          u32x2 ov; ov.x = pk2(o[0], o[1]); ov.y = pk2(o[2], o[3]);
          *(u32x2*)(fbuf + (size_t)row * D + slice * 256 + 16 * idx + 4 * g) = ov; }
        if (!last) { u32x4 idn; PV_RD_IDS(idn, 1, par ^ 1); PV_DMA_WB(row + 1, par ^ 1); PV_DMA_IDS(row + (ti + 2 < NTW ? 2 : 1), par); PV_ISSUE(1, idn); }
    }
#undef PV_DMA_IDS
#undef PV_DMA_WB
#undef PV_RD_IDS
#undef PV_ISSUE
}

struct Ln2In { TRow t; u32x2 f[4]; };
__device__ __forceinline__ void ln2_load(Ln2In& I, int row, int lane, const bf16_t* fbuf, const bf16_t* tb) {
    trow_load(I.t, row, lane, tb); const bf16_t* fp = fbuf + (size_t)row * D;
#pragma unroll
    for (int j = 0; j < 4; ++j) I.f[j] = *(const u32x2*)(fp + j * 256 + lane * 4);
}
__device__ __forceinline__ float ln2_row(f32x4 (&v)[4], const Ln2In& I, int row, int lane, const f32x4 (&l1g)[4], const f32x4 (&l1b)[4], const f32x4 (&g2)[4], const f32x4 (&lg)[4], const f32x4 (&lb)[4], float* x2f, bf16_t* x2b, float* x2c) {
    float sm = 0.f;
    (void)ln1_apply(v, I.t, l1g, l1b);
#pragma unroll
    for (int j = 0; j < 4; ++j) { const u32x2 fw = I.f[j]; const f32x4 f = (f32x4){bflo(fw.x), bfhi(fw.x), bflo(fw.y), bfhi(fw.y)};
        v[j] = v[j] * ALPHA + g2[j] * f; sm += (v[j][0] + v[j][1]) + (v[j][2] + v[j][3]); }
    const float mu = wave_sum(sm) * (1.0f / 1024.0f); float q = 0.f;
#pragma unroll
    for (int j = 0; j < 4; ++j) { v[j] = v[j] - mu; q += (v[j][0] * v[j][0] + v[j][1] * v[j][1]) + (v[j][2] * v[j][2] + v[j][3] * v[j][3]); }
    const float rstd = 1.0f / sqrtf(wave_sum(q) * (1.0f / 1024.0f) + EPS);
    sm = 0.f;
#pragma unroll
    for (int j = 0; j < 4; ++j) { v[j] = v[j] * rstd * lg[j] + lb[j]; row_store(v[j], row, j * 256 + lane * 4, x2f, x2b, x2c); sm += (v[j][0] + v[j][1]) + (v[j][2] + v[j][3]); }
    return sm;
}
#ifndef MK_SINGLE
#define MK_SINGLE 1
#endif
__global__ void __launch_bounds__(NTHREADS, 2) mk_fwd(Params P) {
    extern __shared__ __attribute__((aligned(16))) unsigned char lds_raw[];
    Frame F;
    F.lds = (LAS unsigned char*)lds_raw;
    F.tid = threadIdx.x; F.lane = F.tid & 63; F.wave = __builtin_amdgcn_readfirstlane(F.tid >> 6);
    F.G = gridDim.x; { const int bx = blockIdx.x; F.vcu = (F.G % 8 == 0) ? (bx % 8) * (F.G / 8) + bx / 8 : bx; }
    volatile LAS unsigned* MISC = (volatile LAS unsigned*)(F.lds + MISC_OFF);
    for (int u = F.tid; u < (LDS_BYTES - MISC_OFF) / 4; u += NTHREADS) MISC[u] = 0u;
    __syncthreads();
    unsigned char* ws = P.ws;
    unsigned* ctl = (unsigned*)(ws + WS_CTL);
    XcdBarrier bar; bar.bar = ctl + CW_BAR; bar.x = 0; bar.st = nullptr;
    if (P.ph_hi - P.ph_lo > 1) bar = xcd_barrier_post(ctl + CW_BAR, MISC + 8);

    const float* x = P.in[0]; const float* c = P.in[1]; const float* ctxin = P.in[2]; const float* c_ctx = P.in[3]; const float* w_mod = P.in[4]; const float* b_mod = P.in[5];
    const float* w_in = P.in[6]; const float* q_norm_g = P.in[7]; const float* k_norm_g = P.in[8]; const float* gmlp_ln_g = P.in[9]; const float* gmlp_ln_b = P.in[10];
    const float* gmlp_w_s = P.in[11]; const float* gmlp_b_s = P.in[12]; const float* conv_w_dw = P.in[13]; const float* conv_b_dw = P.in[14]; const float* conv_ln_g = P.in[15];
    const float* conv_ln_b = P.in[16]; const float* conv_w_pw = P.in[17]; const float* conv_b_pw = P.in[18]; const float* w_out = P.in[19]; const float* ln1_g = P.in[20];
    const float* ln1_b = P.in[21]; const float* ln2_g = P.in[22]; const float* ln2_b = P.in[23]; const float* peer_w_q = P.in[24]; const float* peer_sk = P.in[25];
    const float* peer_u = P.in[26]; const float* peer_v = P.in[27];
    float* out = P.out;
    float* mod = (float*)(ws + WS_MOD); float* rope = (float*)(ws + WS_ROPE); float* bout = (float*)(ws + WS_BOUT);
    bf16_t* Win_t = (bf16_t*)(ws + WS_WIN_T); bf16_t* Wout_t = (bf16_t*)(ws + WS_WOUT_T); bf16_t* Ws_t = (bf16_t*)(ws + WS_WS_T); bf16_t* gws = (bf16_t*)(ws + WS_GWS);
    float* xc1 = (float*)(ws + WS_XC1); float* xc2 = (float*)(ws + WS_XC2);
    unsigned char* u8 = ws + WS_U8; unsigned char* v8 = ws + WS_V8;
    bf16_t* hbuf = (bf16_t*)(ws + WS_H); bf16_t* qbuf = (bf16_t*)(ws + WS_Q); bf16_t* kvbuf = (bf16_t*)(ws + WS_KV); bf16_t* zgbuf = (bf16_t*)(ws + WS_ZG); bf16_t* ycbuf = (bf16_t*)(ws + WS_YC);
    bf16_t* mix = (bf16_t*)(ws + WS_MIX); bf16_t* ybuf = (bf16_t*)(ws + WS_Y); unsigned short* sbuf = (unsigned short*)(ws + WS_S);
    bf16_t* pact = (bf16_t*)(ws + WS_PACT); bf16_t* fbuf = (bf16_t*)(ws + WS_F); unsigned short* tk_idx = (unsigned short*)(ws + WS_TKI); float* tk_gate = (float*)(ws + WS_TKG); unsigned char* w8buf = ws + WS_W; unsigned* wscbuf = (unsigned*)(ws + WS_W + 8 * MiB); unsigned char* h8buf = ws + WS_H8; bf16_t* x2b = (bf16_t*)out;

    const P0Ptrs PP{c, c_ctx, w_mod, b_mod, peer_w_q, peer_sk, conv_w_pw, conv_b_pw, w_out, w_in, peer_u, peer_v, mod, bout, Ws_t, Wout_t, Win_t, u8, v8};
    const int lo = P.ph_lo, hi = P.ph_hi;
#ifdef PROBE_MASK
    unsigned long long probe_acc = 0ull, probe_t0 = 0ull;
#define PROBE_BEGIN(k) do { if ((PROBE_MASK >> (k)) & 1) { __syncthreads(); probe_t0 = __builtin_amdgcn_s_memrealtime(); } } while (0)
#define PROBE_END(k) do { if ((PROBE_MASK >> (k)) & 1) { __syncthreads(); probe_acc += __builtin_amdgcn_s_memrealtime() - probe_t0; } } while (0)
#else
#define PROBE_BEGIN(k) do {} while (0)
#define PROBE_END(k) do {} while (0)
#endif
#define IN(k) (lo <= (k) && (k) < hi)
#define SEAM(k) do { if (IN(k) && IN((k) + 1)) xcd_barrier(bar); } while (0)
    const int gw = F.vcu * NWAVES + F.wave, NGW = F.G * NWAVES;
    const int gt = gw * 64 + F.lane, NGT = NGW * 64;

    PROBE_BEGIN(0);
    if (IN(0)) {
#ifndef NO_P0
        p0_block_items(F, PP, 0, 7, F.vcu, F.G);
        p0_wave_transposes(F, PP, 0, gw, NGW);
        for (int i = (NGT >= 2048 ? gt - (NGT - 2048) : gt); i < 2048; i += NGT) if (i >= 0) { const int pos = i >> 4, f = i & 15; const double a = (double)pos * exp(-(double)f * (9.210340371976184 / 16.0)); rope[i * 2] = (float)cos(a); rope[i * 2 + 1] = (float)sin(a); }
        for (int i = gt; i < 2 * 4 * 128 * 128 / 2; i += NGT) { const f32x2 v = *(const f32x2*)(gmlp_w_s + (size_t)i * 2); ((unsigned*)gws)[i] = pk2(v[0], v[1]); }
        p0_convert_tables(PP, 0, gt, NGT);
        __syncthreads();
#endif
    }
    SEAM(0);
    PROBE_END(0);
    PROBE_BEGIN(1);
    if (IN(1)) {
#pragma unroll 1
        for (int ch = gw; ch < ML / 16; ch += NGW) {
            const int r0 = ch * 16; const float* mp = mod + (size_t)modid(r0) * 6144;
            f32x4 sh[4], sc[4]; load_par(sh, mp, F.lane); load_par(sc, mp + 1024, F.lane);
#pragma unroll 1
            for (int tr = 0; tr < 4; ++tr) {
                f32x4 xv[4][4];
#pragma unroll
                for (int k = 0; k < 4; ++k) { const float* xp = x + (size_t)(r0 + tr * 4 + k) * D;
#pragma unroll
                    for (int j = 0; j < 4; ++j) xv[k][j] = *(const f32x4*)(xp + j * 256 + F.lane * 4); }
#pragma unroll
                for (int k = 0; k < 4; ++k) { float s = 0.f;
#pragma unroll
                    for (int j = 0; j < 4; ++j) s += (xv[k][j][0] + xv[k][j][1]) + (xv[k][j][2] + xv[k][j][3]);
                    adaln_store(xv[k], s, sh, sc, hbuf + (size_t)(r0 + tr * 4 + k) * D, F.lane); }
            }
        }
#pragma unroll 1
        for (int row = ML + gw; row < MT; row += NGW) {
            const float* mp = mod + (size_t)4 * 6144; f32x4 sh[4], sc[4], xv[4]; load_par(sh, mp, F.lane); load_par(sc, mp + 1024, F.lane); load_par(xv, ctxin + (size_t)(row - ML) * D, F.lane);
            float s = 0.f;
#pragma unroll
            for (int j = 0; j < 4; ++j) s += (xv[j][0] + xv[j][1]) + (xv[j][2] + xv[j][3]);
            adaln_store(xv, s, sh, sc, hbuf + (size_t)row * D, F.lane);
        }
    }
    SEAM(1);
    PROBE_END(1);

    for (int l = 0; l < 2; ++l) {
        const int pb = 2 + 10 * l;
#define LAUNDER() do { int t_ = threadIdx.x; asm volatile("" : "+v"(t_)); F.tid = t_; F.lane = t_ & 63; } while (0)
        const float* modl = mod + (size_t)l * 5 * 6144;
        const float* xl = l == 0 ? x : out; const float* xc = l == 0 ? ctxin : xc2;
        const int nr = l == 0 ? MT : ML;
        PROBE_BEGIN(2);
        if (IN(pb)) {
            LAUNDER();
#ifndef NO_A
            pg8::Gemm g{hbuf, Win_t + (size_t)l * INW * 1024, MT, INW, 1024}; pg8::StaticOrder S; S.init(MT, INW, F.G, (int)blockIdx.x);
            pg8::EpiInProj E{qbuf, kvbuf, zgbuf, ycbuf, q_norm_g + l * 64, k_norm_g + l * 64, rope};
            pg8::gemm_phase<pg8::EpiInProj, pg8::StaticOrder, true, true>(F.lds, g, S, E);
#endif
        }
        SEAM(pb);
        PROBE_END(2);
        PROBE_BEGIN(3);
        if (IN(pb + 1)) {
            LAUNDER();
#ifndef NO_ATT
            for (int u0 = F.vcu * 4; u0 < 1024; u0 += F.G * 4)
                for (int i = 0; i < 4; ++i) { const int u = u0 + i, gi = u >> 7, qb = (u & 127) >> 2, b = gi >> 1, g = gi & 1, hq = g * 4 + (u & 3);
                    const size_t row0 = (size_t)b * SEQ + qb * 256;
                    attn_body::attn_unit<8>((const attn_body::bf16*)(qbuf + row0 * 512 + hq * 64), (const attn_body::bf16*)(kvbuf + (size_t)b * KVSEQ * 256 + g * 64),
                                            (const attn_body::bf16*)(kvbuf + (size_t)b * KVSEQ * 256 + 128 + g * 64), (attn_body::bf16*)(mix + row0 * 1024 + hq * 64), KVSEQ / 64, (char*)lds_raw); }
            if (l == 0)
                for (int u = F.vcu; u < 32; u += F.G) { const int b = u >> 3, hq = u & 7, g = hq >> 2; const size_t row0 = (size_t)ML + b * CTXL;
                    attn_body::attn_unit<8>((const attn_body::bf16*)(qbuf + row0 * 512 + hq * 64), (const attn_body::bf16*)(kvbuf + (size_t)b * KVSEQ * 256 + g * 64),
                                            (const attn_body::bf16*)(kvbuf + (size_t)b * KVSEQ * 256 + 128 + g * 64), (attn_body::bf16*)(mix + row0 * 1024 + hq * 64), CTXL / 64, (char*)lds_raw); }
#endif
            __syncthreads();
            PROBE_BEGIN(12);
#ifndef NO_GMLP
            for (int ch = F.vcu; ch < nr / 128; ch = (ch < F.G ? F.G + ((F.vcu + F.G - (32 % F.G)) % F.G) : ch + F.G))
                gmlp_chunk(F, ch, zgbuf, gmlp_ln_g + l * 256, gmlp_ln_b + l * 256, gws + (size_t)l * 4 * 128 * 128, gmlp_b_s + l * 512, mix);
#endif
#ifndef NO_CONV
            for (int tl = (F.vcu < F.G / 2 ? F.vcu + F.G / 2 : F.vcu - F.G / 2); tl < nr / 128; tl += F.G)
                conv_tile(F, tl, ycbuf, conv_w_dw + l * 31 * 256, conv_b_dw + l * 256, conv_ln_g + l * 256, conv_ln_b + l * 256, mix);
#endif
            PROBE_END(12);
            __syncthreads();
        }
        SEAM(pb + 1);
        PROBE_END(3);
        PROBE_BEGIN(4);
        if (IN(pb + 2)) {
            LAUNDER();
            pg8::Gemm g{mix, Wout_t + (size_t)l * 1024 * 1024, nr, 1024, 1024}; pg8::StaticOrder S; S.init(nr, 1024, F.G, (int)blockIdx.x);
            pg8::EpiResid E{ybuf, bout + l * 1024, modl, x, l == 0 ? (const bf16_t*)nullptr : (const bf16_t*)x2b, xc};
#ifndef NO_GF32
            pg8::gemm_phase<pg8::EpiResid, pg8::StaticOrder, true, true>(F.lds, g, S, E);
#endif
            if (l == 0) { int nw; const int w = idle_worker((nr / 256) * 4, F.G, (int)blockIdx.x, nw); if (w >= 0) { LAUNDER(); p0_block_items(F, PP, 1, 2, w, nw); } }
        }
        SEAM(pb + 2);
        PROBE_END(4);
        PROBE_BEGIN(5);
        if (IN(pb + 3)) { LAUNDER();
            const int w0 = F.vcu * NWAVES + __builtin_amdgcn_readfirstlane(F.tid >> 6);
            f32x4 lg[4], lb[4]; load_par(lg, ln1_g + l * 1024, F.lane); load_par(lb, ln1_b + l * 1024, F.lane);
#pragma unroll 1
            for (int ch = w0; ch < ML / 16; ch += NGW) {
                const int r0 = ch * 16; const float* mp = modl + (size_t)modid(r0) * 6144;
                f32x4 sh[4], sc[4]; load_par(sh, mp + 3072, F.lane); load_par(sc, mp + 4096, F.lane);
#pragma unroll 1
                for (int tr = 0; tr < 4; ++tr) {
                    TRow in4[4];
#pragma unroll
                    for (int k = 0; k < 4; ++k) trow_load(in4[k], r0 + tr * 4 + k, F.lane, ybuf);
#pragma unroll
                    for (int k = 0; k < 4; ++k) { f32x4 v[4]; const float s = ln1_apply(v, in4[k], lg, lb); adaln_store(v, s, sh, sc, hbuf + (size_t)(r0 + tr * 4 + k) * D, F.lane, h8buf + (size_t)(r0 + tr * 4 + k) * D); }
                }
                        }
#pragma unroll 1
            for (int row = ML + w0; row < nr; row += NGW) {
                const float* mp = modl + (size_t)4 * 6144; f32x4 sh[4], sc[4]; load_par(sh, mp + 3072, F.lane); load_par(sc, mp + 4096, F.lane);
                TRow in1; trow_load(in1, row, F.lane, ybuf); f32x4 v[4]; const float s = ln1_apply(v, in1, lg, lb); adaln_store(v, s, sh, sc, hbuf + (size_t)row * D, F.lane, h8buf + (size_t)row * D);
            } }
        SEAM(pb + 3);
        PROBE_END(5);
        PROBE_BEGIN(6);
        if (IN(pb + 4)) {
            LAUNDER();
            pg8::Gemm g{hbuf, Ws_t + (size_t)l * 2048 * 1024, nr, 2048, 1024}; pg8::StaticOrder S; S.init(nr, 2048, F.G, (int)blockIdx.x);
#ifdef TK_F32
            pg8::EpiF32 E{(float*)sbuf, 2048, nullptr};
            pg8::gemm_phase<pg8::EpiF32, pg8::StaticOrder, true, true>(F.lds, g, S, E);
#else
            pg8::EpiF16 E{sbuf, 2048};
#ifndef NO_GF32
            pg8::gemm_phase<pg8::EpiF16, pg8::StaticOrder, true, true>(F.lds, g, S, E);
#endif
#ifndef TK_F32
            if (l == 0) { int nw; const int w = idle_worker((nr / 256) * 8, F.G, (int)blockIdx.x, nw);
                if (w >= 0) { LAUNDER(); p0_block_items(F, PP, 1, 5, w, nw); p0_wave_transposes(F, PP, 1, w * NWAVES + F.wave, nw * NWAVES); p0_convert_tables(PP, 1, w * NTHREADS + F.tid, nw * NTHREADS); __syncthreads(); } }
#endif
#endif
        }
        SEAM(pb + 4);
        PROBE_END(6);
        PROBE_BEGIN(7);
        if (IN(pb + 5)) {
            LAUNDER();
#ifndef NO_PEER
            peer_topk_wave(F, gw, nr / 4, NGW, sbuf, tk_idx, tk_gate);
#endif
        }
        SEAM(pb + 5);
        PROBE_END(7);
        PROBE_BEGIN(8);
        if (IN(pb + 6)) {
            LAUNDER();
#ifndef NO_PEER
            const int own = (int)(xb_xcc_id() & 7u) >> 1;
            const int gwv = F.vcu * NWAVES + F.wave;
            const int r_lo = (int)(((long long)gwv * nr) / NGW), r_hi = (int)(((long long)(gwv + 1) * nr) / NGW), ntw = r_hi - r_lo;
            if (ntw > 0) {
                for (int so = 0; so < 4; ++so) { const int slice = (own + so) & 3; peer_u_item(F, r_lo, ntw, slice, h8buf, tk_idx, u8 + ((size_t)l * 4 + slice) * 16384 * 128, pact); }
                asm volatile("s_waitcnt vmcnt(0)" ::: "memory"); __builtin_amdgcn_fence(__ATOMIC_ACQ_REL, "workgroup");
#pragma unroll 1
                for (int r = r_lo; r < r_hi; r += 2) {
                    const int tok = r + (F.lane >> 5); const bool valid = tok < r_hi; const int i = (valid ? tok : r) * 32 + (F.lane & 31);
                    f32x4 a = (f32x4){0.f, 0.f, 0.f, 0.f};
#pragma unroll
                    for (int sl = 0; sl < 4; ++sl) { const u32x2 pw = *(const u32x2*)(pact + ((size_t)sl * MT * 128) + (size_t)i * 4); a = a + (f32x4){bflo(pw.x), bfhi(pw.x), bflo(pw.y), bfhi(pw.y)}; }
                    const f32x4 g = *(const f32x4*)(tk_gate + (size_t)i * 4);
                    f32x4 w;
#pragma unroll
                    for (int e = 0; e < 4; ++e) w[e] = g[e] * gelu_tanh(a[e] * (1.0f / (U_SCALE * H_SCALE))) * (1.0f / V_SCALE);
                    float mx = fmaxf(fmaxf(fabsf(w[0]), fabsf(w[1])), fmaxf(fabsf(w[2]), fabsf(w[3])));
                    mx = fmaxf(mx, dpp_f<0xB1>(mx)); mx = fmaxf(mx, dpp_f<0x4E>(mx)); mx = fmaxf(mx, dpp_f<0x141>(mx)); mx = fmaxf(mx, dpp_f<0x140>(mx)); mx = fmaxf(mx, xchg16(mx, F.lane & 16));
                    int ex = (int)((__float_as_uint(mx) >> 23) & 255u) - 127; ex = ex < -100 ? -100 : ex;
                    const float sc = __uint_as_float((unsigned)(134 - ex) << 23);
                    int pw8 = 0; pw8 = __builtin_amdgcn_cvt_pk_fp8_f32(w[0] * sc, w[1] * sc, pw8, false); pw8 = __builtin_amdgcn_cvt_pk_fp8_f32(w[2] * sc, w[3] * sc, pw8, true);
                    if (valid) { *(unsigned*)(w8buf + (size_t)i * 4) = (unsigned)pw8; if ((i & 31) == 0) wscbuf[i >> 5] = 0x01010101u * (unsigned)(ex + 120); }
                }
                asm volatile("s_waitcnt vmcnt(0)" ::: "memory"); __builtin_amdgcn_fence(__ATOMIC_ACQ_REL, "workgroup");
                for (int so = 0; so < 4; ++so) { const int slice = (own + so) & 3; peer_v_item(F, r_lo, ntw, slice, tk_idx, w8buf, wscbuf, v8 + ((size_t)l * 4 + slice) * 16384 * 128, fbuf); }
                asm volatile("s_waitcnt vmcnt(0)" ::: "memory"); __builtin_amdgcn_fence(__ATOMIC_ACQ_REL, "workgroup");
                {
                    f32x4 l1g[4], l1b[4], lg[4], lb[4];
                    load_par(l1g, ln1_g + l * 1024, F.lane); load_par(l1b, ln1_b + l * 1024, F.lane); load_par(lg, ln2_g + l * 1024, F.lane); load_par(lb, ln2_b + l * 1024, F.lane);
                    const float* modn = l == 0 ? mod + (size_t)5 * 6144 : (const float*)nullptr;
                    int mi_c = -1; f32x4 g2[4];
                    Ln2In cur; ln2_load(cur, r_lo, F.lane, fbuf, ybuf);
#pragma unroll 1
                    for (int row = r_lo; row < r_hi; ++row) {
                        const int mi = modid(row);
                        if (mi != mi_c) { load_par(g2, modl + (size_t)mi * 6144 + 5120, F.lane); mi_c = mi; }
                        Ln2In nxt; ln2_load(nxt, row + 1 < r_hi ? row + 1 : row, F.lane, fbuf, ybuf);
                        f32x4 v[4];
                        const float s_ = ln2_row(v, cur, row, F.lane, l1g, l1b, g2, lg, lb, out, l == 0 ? x2b : (bf16_t*)nullptr, xc2);
                        if (modn) { f32x4 shn[4], scn[4]; load_par(shn, modn + (size_t)mi * 6144, F.lane); load_par(scn, modn + (size_t)mi * 6144 + 1024, F.lane); asm volatile("" ::: "memory");
                            adaln_store(v, s_, shn, scn, hbuf + (size_t)row * D, F.lane); }
                        cur = nxt;
                    }
                }
            }
#endif
        }
        PROBE_END(8);
        PROBE_BEGIN(11);
        SEAM(pb + 9);
        PROBE_END(11);
    }
#ifdef PROBE_MASK
    if (blockIdx.x == 0 && threadIdx.x == 0) { const unsigned long long t1 = __builtin_amdgcn_s_memrealtime(); while (__builtin_amdgcn_s_memrealtime() - t1 < (unsigned long long)PROBE_MULT * probe_acc) __builtin_amdgcn_s_sleep(32); }
#endif
#undef IN
#undef SEAM
}

extern "C" void kernel_launch(void* const* d_in, const int* in_sizes, int n_in, void* d_out, int out_size, void* d_ws, size_t ws_size, hipStream_t stream) {
    static int grid = 0;
    if (grid == 0) {
        int dev = 0, cus = 0;
        if (n_in != 28 || ws_size < WS_END) { fprintf(stderr, "kernel_launch: unexpected n_in %d / ws_size %zu (need %zu)\n", n_in, ws_size, (size_t)WS_END); grid = -1; return; }
        if (hipGetDevice(&dev) != hipSuccess || hipDeviceGetAttribute(&cus, hipDeviceAttributeMultiprocessorCount, dev) != hipSuccess) { grid = -1; return; }
        if (hipFuncSetAttribute((const void*)mk_fwd, hipFuncAttributeMaxDynamicSharedMemorySize, LDS_BYTES) != hipSuccess) { fprintf(stderr, "kernel_launch: hipFuncSetAttribute failed\n"); grid = -1; return; }
        int per_cu = 0;
        if (hipOccupancyMaxActiveBlocksPerMultiprocessor(&per_cu, (const void*)mk_fwd, NTHREADS, LDS_BYTES) != hipSuccess || per_cu < 1) { fprintf(stderr, "kernel_launch: occupancy query says %d\n", per_cu); }
        (void)hipGetLastError();
        grid = cus;
    }
    if (grid < 0) return;
    (void)hipMemsetAsync((char*)d_ws + WS_CTL + (size_t)CW_BAR * 4, 0, 16384, stream);
    Params p{};
    for (int i = 0; i < 28; ++i) p.in[i] = (const float*)d_in[i];
    p.out = (float*)d_out; p.ws = (unsigned char*)d_ws;
#if MK_SINGLE
    p.ph_lo = 0; p.ph_hi = N_PHASES;
    hipLaunchKernelGGL(mk_fwd, dim3(grid), dim3(NTHREADS), LDS_BYTES, stream, p);
#else
    for (int ph = 0; ph < N_PHASES; ++ph) { p.ph_lo = ph; p.ph_hi = ph + 1; hipLaunchKernelGGL(mk_fwd, dim3(grid), dim3(NTHREADS), LDS_BYTES, stream, p); }
#endif
}
```
